# Optimizing an MI355X kernel written in HIP

```python
import jax, jax.numpy as jnp
from jax import lax
import numpy as np

D_MODEL = 1024
BATCH = 8
SEQ = 4096
DEPTH = 2

HG_EXPAND = 128
HG_HEADS = D_MODEL // HG_EXPAND
HG_DK = HG_EXPAND
HG_DV = D_MODEL // HG_HEADS
HG_QK = HG_HEADS * HG_DK
HG_WIDTH = HG_HEADS * HG_DV
HG_CHUNK = 64
RET_HEADS = D_MODEL // 256
RET_DK = D_MODEL // RET_HEADS
RET_DV = 2 * RET_DK
RET_QK = RET_HEADS * RET_DK
RET_WIDTH = RET_HEADS * RET_DV
RET_CHUNK = 128
ROPE_BASE = 10000.0
D_FF = 4 * D_MODEL
DEEPNORM_ALPHA = (2 * DEPTH) ** 0.25
DEEPNORM_BETA = (8 * DEPTH) ** -0.25
LN_EPS = 1e-5
HEAD_NORM_EPS = 1e-6
ADA_SCALE = 0.1
IN_SIZES = (HG_QK, HG_QK, HG_WIDTH, HG_WIDTH,
            RET_QK, RET_QK, RET_WIDTH, RET_WIDTH,
            D_MODEL, D_MODEL)
IN_WIDTH = sum(IN_SIZES)

kernel_name = "hgrn2_retention_gated_hybrid_deepnorm_adaln"


def _layer_norm(x, g, b):
    x32 = x.astype(jnp.float32)
    mu = jnp.mean(x32, axis=-1, keepdims=True)
    var = jnp.mean(jnp.square(x32 - mu), axis=-1, keepdims=True)
    return ((x32 - mu) * lax.rsqrt(var + LN_EPS)).astype(x.dtype) * g + b


def _head_norm(o, centered):
    if centered:
        o = o - jnp.mean(o, axis=-1, keepdims=True)
    return o * lax.rsqrt(jnp.mean(jnp.square(o), axis=-1, keepdims=True) + HEAD_NORM_EPS)


def _to_chunks(t, chunk):
    b, s, h, d = t.shape
    return t.reshape(b, s // chunk, chunk, h, d).transpose(1, 0, 3, 2, 4)


def _from_chunks(t):
    n, b, h, c, d = t.shape
    return t.transpose(1, 0, 3, 2, 4).reshape(b, n * c, h, d)


def _hgrn2(q, zf, v, g, lb):
    B, S, _ = q.shape
    f32 = jnp.float32
    zf = zf.astype(f32)
    lb = lb.astype(f32)
    q = jax.nn.silu(q.astype(f32)).reshape(B, S, HG_HEADS, HG_DK)
    log_f = jnp.logaddexp(jnp.log(lb), jnp.log1p(-lb) + jax.nn.log_sigmoid(zf))
    k = (1.0 - lb) * jax.nn.sigmoid(-zf)
    log_f = log_f.reshape(B, S, HG_HEADS, HG_DK)
    k = k.reshape(B, S, HG_HEADS, HG_DK)
    v = v.astype(f32).reshape(B, S, HG_HEADS, HG_DV)
    causal = jnp.tril(jnp.ones((HG_CHUNK, HG_CHUNK), dtype=bool))[:, :, None]

    def step(state, blk):
        qc, lfc, kc, vc = blk
        b = jnp.cumsum(lfc, axis=2)
        rel = jnp.where(causal, b[:, :, :, None, :] - b[:, :, None, :, :], -jnp.inf)
        scores = jnp.einsum('bhid,bhijd,bhjd->bhij', qc, jnp.exp(rel), kc)
        b_last = b[:, :, -1:, :]
        o = (jnp.einsum('bhij,bhje->bhie', scores, vc)
             + jnp.einsum('bhid,bhde->bhie', qc * jnp.exp(b), state))
        state = (jnp.exp(b_last[:, :, 0, :, None]) * state
                 + jnp.einsum('bhjd,bhje->bhde', kc * jnp.exp(b_last - b), vc))
        return state, o

    state0 = jnp.zeros((B, HG_HEADS, HG_DK, HG_DV), f32)
    blocks = (_to_chunks(q, HG_CHUNK), _to_chunks(log_f, HG_CHUNK),
              _to_chunks(k, HG_CHUNK), _to_chunks(v, HG_CHUNK))
    _, o = lax.scan(step, state0, blocks)
    o = _head_norm(_from_chunks(o), centered=False).reshape(B, S, HG_WIDTH)
    return (o * jax.nn.silu(g.astype(f32))).astype(g.dtype)


def _rotate(t, cos, sin):
    B, S, H, d = t.shape
    t = t.reshape(B, S, H, d // 2, 2)
    t1, t2 = t[..., 0], t[..., 1]
    return jnp.stack([t1 * cos - t2 * sin, t1 * sin + t2 * cos], axis=-1).reshape(B, S, H, d)


def _retention(q, k, v, g, positions):
    B, S, _ = q.shape
    f32 = jnp.float32
    theta = ROPE_BASE ** (-jnp.linspace(0.0, 1.0, RET_DK // 2, dtype=f32))
    ang = positions.astype(f32)[:, :, None, None] * theta
    cos, sin = jnp.cos(ang), jnp.sin(ang)
    q = _rotate(q.astype(f32).reshape(B, S, RET_HEADS, RET_DK), cos, sin)
    k = _rotate(k.astype(f32).reshape(B, S, RET_HEADS, RET_DK), cos, sin) * (RET_DK ** -0.5)
    v = v.astype(f32).reshape(B, S, RET_HEADS, RET_DV)
    log_gamma = jnp.log1p(-jnp.exp2(-5.0 - jnp.arange(RET_HEADS, dtype=f32)))
    pos = jnp.arange(RET_CHUNK, dtype=f32)
    diff = pos[:, None] - pos[None, :]
    decay_mask = jnp.where(diff >= 0,
                           jnp.exp(log_gamma[:, None, None] * jnp.maximum(diff, 0.0)), 0.0)
    q_decay = jnp.exp(log_gamma[:, None] * (pos + 1.0))[:, :, None]
    k_decay = jnp.exp(log_gamma[:, None] * (RET_CHUNK - 1.0 - pos))[:, :, None]
    chunk_decay = jnp.exp(log_gamma * RET_CHUNK)[:, None, None]

    def step(state, blk):
        qc, kc, vc = blk
        scores = jnp.einsum('bhid,bhjd->bhij', qc, kc) * decay_mask
        o = (jnp.einsum('bhij,bhje->bhie', scores, vc)
             + jnp.einsum('bhid,bhde->bhie', qc * q_decay, state))
        state = chunk_decay * state + jnp.einsum('bhjd,bhje->bhde', kc * k_decay, vc)
        return state, o

    state0 = jnp.zeros((B, RET_HEADS, RET_DK, RET_DV), f32)
    blocks = (_to_chunks(q, RET_CHUNK), _to_chunks(k, RET_CHUNK), _to_chunks(v, RET_CHUNK))
    _, o = lax.scan(step, state0, blocks)
    o = _head_norm(_from_chunks(o), centered=True).reshape(B, S, RET_WIDTH)
    return (o * jax.nn.silu(g.astype(f32))).astype(g.dtype)


def setup_inputs(seed: int = 0) -> dict:
    key = jax.random.key(seed)
    ks = jax.random.split(key, 20)
    f32 = jnp.float32

    def nrm(k, shape, scale):
        return jax.random.normal(k, shape, f32) * scale

    x = nrm(ks[0], (BATCH, SEQ, D_MODEL), 1.0)
    c = nrm(ks[1], (BATCH, D_MODEL), 1.0)
    positions = jnp.broadcast_to(jnp.arange(SEQ, dtype=jnp.int32), (BATCH, SEQ))
    lb_logits = nrm(ks[2], (DEPTH, HG_QK), 0.5)
    w_ada = nrm(ks[3], (DEPTH, D_MODEL, 6 * D_MODEL), ADA_SCALE * D_MODEL ** -0.5)
    b_ada = nrm(ks[4], (DEPTH, 6 * D_MODEL), 0.01)
    w_in = nrm(ks[5], (DEPTH, D_MODEL, IN_WIDTH), D_MODEL ** -0.5)
    w_pa = nrm(ks[6], (DEPTH, HG_WIDTH, D_MODEL), HG_WIDTH ** -0.5)
    w_pb = nrm(ks[7], (DEPTH, RET_WIDTH, D_MODEL), RET_WIDTH ** -0.5)
    w_o = nrm(ks[8], (DEPTH, D_MODEL, D_MODEL), DEEPNORM_BETA * D_MODEL ** -0.5)
    ln1_g = 1.0 + nrm(ks[9], (DEPTH, D_MODEL), 0.02)
    ln1_b = nrm(ks[10], (DEPTH, D_MODEL), 0.02)
    w_up = nrm(ks[11], (DEPTH, D_MODEL, D_FF), D_MODEL ** -0.5)
    b_up = nrm(ks[12], (DEPTH, D_FF), 0.02)
    w_down = nrm(ks[13], (DEPTH, D_FF, D_MODEL), DEEPNORM_BETA * D_FF ** -0.5)
    b_down = nrm(ks[14], (DEPTH, D_MODEL), 0.02)
    ln2_g = 1.0 + nrm(ks[15], (DEPTH, D_MODEL), 0.02)
    ln2_b = nrm(ks[16], (DEPTH, D_MODEL), 0.02)
    return {"x": x, "c": c, "positions": positions, "lb_logits": lb_logits,
            "w_ada": w_ada, "b_ada": b_ada, "w_in": w_in, "w_pa": w_pa, "w_pb": w_pb,
            "w_o": w_o, "ln1_g": ln1_g, "ln1_b": ln1_b, "w_up": w_up, "b_up": b_up,
            "w_down": w_down, "b_down": b_down, "ln2_g": ln2_g, "ln2_b": ln2_b}


def reference(x, c, positions, lb_logits, w_ada, b_ada, w_in, w_pa, w_pb, w_o,
              ln1_g, ln1_b, w_up, b_up, w_down, b_down, ln2_g, ln2_b):
    lb_cum = jnp.cumsum(jax.nn.softmax(lb_logits.astype(jnp.float32), axis=0), axis=0)
    lower_bounds = lb_cum - lb_cum[:1]
    split_at = np.cumsum(IN_SIZES)[:-1].tolist()
    cond = jax.nn.silu(c)
    for l in range(DEPTH):
        mod = cond @ w_ada[l] + b_ada[l]
        shift1, scale1, gate1, shift2, scale2, gate2 = jnp.split(mod[:, None, :], 6, axis=-1)
        u = x * (1.0 + scale1) + shift1
        hq, hf, hi, hg, rq, rk, rv, rg, ga, gb = jnp.split(u @ w_in[l], split_at, axis=-1)
        ya = _hgrn2(hq, hf, hi, hg, lower_bounds[l]) @ w_pa[l]
        yb = _retention(rq, rk, rv, rg, positions) @ w_pb[l]
        y = (jax.nn.sigmoid(ga) * ya + jax.nn.sigmoid(gb) * yb) @ w_o[l]
        x = _layer_norm(DEEPNORM_ALPHA * x + (1.0 + gate1) * y, ln1_g[l], ln1_b[l])
        u = x * (1.0 + scale2) + shift2
        h = jnp.square(jax.nn.relu(u @ w_up[l] + b_up[l]))
        y = h @ w_down[l] + b_down[l]
        x = _layer_norm(DEEPNORM_ALPHA * x + (1.0 + gate2) * y, ln2_g[l], ln2_b[l])
    return x
```

```cpp
#include <hip/hip_runtime.h>
#include <hip/hip_cooperative_groups.h>
#include <cstdio>
namespace cg = cooperative_groups;
__device__ __forceinline__ int otid(int wv) { int t = (wv << 6) | (int)__builtin_amdgcn_mbcnt_hi(~0u, __builtin_amdgcn_mbcnt_lo(~0u, 0u)); asm volatile("" : "+v"(t)); return t; }
__device__ __forceinline__ int obid() { int t = blockIdx.x; asm volatile("" : "+s"(t)); return t; }
template <class T> __device__ __forceinline__ T* oaddr(T* q) { asm volatile("" : "+s"(q)); return q; }
namespace pg8 {
#define PG8_LAS __attribute__((address_space(3)))
typedef unsigned short bf16_t;
typedef short bf16x8 __attribute__((ext_vector_type(8)));
typedef float f32x4 __attribute__((ext_vector_type(4)));
typedef unsigned u32x4 __attribute__((ext_vector_type(4)));
constexpr int BM = 256, BK = 64, HALF = 128, HTB = HALF * BK * 2  , STAGE_BYTES = 8 * HTB, NXCD = 8, WGM = 8;

__host__ __device__ __forceinline__ int lds_byte(int r, int c) { const int st = (r >> 4) * 2 + (c >> 5), rr = r & 15, cc = c & 31, ob = rr * 64 + cc * 2; return st * 1024 + (ob ^ (((ob >> 9) & 1) << 5)); }
__host__ __device__ __forceinline__ void stage_rc(int b, int& R, int& C) { const int st = b / 1024, sb = b % 1024, swz = sb ^ (((sb >> 9) & 1) << 5); R = (st >> 1) * 16 + swz / 64; C = (st & 1) * 32 + (swz % 64) / 2; }
__host__ __device__ __forceinline__ int perm32(int rho) { const int n = rho >> 4, i = rho & 15; return 8 * (i >> 2) + 4 * n + (i & 3); }

struct Unit { int pm, pn; };
struct Gemm { const bf16_t* A; const bf16_t* Bt; int M, N, K; };

struct StaticOrder {
    int nM, nN, nwg, G, c;
    __host__ __device__ void init(int M, int N, int G_, int c_) { nM = M / BM; nN = N / BM; nwg = nM * nN; G = G_; c = c_; }
    __host__ __device__ bool next(int i, Unit& u) const {
        const long L = (long)i * G + c; if (L >= nwg) return false;
        int wgid = (int)L; { const int q = nwg / NXCD, r = nwg % NXCD, xcd = wgid % NXCD, off = wgid / NXCD; wgid = (xcd < r ? xcd * (q + 1) : r * (q + 1) + (xcd - r) * q) + off; }
        const int nig = WGM * nN, gid = wgid / nig, fm = gid * WGM, gsz = (nM - fm) < WGM ? (nM - fm) : WGM;
        u.pm = fm + ((wgid % nig) % gsz); u.pn = (wgid % nig) / gsz; return true;
    }
    __device__ __forceinline__ void a_ready(const Unit&) const {}
    __device__ __forceinline__ void done(const Unit&) const {}
};
__device__ __forceinline__ unsigned cvt_pk_bf16(float lo, float hi) { unsigned r; asm volatile("v_cvt_pk_bf16_f32 %0, %1, %2" : "=v"(r) : "v"(lo), "v"(hi)); return r; }

template <class Epi, class Sched, bool STAMP = false>
__device__ __forceinline__ void gemm_phase(PG8_LAS unsigned char* lds, const Gemm g, const Sched& S, const Epi& E, unsigned long long* stamps) {
    const int tid = otid(E.pp->wv), wid = __builtin_amdgcn_readfirstlane(tid >> 6), lane = tid & 63, wr = wid >> 2, wc = wid & 3, fr = lane & 15, fq = lane >> 4;
    const int K = g.K, nt = K / BK;
    int ts_lo = 0, ts_hi = 0, nts = 0; const unsigned long long rt_entry = STAMP ? (unsigned long long)wall_clock64() : 0ull;
#define PG8_STAMP() do { if (STAMP && wid == 0 && nts < 64) { const unsigned long long _c = (unsigned long long)clock64(); \
        ts_lo = (lane == nts) ? (int)(unsigned)_c : ts_lo; ts_hi = (lane == nts) ? (int)(unsigned)(_c >> 32) : ts_hi; ++nts; } } while (0)
    PG8_STAMP();
    unsigned voffA[2], voffB[2];
#pragma unroll
    for (int i = 0; i < 2; ++i) { int R, C; stage_rc(tid * 16 + i * 8192, R, C); const int Rb = Epi::PERM ? ((R & ~31) + perm32(R & 31)) : R;
        voffA[i] = (unsigned)(R * K + C) * 2u; voffB[i] = (unsigned)(Rb * K + C) * 2u; }
    const size_t kstep = (size_t)(BK * 2);
    const size_t hstep = (size_t)HALF * K * 2;
    const size_t tstep = 2 * hstep;
    const unsigned ldsw = (unsigned)wid * 1024u;
    const int aoff = lds_byte(wr * 64 + fr, fq * 8), boff = lds_byte(wc * 32 + fr, fq * 8);
#define PG8_SA(b, h) (((b) * 2 + (h)) * HTB)
#define PG8_SB(b, h) ((4 + (b) * 2 + (h)) * HTB)
#define PG8_STAGE(bufoff, gbase, voff) do { _Pragma("unroll") for (int _i = 0; _i < 2; ++_i) \
        __builtin_amdgcn_global_load_lds((const unsigned*)((const char*)(gbase) + (voff)[_i]), (PG8_LAS unsigned*)(lds + (bufoff) + ldsw + _i * 8192), 16, 0, 0); } while (0)
#define PG8_LDA(dst, b, h) do { _Pragma("unroll") for (int m = 0; m < 4; ++m) _Pragma("unroll") for (int k = 0; k < 2; ++k) dst[m][k] = *(const PG8_LAS bf16x8*)(lds + PG8_SA(b, h) + aoff + m * 2048 + k * 1024); } while (0)
#define PG8_LDB(dst, b, h) do { _Pragma("unroll") for (int n = 0; n < 2; ++n) _Pragma("unroll") for (int k = 0; k < 2; ++k) dst[n][k] = *(const PG8_LAS bf16x8*)(lds + PG8_SB(b, h) + boff + n * 2048 + k * 1024); } while (0)
#define PG8_MMA(ai, bj, At, Bt) do { __builtin_amdgcn_s_setprio(1); _Pragma("unroll") for (int m = 0; m < 4; ++m) _Pragma("unroll") for (int n = 0; n < 2; ++n) _Pragma("unroll") for (int k = 0; k < 2; ++k) \
        acc[ai][bj][m][n] = __builtin_amdgcn_mfma_f32_16x16x32_bf16(Bt[n][k], At[m][k], acc[ai][bj][m][n], 0, 0, 0); __builtin_amdgcn_s_setprio(0); } while (0)
#define PG8_WAIT_V(n) asm volatile("s_waitcnt vmcnt(" #n ")" ::: "memory")
#define PG8_WAIT_L(n) asm volatile("s_waitcnt lgkmcnt(" #n ")" ::: "memory")
#define PG8_BAR __builtin_amdgcn_s_barrier()
#define PG8_SCHED __builtin_amdgcn_sched_barrier(0)
    Unit cur, nxt; int ui = 0;
    if (!S.next(0, cur)) return;
    f32x4 acc[2][2][4][2];
#pragma unroll
    for (int a = 0; a < 2; ++a)
#pragma unroll
        for (int b = 0; b < 2; ++b)
#pragma unroll
            for (int m = 0; m < 4; ++m)
#pragma unroll
                for (int n = 0; n < 2; ++n) acc[a][b][m][n] = (f32x4){0.f, 0.f, 0.f, 0.f};
    bf16x8 At[4][2], B0[2][2], B1[2][2];
    const char* cA = (const char*)g.A + (size_t)cur.pm * tstep; const char* cB = (const char*)g.Bt + (size_t)cur.pn * tstep;
    S.a_ready(cur);
    PG8_STAGE(PG8_SB(0, 0), cB, voffB); PG8_STAGE(PG8_SA(0, 0), cA, voffA); PG8_STAGE(PG8_SB(0, 1), cB + hstep, voffB); PG8_STAGE(PG8_SA(0, 1), cA + hstep, voffA);
    if (wr == 1) PG8_BAR;
    PG8_WAIT_V(4); PG8_BAR;
    PG8_STAGE(PG8_SB(1, 0), cB + kstep, voffB); PG8_STAGE(PG8_SA(1, 0), cA + kstep, voffA); PG8_STAGE(PG8_SB(1, 1), cB + hstep + kstep, voffB);
    PG8_WAIT_V(6); PG8_BAR;
    PG8_STAMP();
    for (;;) {
        const bool has_next = S.next(ui + 1, nxt);
        const char* nA = has_next ? (const char*)g.A + (size_t)nxt.pm * tstep : cA; const char* nB = has_next ? (const char*)g.Bt + (size_t)nxt.pn * tstep : cB;
        for (int t = 0; t < nt; t += 2) {
            const bool last = (t == nt - 2);
            const char* a1 = cA + (size_t)(t + 1) * kstep;
            const char* a2 = last ? nA : cA + (size_t)(t + 2) * kstep; const char* b2 = last ? nB : cB + (size_t)(t + 2) * kstep;
            const char* a3 = a2 + kstep; const char* b3 = b2 + kstep;
            if (last && has_next) S.a_ready(nxt);
            PG8_LDB(B0, 0, 0); PG8_SCHED; PG8_LDA(At, 0, 0); PG8_STAGE(PG8_SA(1, 1), a1 + hstep, voffA);
            PG8_WAIT_L(8); PG8_BAR; PG8_WAIT_L(0); PG8_MMA(0, 0, At, B0); PG8_BAR; PG8_SCHED;
            PG8_LDB(B1, 0, 1); PG8_STAGE(PG8_SB(0, 0), b2, voffB);
            PG8_BAR; PG8_WAIT_L(0); PG8_MMA(0, 1, At, B1); PG8_BAR;
            PG8_LDA(At, 0, 1); PG8_STAGE(PG8_SA(0, 0), a2, voffA);
            PG8_BAR; PG8_WAIT_L(0); PG8_MMA(1, 0, At, B0); PG8_BAR; PG8_SCHED;
            PG8_STAGE(PG8_SB(0, 1), b2 + hstep, voffB);
            PG8_WAIT_V(6); PG8_BAR; PG8_MMA(1, 1, At, B1); PG8_BAR;
            PG8_LDB(B0, 1, 0); PG8_SCHED; PG8_LDA(At, 1, 0); PG8_STAGE(PG8_SA(0, 1), a2 + hstep, voffA);
            PG8_WAIT_L(8); PG8_BAR; PG8_WAIT_L(0); PG8_MMA(0, 0, At, B0); PG8_BAR; PG8_SCHED;
            PG8_LDB(B1, 1, 1); PG8_STAGE(PG8_SB(1, 0), b3, voffB);
            PG8_BAR; PG8_WAIT_L(0); PG8_MMA(0, 1, At, B1); PG8_BAR;
            PG8_LDA(At, 1, 1); PG8_STAGE(PG8_SA(1, 0), a3, voffA);
            PG8_BAR; PG8_WAIT_L(0); PG8_MMA(1, 0, At, B0); PG8_BAR; PG8_SCHED;
            PG8_STAGE(PG8_SB(1, 1), b3 + hstep, voffB);
            PG8_WAIT_V(6); PG8_BAR; PG8_MMA(1, 1, At, B1); PG8_BAR;
        }
        PG8_STAMP();
        if constexpr (!Epi::AFTER_DRAIN) { E(acc, cur, wr, wc, fr, fq); S.done(cur); }
        PG8_STAMP();
        if (!has_next) break;
#pragma unroll
        for (int a = 0; a < 2; ++a)
#pragma unroll
            for (int b = 0; b < 2; ++b)
#pragma unroll
                for (int m = 0; m < 4; ++m)
#pragma unroll
                    for (int n = 0; n < 2; ++n) acc[a][b][m][n] = (f32x4){0.f, 0.f, 0.f, 0.f};
        cur = nxt; cA = nA; cB = nB; ++ui;
    }
    PG8_WAIT_V(0);
    if (wr == 0) PG8_BAR;
    PG8_BAR;
    if constexpr (Epi::AFTER_DRAIN) { E.fused(acc, cur, wr, wc, fr, fq, lds, wid, lane); S.done(cur); }
    PG8_STAMP();
    if (STAMP && wid == 0) { stamps[lane] = lane < nts ? (((unsigned long long)(unsigned)ts_hi << 32) | (unsigned)ts_lo) : 0ull;
        if (lane == 62) stamps[62] = rt_entry; if (lane == 63) stamps[63] = (unsigned long long)wall_clock64(); }
#undef PG8_STAMP
#undef PG8_SA
#undef PG8_SB
#undef PG8_STAGE
#undef PG8_LDA
#undef PG8_LDB
#undef PG8_MMA
#undef PG8_WAIT_V
#undef PG8_WAIT_L
#undef PG8_BAR
#undef PG8_SCHED
}
}
using pg8::bf16_t; using pg8::bf16x8; using pg8::f32x4; using pg8::u32x4; using pg8::Unit;
typedef unsigned u32x2 __attribute__((ext_vector_type(2)));
#define LAS __attribute__((address_space(3)))
typedef LAS unsigned char* ldsp;

constexpr int T_ALL = 32768, TG = 16384, DM = 1024, SEQ = 4096;
constexpr float ALPHA = 1.4142135623730951f;
constexpr size_t MB = 1024ull * 1024ull;
constexpr size_t OFF_XB = 0, OFF_WB = 128 * MB, OFF_U = 184 * MB, OFF_SMALL = 248 * MB, OFF_R0 = 256 * MB;
constexpr size_t W1A = 0, W1S = W1A + 4096ull * 1024, W1B = W1S + 4096ull * 1024, WPA = W1B + 5120ull * 1024, WPB = WPA + 1024ull * 1024,
                 WO = WPB + 1024ull * 2048, WUP = WO + 1024ull * 1024, WDN = WUP + 4096ull * 1024, W_END = WDN + 4096ull * 1024;
static_assert(W_END * 2 <= 56 * MB, "weights");
constexpr size_t SM_MOD = 0  , SM_LB = 2 * 8 * 6144  , SM_STR = SM_LB + 2048  , SM_STH = SM_STR + (size_t)TG * 8  , SM_END = SM_STH + (size_t)TG * 8;
static_assert(SM_END * 4 <= 8 * MB, "small");
constexpr size_t R_QH = 0, R_VIT = 32 * MB, R_QR = 64 * MB, R_KR = 96 * MB, R_KRT = 128 * MB, R_ORA = 160 * MB, R_ORB = 192 * MB;
constexpr size_t R_SGA = R_QH, R_SGB = R_VIT, R_M1 = R_QR, R_MG = R_KRT;
constexpr size_t D_LF = 0, D_VRT = 64 * MB;

struct Params {
  const float* x; const float* c; const int* pos; const float* lb_logits; const float* w_ada; const float* b_ada; const float* w_in; const float* w_pa; const float* w_pb;
  const float* w_o; const float* ln1_g; const float* ln1_b; const float* w_up; const float* b_up; const float* w_down; const float* b_down; const float* ln2_g; const float* ln2_b;
  float* out; unsigned char* ws; int wv; int pad;
};

__device__ __forceinline__ float bf2f(unsigned short b) { return __uint_as_float(((unsigned)b) << 16); }
__device__ __forceinline__ float bflo(unsigned u) { return __uint_as_float(u << 16); }
__device__ __forceinline__ float bfhi(unsigned u) { return __uint_as_float(u & 0xffff0000u); }
__device__ __forceinline__ unsigned pk2(float lo, float hi) { return pg8::cvt_pk_bf16(lo, hi); }
__device__ __forceinline__ float sigmoidf_(float v) { return 1.0f / (1.0f + __expf(-v)); }
__device__ __forceinline__ float siluf_(float v) { return v * sigmoidf_(v); }
__device__ __forceinline__ f32x4 mfma16(bf16x8 a, bf16x8 b, f32x4 c) { return __builtin_amdgcn_mfma_f32_16x16x32_bf16(a, b, c, 0, 0, 0); }
__device__ __forceinline__ bf16x8 ldfrag(ldsp base, int off) { return *(const LAS bf16x8*)(base + off); }
__device__ __forceinline__ float shx(float v, int mask, int lane) { return __int_as_float(__builtin_amdgcn_ds_bpermute((lane ^ mask) << 2, __float_as_int(v))); }
__device__ __forceinline__ float wave_sum(float v, int lane) {
#pragma unroll
  for (int o = 32; o > 0; o >>= 1) v += shx(v, o, lane);
  return v;
}

enum { MD_G1A = 0, MD_G1S, MD_G1B, MD_G2A, MD_G2B, MD_G3, MD_G4, MD_G5 };
struct EpiP {
  static constexpr bool PERM = true, AFTER_DRAIN = false;
  int mode, l, g;
  const Params* pp;
  template <int MODE, int ai, int m> __device__ __forceinline__ void rowf(const f32x4 (&acc)[2][2][4][2], const Unit& u, int wr, int wc, int fr, int fq) const {
    const Params& p = *pp;
    unsigned char* R0 = p.ws + OFF_R0; unsigned char* DO = (unsigned char*)p.out;
    float* small = (float*)(p.ws + OFF_SMALL);
    const float* mod = small + SM_MOD + (size_t)l * 8 * 6144;
      {
        const int row = u.pm * 256 + ai * 128 + wr * 64 + m * 16 + fr;
#pragma unroll
        for (int bj = 0; bj < 2; ++bj) {
          const int col = u.pn * 256 + bj * 128 + wc * 32 + 8 * fq;
          float v[8];
#pragma unroll
          for (int i = 0; i < 4; ++i) { v[i] = acc[ai][bj][m][0][i]; v[4 + i] = acc[ai][bj][m][1][i]; }
          if constexpr (MODE == MD_G1A) {
            const int sec = col >> 10, cs = col & 1023;
            if (sec == 0) {
              u32x4 o;
#pragma unroll
              for (int i = 0; i < 4; ++i) o[i] = pk2(siluf_(v[2 * i]), siluf_(v[2 * i + 1]));
              *(u32x4*)(R0 + R_QH + ((size_t)row * 1024 + cs) * 2) = o;
            } else if (sec == 1) {
              const float* lbp = small + SM_LB + l * 1024 + cs;
              const f32x4 l0 = *(const f32x4*)lbp, l1 = *(const f32x4*)(lbp + 4);
              float o[8];
#pragma unroll
              for (int i = 0; i < 8; ++i) {
                const float lbv = i < 4 ? l0[i & 3] : l1[i & 3];
                const float z = v[i];
                const float ls = fminf(z, 0.f) - log1pf(__expf(-fabsf(z)));
                const float f = lbv + (1.f - lbv) * sigmoidf_(z);
                o[i] = (lbv == 0.f) ? ls : __logf(f);
              }
              float* dst = (float*)(DO + D_LF) + (size_t)row * 1024 + cs;
              *(f32x4*)dst = (f32x4){o[0], o[1], o[2], o[3]}; *(f32x4*)(dst + 4) = (f32x4){o[4], o[5], o[6], o[7]};
            } else {
              const float posf = (float)p.pos[g * TG + row];
              const float sc = sec == 3 ? 0.0625f : 1.0f;
              const int p0 = (cs & 255) >> 1;
              u32x4 o;
#pragma unroll
              for (int i = 0; i < 4; ++i) {
                const float theta = __builtin_amdgcn_exp2f(-13.287712379549449f * (float)(p0 + i) * (1.0f / 127.0f));
                float rev = posf * theta * 0.15915494309189535f; rev -= floorf(rev);
                const float sn = __builtin_amdgcn_sinf(rev), cn = __builtin_amdgcn_cosf(rev);
                const float t1 = v[2 * i], t2 = v[2 * i + 1];
                o[i] = pk2((t1 * cn - t2 * sn) * sc, (t1 * sn + t2 * cn) * sc);
              }
              *(u32x4*)(R0 + (sec == 2 ? R_QR : R_KR) + ((size_t)row * 1024 + cs) * 2) = o;
            }
          } else if constexpr (MODE == MD_G1S) {
            const int sec = row >> 10;
            if (sec == 0) {
              u32x4 o;
#pragma unroll
              for (int i = 0; i < 4; ++i) o[i] = pk2(v[2 * i], v[2 * i + 1]);
              *(u32x4*)(R0 + R_VIT + ((size_t)row * TG + col) * 2) = o;
            } else if (sec == 1) {
              const int f = row - 1024;
              const float theta = __builtin_amdgcn_exp2f(-13.287712379549449f * (float)((f & 255) >> 1) * (1.0f / 127.0f));
              const bool odd = (f & 1) != 0;
              const int* pp_ = p.pos + g * TG + col;
              float o[8];
#pragma unroll
              for (int i = 0; i < 8; ++i) {
                const float pv = shx(v[i], 1, (fq << 4) | fr);
                float rev = (float)pp_[i] * theta * 0.15915494309189535f; rev -= floorf(rev);
                const float sn = __builtin_amdgcn_sinf(rev), cn = __builtin_amdgcn_cosf(rev);
                o[i] = (odd ? (pv * sn + v[i] * cn) : (v[i] * cn - pv * sn)) * 0.0625f;
              }
              u32x4 ov;
#pragma unroll
              for (int i = 0; i < 4; ++i) ov[i] = pk2(o[2 * i], o[2 * i + 1]);
              *(u32x4*)(R0 + R_KRT + ((size_t)f * TG + col) * 2) = ov;
            } else {
              const int f = row - 2048, h = f >> 9;
              const float lg2 = __log2f(1.0f - __builtin_amdgcn_exp2f(-5.0f - (float)h));
              float o[8];
#pragma unroll
              for (int i = 0; i < 8; ++i) o[i] = v[i] * __builtin_amdgcn_exp2f(lg2 * (float)(63 - ((col + i) & 63)));
              u32x4 ov;
#pragma unroll
              for (int i = 0; i < 4; ++i) ov[i] = pk2(o[2 * i], o[2 * i + 1]);
              *(u32x4*)(DO + D_VRT + ((size_t)f * TG + col) * 2) = ov;
            }
          } else if constexpr (MODE == MD_G1B) {
            const int sec = col >> 10, cs = col & 1023;
            if (sec == 0) {
              const float ss = (small + SM_STH)[(size_t)row * 8 + (cs >> 7)];
              const float rstd = rsqrtf(ss * (1.0f / 128.0f) + 1e-6f);
              u32x4* ptr = (u32x4*)(R0 + R_ORA + ((size_t)row * 1024 + cs) * 2);
              const u32x4 ov = *ptr; u32x4 o;
#pragma unroll
              for (int i = 0; i < 4; ++i) o[i] = pk2(bflo(ov[i]) * rstd * siluf_(v[2 * i]), bfhi(ov[i]) * rstd * siluf_(v[2 * i + 1]));
              *ptr = o;
            } else if (sec < 3) {
              const int c2 = col - 1024;
              const float* st = small + SM_STR + ((size_t)row * 4 + (c2 >> 9)) * 2;
              const float mean = st[0] * (1.0f / 512.0f);
              const float var = fmaxf(st[1] * (1.0f / 512.0f) - mean * mean, 0.f);
              const float rstd = rsqrtf(var + 1e-6f);
              u32x4* ptr = (u32x4*)(R0 + R_ORB + ((size_t)row * 2048 + c2) * 2);
              const u32x4 ov = *ptr; u32x4 o;
#pragma unroll
              for (int i = 0; i < 4; ++i) o[i] = pk2((bflo(ov[i]) - mean) * rstd * siluf_(v[2 * i]), (bfhi(ov[i]) - mean) * rstd * siluf_(v[2 * i + 1]));
              *ptr = o;
            } else {
              u32x4 o;
#pragma unroll
              for (int i = 0; i < 4; ++i) o[i] = pk2(sigmoidf_(v[2 * i]), sigmoidf_(v[2 * i + 1]));
              *(u32x4*)(R0 + (sec == 3 ? R_SGA : R_SGB) + ((size_t)row * 1024 + cs) * 2) = o;
            }
          } else if constexpr (MODE == MD_G2A) {
            const u32x4 gv = *(const u32x4*)(R0 + R_SGA + ((size_t)row * 1024 + col) * 2);
            float* dst = (float*)(R0 + R_M1) + (size_t)row * 1024 + col;
            *(f32x4*)dst = (f32x4){bflo(gv[0]) * v[0], bfhi(gv[0]) * v[1], bflo(gv[1]) * v[2], bfhi(gv[1]) * v[3]};
            *(f32x4*)(dst + 4) = (f32x4){bflo(gv[2]) * v[4], bfhi(gv[2]) * v[5], bflo(gv[3]) * v[6], bfhi(gv[3]) * v[7]};
          } else if constexpr (MODE == MD_G2B) {
            const u32x4 gv = *(const u32x4*)(R0 + R_SGB + ((size_t)row * 1024 + col) * 2);
            const float* src = (const float*)(R0 + R_M1) + (size_t)row * 1024 + col;
            const f32x4 m0 = *(const f32x4*)src, m1 = *(const f32x4*)(src + 4);
            u32x4 o;
            o[0] = pk2(m0[0] + bflo(gv[0]) * v[0], m0[1] + bfhi(gv[0]) * v[1]);
            o[1] = pk2(m0[2] + bflo(gv[1]) * v[2], m0[3] + bfhi(gv[1]) * v[3]);
            o[2] = pk2(m1[0] + bflo(gv[2]) * v[4], m1[1] + bfhi(gv[2]) * v[5]);
            o[3] = pk2(m1[2] + bflo(gv[3]) * v[6], m1[3] + bfhi(gv[3]) * v[7]);
            *(u32x4*)(R0 + R_MG + ((size_t)row * 1024 + col) * 2) = o;
          } else if constexpr (MODE == MD_G3) {
            const int tg = g * TG + row, b = tg >> 12;
            const float* xin = (l == 0 ? p.x : (const float*)(p.ws + OFF_XB)) + (size_t)tg * 1024 + col;
            const float* gt = mod + (size_t)b * 6144 + 2 * 1024 + col;
            const f32x4 x0 = *(const f32x4*)xin, x1 = *(const f32x4*)(xin + 4), g0 = *(const f32x4*)gt, g1 = *(const f32x4*)(gt + 4);
            float* dst = (float*)(p.ws + OFF_XB) + (size_t)tg * 1024 + col;
            f32x4 o0, o1;
#pragma unroll
            for (int i = 0; i < 4; ++i) { o0[i] = ALPHA * x0[i] + (1.f + g0[i]) * v[i]; o1[i] = ALPHA * x1[i] + (1.f + g1[i]) * v[4 + i]; }
            *(f32x4*)dst = o0; *(f32x4*)(dst + 4) = o1;
          } else if constexpr (MODE == MD_G4) {
            const float* bp = p.b_up + (size_t)l * 4096 + col;
            const f32x4 b0 = *(const f32x4*)bp, b1 = *(const f32x4*)(bp + 4);
            float o[8];
#pragma unroll
            for (int i = 0; i < 8; ++i) { const float hh = fmaxf(v[i] + (i < 4 ? b0[i & 3] : b1[i & 3]), 0.f); o[i] = hh * hh; }
            u32x4 ov;
#pragma unroll
            for (int i = 0; i < 4; ++i) ov[i] = pk2(o[2 * i], o[2 * i + 1]);
            *(u32x4*)(R0 + ((size_t)row * 4096 + col) * 2) = ov;
          } else if constexpr (MODE == MD_G5) {
            const int b = row >> 12;
            float* dst = (float*)(p.ws + OFF_XB) + (size_t)row * 1024 + col;
            const float* gt = mod + (size_t)b * 6144 + 5 * 1024 + col;
            const float* bp = p.b_down + (size_t)l * 1024 + col;
            const f32x4 x0 = *(const f32x4*)dst, x1 = *(const f32x4*)(dst + 4), g0 = *(const f32x4*)gt, g1 = *(const f32x4*)(gt + 4), b0 = *(const f32x4*)bp, b1 = *(const f32x4*)(bp + 4);
            f32x4 o0, o1;
#pragma unroll
            for (int i = 0; i < 4; ++i) { o0[i] = ALPHA * x0[i] + (1.f + g0[i]) * (v[i] + b0[i]); o1[i] = ALPHA * x1[i] + (1.f + g1[i]) * (v[4 + i] + b1[i]); }
            *(f32x4*)dst = o0; *(f32x4*)(dst + 4) = o1;
          }
        }
      }
  }
  template <int MODE> __device__ __forceinline__ void run(const f32x4 (&acc)[2][2][4][2], const Unit& u, int wr, int wc, int fr, int fq) const {
    #define RW(a, b) rowf<MODE, a, b>(acc, u, wr, wc, fr, fq); __builtin_amdgcn_sched_barrier(0);
    RW(0, 0) RW(0, 1) RW(0, 2) RW(0, 3) RW(1, 0) RW(1, 1) RW(1, 2) RW(1, 3)
#undef RW
  }
  __device__ __forceinline__ void operator()(const f32x4 (&acc)[2][2][4][2], const Unit& u, int wr, int wc, int fr, int fq) const {
    switch (mode) {
      case MD_G1A: run<MD_G1A>(acc, u, wr, wc, fr, fq); break;
      case MD_G1S: run<MD_G1S>(acc, u, wr, wc, fr, fq); break;
      case MD_G1B: run<MD_G1B>(acc, u, wr, wc, fr, fq); break;
      case MD_G2A: run<MD_G2A>(acc, u, wr, wc, fr, fq); break;
      case MD_G2B: run<MD_G2B>(acc, u, wr, wc, fr, fq); break;
      case MD_G3: run<MD_G3>(acc, u, wr, wc, fr, fq); break;
      case MD_G4: run<MD_G4>(acc, u, wr, wc, fr, fq); break;
      default: run<MD_G5>(acc, u, wr, wc, fr, fq); break;
    }
  }
};
__device__ __forceinline__ void conv_job(ldsp lds, int wv, const float* src, int ld, int K, int c0, int ncols, bf16_t* dst) {
  LAS float* tile = (LAS float*)lds;
  const int tid = otid(wv), ntk = K >> 6, ntn = ncols >> 6, nt = ntk * ntn;
  for (int t = obid(); t < nt; t += gridDim.x) {
    const int tk = t / ntn, tn = t - tk * ntn, k0 = tk << 6, n0 = tn << 6;
    __syncthreads();
#pragma unroll
    for (int i = 0; i < 8; ++i) { const int r = i * 8 + (tid >> 6), cc = tid & 63; tile[r * 65 + cc] = src[(size_t)(k0 + r) * ld + c0 + n0 + cc]; }
    __syncthreads();
    const int kp = tid & 31, nn = tid >> 5;
#pragma unroll
    for (int i = 0; i < 4; ++i) { const int n = nn + 16 * i; *(unsigned*)(dst + (size_t)(n0 + n) * K + k0 + 2 * kp) = pk2(tile[(2 * kp) * 65 + n], tile[(2 * kp + 1) * 65 + n]); }
  }
  __syncthreads();
}
__device__ __forceinline__ void phase_conv(ldsp lds, const Params& p, int l) {
  bf16_t* WB = (bf16_t*)(p.ws + OFF_WB);
  const float* win = p.w_in + (size_t)l * 1024 * 12288;
  conv_job(lds, p.wv, win, 12288, 1024, 0, 1024, WB + W1A);
  conv_job(lds, p.wv, win, 12288, 1024, 1024, 1024, WB + W1A + 1024ull * 1024);
  conv_job(lds, p.wv, win, 12288, 1024, 4096, 2048, WB + W1A + 2048ull * 1024);
  conv_job(lds, p.wv, win, 12288, 1024, 2048, 1024, WB + W1S);
  conv_job(lds, p.wv, win, 12288, 1024, 5120, 3072, WB + W1S + 1024ull * 1024);
  conv_job(lds, p.wv, win, 12288, 1024, 3072, 1024, WB + W1B);
  conv_job(lds, p.wv, win, 12288, 1024, 8192, 4096, WB + W1B + 1024ull * 1024);
  conv_job(lds, p.wv, p.w_pa + (size_t)l * 1024 * 1024, 1024, 1024, 0, 1024, WB + WPA);
  conv_job(lds, p.wv, p.w_pb + (size_t)l * 2048 * 1024, 1024, 2048, 0, 1024, WB + WPB);
  conv_job(lds, p.wv, p.w_o + (size_t)l * 1024 * 1024, 1024, 1024, 0, 1024, WB + WO);
  conv_job(lds, p.wv, p.w_up + (size_t)l * 1024 * 4096, 4096, 1024, 0, 4096, WB + WUP);
  conv_job(lds, p.wv, p.w_down + (size_t)l * 4096 * 1024, 1024, 4096, 0, 1024, WB + WDN);
}
__device__ __forceinline__ void phase_mod(ldsp lds, const Params& p) {
  float* small = (float*)(p.ws + OFF_SMALL);
  const int tid = otid(p.wv);
  const int bid = obid();
  if (bid < 24) {
    LAS float* cond = (LAS float*)lds;
    for (int i = tid; i < 8192; i += 512) cond[i] = siluf_(p.c[i]);
    __syncthreads();
    const int o = bid * 512 + tid, l = o / 6144, n = o - l * 6144;
    const float* w = p.w_ada + (size_t)l * 1024 * 6144 + n;
    float a[8];
#pragma unroll
    for (int b = 0; b < 8; ++b) a[b] = 0.f;
    for (int k = 0; k < 1024; ++k) {
      const float wv = w[(size_t)k * 6144];
#pragma unroll
      for (int b = 0; b < 8; ++b) a[b] += cond[b * 1024 + k] * wv;
    }
    const float bb = p.b_ada[l * 6144 + n];
#pragma unroll
    for (int b = 0; b < 8; ++b) small[SM_MOD + (size_t)l * 8 * 6144 + b * 6144 + n] = a[b] + bb;
    __syncthreads();
  } else if (bid == 24) {
    for (int i = tid; i < 1024; i += 512) {
      const float a = p.lb_logits[i], b = p.lb_logits[1024 + i], mx = fmaxf(a, b);
      const float ea = __expf(a - mx), eb = __expf(b - mx);
      small[SM_LB + i] = 0.f; small[SM_LB + 1024 + i] = eb / (ea + eb);
    }
  }
}
__device__ __forceinline__ void phase_u0(const Params& p) {
  const float* mod = (const float*)(p.ws + OFF_SMALL) + SM_MOD;
  bf16_t* U = (bf16_t*)(p.ws + OFF_U);
  const size_t n4 = (size_t)T_ALL * 1024 / 4;
  for (size_t i = (size_t)obid() * 512 + otid(p.wv); i < n4; i += (size_t)gridDim.x * 512) {
    const size_t e = i * 4; const int t = (int)(e >> 10), cc = (int)(e & 1023), b = t >> 12;
    const f32x4 xv = *(const f32x4*)(p.x + e), sh = *(const f32x4*)(mod + b * 6144 + cc), sc = *(const f32x4*)(mod + b * 6144 + 1024 + cc);
    u32x2 o; o[0] = pk2(xv[0] * (1.f + sc[0]) + sh[0], xv[1] * (1.f + sc[1]) + sh[1]); o[1] = pk2(xv[2] * (1.f + sc[2]) + sh[2], xv[3] * (1.f + sc[3]) + sh[3]);
    *(u32x2*)(U + e) = o;
  }
}
__device__ __forceinline__ void phase_ln(const Params& p, const float* gam, const float* bet, int lm, int s_shift, bool fin) {
  float* XB = (float*)(p.ws + OFF_XB);
  const float* mod = (const float*)(p.ws + OFF_SMALL) + SM_MOD + (size_t)lm * 8 * 6144;
  bf16_t* U = (bf16_t*)(p.ws + OFF_U);
  const int tid_ = otid(p.wv); const int lane = tid_ & 63, gw = obid() * 8 + (tid_ >> 6), nw = gridDim.x * 8;
  for (int row = gw; row < T_ALL; row += nw) {
    const float* src = XB + (size_t)row * 1024;
    f32x4 v[4]; float s = 0.f;
#pragma unroll
    for (int k = 0; k < 4; ++k) { v[k] = *(const f32x4*)(src + 256 * k + 4 * lane); s += v[k][0] + v[k][1] + v[k][2] + v[k][3]; }
    const float mu = wave_sum(s, lane) * (1.0f / 1024.0f);
    float q = 0.f;
#pragma unroll
    for (int k = 0; k < 4; ++k)
#pragma unroll
      for (int i = 0; i < 4; ++i) { const float d = v[k][i] - mu; q += d * d; }
    const float rstd = rsqrtf(wave_sum(q, lane) * (1.0f / 1024.0f) + 1e-5f);
    const int b = row >> 12;
#pragma unroll
    for (int k = 0; k < 4; ++k) {
      const int cc = 256 * k + 4 * lane;
      const f32x4 gg = *(const f32x4*)(gam + cc), bb = *(const f32x4*)(bet + cc);
      f32x4 y;
#pragma unroll
      for (int i = 0; i < 4; ++i) y[i] = (v[k][i] - mu) * rstd * gg[i] + bb[i];
      if (fin) { *(f32x4*)(p.out + (size_t)row * 1024 + cc) = y; }
      else {
        *(f32x4*)(XB + (size_t)row * 1024 + cc) = y;
        const f32x4 sh = *(const f32x4*)(mod + b * 6144 + s_shift * 1024 + cc), sc = *(const f32x4*)(mod + b * 6144 + (s_shift + 1) * 1024 + cc);
        u32x2 o; o[0] = pk2(y[0] * (1.f + sc[0]) + sh[0], y[1] * (1.f + sc[1]) + sh[1]); o[1] = pk2(y[2] * (1.f + sc[2]) + sh[2], y[3] * (1.f + sc[3]) + sh[3]);
        *(u32x2*)(U + (size_t)row * 1024 + cc) = o;
      }
    }
  }
}
template <class T> __device__ __forceinline__ T* vaddr(T* q) { asm volatile("" : "+v"(q)); return q; }
__device__ __forceinline__ void ret_item(ldsp lds, const Params& p, int item) {
  constexpr int KS = 0, KTS = 33792, VTS = 70656, STS = 79872, PS = 113664;
  const int es = item & 7, h = (item >> 3) & 3, bl = item >> 5;
  const int tid = otid(p.wv), w = tid >> 6, lane = tid & 63, fr = lane & 15, fq = lane >> 4;
  unsigned char* R0 = oaddr(p.ws) + OFF_R0; unsigned char* DO = (unsigned char*)oaddr(p.out);
  const bf16_t* Qr = (const bf16_t*)(R0 + R_QR); const bf16_t* Kr = (const bf16_t*)(R0 + R_KR); const bf16_t* KrT = (const bf16_t*)(R0 + R_KRT);
  const bf16_t* VrT = (const bf16_t*)(DO + D_VRT); bf16_t* OrB = (bf16_t*)(R0 + R_ORB);
  float* stR = (float*)(p.ws + OFF_SMALL) + SM_STR;
  const float gam = 1.0f - __builtin_amdgcn_exp2f(-5.0f - (float)h), lg2 = __log2f(gam), g64 = __builtin_amdgcn_exp2f(lg2 * 64.0f);
  const int it = w >> 1, eh = w & 1;
  f32x4 st[2][4];
#pragma unroll
  for (int a = 0; a < 2; ++a)
#pragma unroll
    for (int b = 0; b < 4; ++b) st[a][b] = (f32x4){0.f, 0.f, 0.f, 0.f};
  const float rowscale = __builtin_amdgcn_exp2f(lg2 * (float)(16 * it + fr - 63));
  for (int n = 0; n < 64; ++n) {
    const int tok0 = bl * SEQ + n * 64;
    u32x4 kreg[4], ktreg[4], vtreg; bf16x8 qf[8];
    const bf16_t* kbase = vaddr(Kr + (size_t)(tok0 + (tid >> 5)) * 1024 + h * 256 + (tid & 31) * 8);
    const bf16_t* ktbase = vaddr(KrT + (size_t)(h * 256 + (tid >> 3)) * TG + tok0 + (tid & 7) * 8);
    const bf16_t* vtbase = vaddr(VrT + (size_t)(h * 512 + es * 64 + (tid >> 3)) * TG + tok0 + (tid & 7) * 8);
    const bf16_t* qbase = vaddr(Qr + (size_t)(tok0 + 16 * it + fr) * 1024 + h * 256 + fq * 8);
    bf16_t* obase = vaddr(OrB + (size_t)(tok0 + 16 * it + fr) * 2048 + h * 512 + es * 64 + 32 * eh + 4 * fq);
    float* sbase = vaddr(stR + ((size_t)(tok0 + 16 * it + fr) * 4 + h) * 2);
#pragma unroll
    for (int i = 0; i < 4; ++i) kreg[i] = *(const u32x4*)(kbase + (size_t)i * 16 * 1024);
#pragma unroll
    for (int i = 0; i < 4; ++i) ktreg[i] = *(const u32x4*)(ktbase + (size_t)i * 64 * TG);
    vtreg = *(const u32x4*)vtbase;
#pragma unroll
    for (int ks = 0; ks < 8; ++ks) qf[ks] = *(const bf16x8*)(qbase + ks * 32);
    __builtin_amdgcn_sched_barrier(0);
#pragma unroll
    for (int dt = 0; dt < 2; ++dt)
#pragma unroll
      for (int et = 0; et < 4; ++et) {
        u32x2 o; o[0] = pk2(st[dt][et][0], st[dt][et][1]); o[1] = pk2(st[dt][et][2], st[dt][et][3]);
        *(LAS u32x2*)(lds + STS + (16 * et + fr) * 528 + (32 * w + 16 * dt + 4 * fq) * 2) = o;
      }
#pragma unroll
    for (int i = 0; i < 4; ++i) { const int c = tid + 512 * i, r = c >> 5, ch = c & 31; *(LAS u32x4*)(lds + KS + r * 528 + ch * 16) = kreg[i]; }
#pragma unroll
    for (int i = 0; i < 4; ++i) { const int c = tid + 512 * i, r = c >> 3, ch = c & 7; *(LAS u32x4*)(lds + KTS + r * 144 + ch * 16) = ktreg[i]; }
    { const int r = tid >> 3, ch = tid & 7; *(LAS u32x4*)(lds + VTS + r * 144 + ch * 16) = vtreg; }
    __syncthreads();
    __builtin_amdgcn_sched_barrier(0);
#pragma unroll
    for (int jj = 0; jj < 2; ++jj) {
      const int jt = 2 * eh + jj;
      f32x4 sc = (f32x4){0.f, 0.f, 0.f, 0.f};
#pragma unroll
      for (int ks = 0; ks < 8; ++ks) sc = mfma16(ldfrag(lds, KS + (16 * jt + fr) * 528 + (32 * ks + 8 * fq) * 2), qf[ks], sc);
      const int i_ = 16 * it + fr, j0 = 16 * jt + 4 * fq;
      u32x2 o; o[0] = pk2(j0 + 0 <= i_ ? sc[0] : 0.f, j0 + 1 <= i_ ? sc[1] : 0.f); o[1] = pk2(j0 + 2 <= i_ ? sc[2] : 0.f, j0 + 3 <= i_ ? sc[3] : 0.f);
      *(LAS u32x2*)(lds + PS + i_ * 144 + j0 * 2) = o;
    }
    __syncthreads();
    __builtin_amdgcn_sched_barrier(0);
    float s1 = 0.f, s2 = 0.f;
#pragma unroll
    for (int ee = 0; ee < 2; ++ee) {
      const int et = 2 * eh + ee;
      f32x4 o = (f32x4){0.f, 0.f, 0.f, 0.f};
#pragma unroll
      for (int k2 = 0; k2 < 2; ++k2) o = mfma16(ldfrag(lds, VTS + (16 * et + fr) * 144 + (32 * k2 + 8 * fq) * 2), ldfrag(lds, PS + (16 * it + fr) * 144 + (32 * k2 + 8 * fq) * 2), o);
#pragma unroll
      for (int ks = 0; ks < 8; ++ks) o = mfma16(ldfrag(lds, STS + (16 * et + fr) * 528 + (32 * ks + 8 * fq) * 2), qf[ks], o);
#pragma unroll
      for (int r = 0; r < 4; ++r) { o[r] *= rowscale; s1 += o[r]; s2 += o[r] * o[r]; }
      u32x2 ov; ov[0] = pk2(o[0], o[1]); ov[1] = pk2(o[2], o[3]);
      *(u32x2*)(obase + 16 * ee) = ov;
    }
    s1 += shx(s1, 16, lane); s1 += shx(s1, 32, lane); s2 += shx(s2, 16, lane); s2 += shx(s2, 32, lane);
    if (fq == 0) { unsafeAtomicAdd(sbase, s1); unsafeAtomicAdd(sbase + 1, s2); }
    __builtin_amdgcn_sched_barrier(0);
#pragma unroll
    for (int k2 = 0; k2 < 2; ++k2) {
      bf16x8 vf[4];
#pragma unroll
      for (int et = 0; et < 4; ++et) vf[et] = ldfrag(lds, VTS + (16 * et + fr) * 144 + (32 * k2 + 8 * fq) * 2);
#pragma unroll
      for (int dt = 0; dt < 2; ++dt) {
        const bf16x8 kf = ldfrag(lds, KTS + (32 * w + 16 * dt + fr) * 144 + (32 * k2 + 8 * fq) * 2);
#pragma unroll
        for (int et = 0; et < 4; ++et) st[dt][et] = mfma16(kf, vf[et], st[dt][et]);
      }
    }
#pragma unroll
    for (int dt = 0; dt < 2; ++dt)
#pragma unroll
      for (int et = 0; et < 4; ++et)
#pragma unroll
        for (int r = 0; r < 4; ++r) st[dt][et][r] *= g64;
    __syncthreads();
  }
}
__device__ __forceinline__ void hgrn_item(ldsp lds, const Params& p, int item) {
  constexpr int QT = 0, KT = 17408, QB = 34816, KBT = 52224, VTS = 70656, STS = 75264, PS = 83968, TOT = 93184, DEC = 97280;
  const int es = item & 3, h = (item >> 2) & 7, bl = item >> 5;
  const int tid = otid(p.wv), w = tid >> 6, lane = tid & 63, fr = lane & 15, fq = lane >> 4;
  unsigned char* R0 = oaddr(p.ws) + OFF_R0; unsigned char* DO = (unsigned char*)oaddr(p.out);
  const bf16_t* Qh = (const bf16_t*)(R0 + R_QH); const float* LF = (const float*)(DO + D_LF); const bf16_t* ViT = (const bf16_t*)(R0 + R_VIT);
  bf16_t* OrA = (bf16_t*)(R0 + R_ORA);
  float* stH = (float*)(p.ws + OFF_SMALL) + SM_STH;
  LAS float* tot = (LAS float*)(lds + TOT); LAS float* dec = (LAS float*)(lds + DEC);
  const int it = w >> 1, eh = w & 1, d0 = 2 * lane;
  f32x4 st[2];
  st[0] = (f32x4){0.f, 0.f, 0.f, 0.f}; st[1] = (f32x4){0.f, 0.f, 0.f, 0.f};
  for (int n = 0; n < 64; ++n) {
    const int tok0 = bl * SEQ + n * 64;
    float lx[8], ly[8]; unsigned q2[8]; u32x4 vtreg;
    const float* lfbase = vaddr(LF + (size_t)(tok0 + 8 * w) * 1024 + h * 128 + d0);
    const bf16_t* qhbase = vaddr(Qh + (size_t)(tok0 + 8 * w) * 1024 + h * 128 + d0);
    const bf16_t* vtbase = vaddr(ViT + (size_t)(h * 128 + es * 32 + ((tid & 255) >> 3)) * TG + tok0 + (tid & 7) * 8);
    bf16_t* obase = vaddr(OrA + (size_t)(tok0 + 16 * it + fr) * 1024 + h * 128 + es * 32 + 16 * eh + 4 * fq);
    float* sbase = vaddr(stH + (size_t)(tok0 + 16 * it + fr) * 8 + h);
#pragma unroll
    for (int jj = 0; jj < 8; ++jj) {
      const float2 t = *(const float2*)(lfbase + (size_t)jj * 1024); lx[jj] = t.x; ly[jj] = t.y; q2[jj] = *(const unsigned*)(qhbase + (size_t)jj * 1024);
    }
    if (tid < 256) vtreg = *(const u32x4*)vtbase;
    __builtin_amdgcn_sched_barrier(0);
    float px[8], py[8]; float cx = 0.f, cy = 0.f;
#pragma unroll
    for (int jj = 0; jj < 8; ++jj) { cx += lx[jj]; cy += ly[jj]; px[jj] = cx; py[jj] = cy; }
    tot[w * 128 + d0] = cx; tot[w * 128 + d0 + 1] = cy;
#pragma unroll
    for (int et = 0; et < 2; ++et) {
      u32x2 o; o[0] = pk2(st[et][0], st[et][1]); o[1] = pk2(st[et][2], st[et][3]);
      *(LAS u32x2*)(lds + STS + (16 * et + fr) * 272 + (16 * w + 4 * fq) * 2) = o;
    }
    if (tid < 256) { const int r = tid >> 3, ch = tid & 7; *(LAS u32x4*)(lds + VTS + r * 144 + ch * 16) = vtreg; }
    __syncthreads();
    float offx = 0.f, offy = 0.f, rx = 0.f, ry = 0.f, bx = 0.f, by = 0.f;
#pragma unroll
    for (int q = 0; q < 8; ++q) {
      const float tx = tot[q * 128 + d0], ty = tot[q * 128 + d0 + 1];
      if (q < w) { offx += tx; offy += ty; }
      if (q < 4) { rx += tx; ry += ty; }
      bx += tx; by += ty;
    }
    if (w == 0) { dec[d0] = __expf(bx); dec[d0 + 1] = __expf(by); }
    unsigned kbx[4], kby[4];
#pragma unroll
    for (int jj = 0; jj < 8; ++jj) {
      const float Bx = offx + px[jj], By = offy + py[jj];
      const float qx = bflo(q2[jj]), qy = bfhi(q2[jj]);
      const float kx = 1.0f - __expf(lx[jj]), ky = 1.0f - __expf(ly[jj]);
      const float e1x = __expf(fminf(fmaxf(Bx - rx, -80.f), 80.f)), e1y = __expf(fminf(fmaxf(By - ry, -80.f), 80.f));
      const float e2x = __expf(fminf(fmaxf(rx - Bx, -80.f), 80.f)), e2y = __expf(fminf(fmaxf(ry - By, -80.f), 80.f));
      const int j = 8 * w + jj;
      *(LAS unsigned*)(lds + QT + j * 272 + d0 * 2) = pk2(qx * e1x, qy * e1y);
      *(LAS unsigned*)(lds + KT + j * 272 + d0 * 2) = pk2(kx * e2x, ky * e2y);
      *(LAS unsigned*)(lds + QB + j * 272 + d0 * 2) = pk2(qx * __expf(Bx), qy * __expf(By));
      const float kbvx = kx * __expf(bx - Bx), kbvy = ky * __expf(by - By);
      if (jj & 1) { kbx[jj >> 1] = pk2(__uint_as_float(kbx[jj >> 1]), kbvx); kby[jj >> 1] = pk2(__uint_as_float(kby[jj >> 1]), kbvy); }
      else { kbx[jj >> 1] = __float_as_uint(kbvx); kby[jj >> 1] = __float_as_uint(kbvy); }
    }
    *(LAS u32x4*)(lds + KBT + d0 * 144 + (8 * w) * 2) = (u32x4){kbx[0], kbx[1], kbx[2], kbx[3]};
    *(LAS u32x4*)(lds + KBT + (d0 + 1) * 144 + (8 * w) * 2) = (u32x4){kby[0], kby[1], kby[2], kby[3]};
    __syncthreads();
    __builtin_amdgcn_sched_barrier(0);
#pragma unroll
    for (int jj = 0; jj < 2; ++jj) {
      const int jt = 2 * eh + jj;
      f32x4 sc = (f32x4){0.f, 0.f, 0.f, 0.f};
#pragma unroll
      for (int ks = 0; ks < 4; ++ks) sc = mfma16(ldfrag(lds, KT + (16 * jt + fr) * 272 + (32 * ks + 8 * fq) * 2), ldfrag(lds, QT + (16 * it + fr) * 272 + (32 * ks + 8 * fq) * 2), sc);
      const int i_ = 16 * it + fr, j0 = 16 * jt + 4 * fq;
      u32x2 o; o[0] = pk2(j0 + 0 <= i_ ? sc[0] : 0.f, j0 + 1 <= i_ ? sc[1] : 0.f); o[1] = pk2(j0 + 2 <= i_ ? sc[2] : 0.f, j0 + 3 <= i_ ? sc[3] : 0.f);
      *(LAS u32x2*)(lds + PS + i_ * 144 + j0 * 2) = o;
    }
    __syncthreads();
    __builtin_amdgcn_sched_barrier(0);
    {
      f32x4 o = (f32x4){0.f, 0.f, 0.f, 0.f};
#pragma unroll
      for (int k2 = 0; k2 < 2; ++k2) o = mfma16(ldfrag(lds, VTS + (16 * eh + fr) * 144 + (32 * k2 + 8 * fq) * 2), ldfrag(lds, PS + (16 * it + fr) * 144 + (32 * k2 + 8 * fq) * 2), o);
#pragma unroll
      for (int ks = 0; ks < 4; ++ks) o = mfma16(ldfrag(lds, STS + (16 * eh + fr) * 272 + (32 * ks + 8 * fq) * 2), ldfrag(lds, QB + (16 * it + fr) * 272 + (32 * ks + 8 * fq) * 2), o);
      float s2 = o[0] * o[0] + o[1] * o[1] + o[2] * o[2] + o[3] * o[3];
      u32x2 ov; ov[0] = pk2(o[0], o[1]); ov[1] = pk2(o[2], o[3]);
      *(u32x2*)obase = ov;
      s2 += shx(s2, 16, lane); s2 += shx(s2, 32, lane);
      if (fq == 0) unsafeAtomicAdd(sbase, s2);
    }
    __builtin_amdgcn_sched_barrier(0);
    {
      const f32x4 dv = *(const LAS f32x4*)(dec + 16 * w + 4 * fq);
#pragma unroll
      for (int et = 0; et < 2; ++et)
#pragma unroll
        for (int r = 0; r < 4; ++r) st[et][r] *= dv[r];
#pragma unroll
      for (int k2 = 0; k2 < 2; ++k2) {
        const bf16x8 kf = ldfrag(lds, KBT + (16 * w + fr) * 144 + (32 * k2 + 8 * fq) * 2);
#pragma unroll
        for (int et = 0; et < 2; ++et) st[et] = mfma16(kf, ldfrag(lds, VTS + (16 * et + fr) * 144 + (32 * k2 + 8 * fq) * 2), st[et]);
      }
    }
    __syncthreads();
  }
}
enum { ST_G1 = 0, ST_S1, ST_G1B, ST_G2, ST_G3, ST_L1, ST_G4, ST_G5, ST_L2 };
__global__ void __launch_bounds__(512, 2) mega(Params p0) {
  extern __shared__ __attribute__((aligned(16))) unsigned char shm[];
  ldsp lds = (ldsp)shm;
  cg::grid_group grid = cg::this_grid();
  Params p = p0; p.ws = oaddr(p0.ws); p.out = oaddr(p0.out); p.wv = __builtin_amdgcn_readfirstlane((int)(threadIdx.x >> 6));
  phase_mod(lds, p);
  phase_conv(lds, p, 0);
  grid.sync();
  phase_u0(p);
  grid.sync();
  for (int pc = 0; pc < 28; ++pc) {
    p.ws = oaddr(p0.ws); p.out = oaddr(p0.out);
    const bf16_t* WB = (const bf16_t*)(p.ws + OFF_WB);
    const bf16_t* U = (const bf16_t*)(p.ws + OFF_U);
    unsigned char* R0 = p.ws + OFF_R0;
    const int l = pc / 14, k = pc - l * 14;
    int g = 0, stg;
    if (k < 10) { g = k / 5; stg = k - g * 5; } else stg = ST_L1 + (k - 10);
    int nj = 0, jmode0 = 0, jmode1 = 0; const bf16_t* jA0 = nullptr; const bf16_t* jA1 = nullptr; const bf16_t* jB0 = nullptr; const bf16_t* jB1 = nullptr;
    int jM0 = 0, jM1 = 0, jN0 = 0, jN1 = 0, jK0 = 0, jK1 = 0;
    if (stg == ST_G1) {
      float* stz = (float*)(p.ws + OFF_SMALL) + SM_STR;
      for (int i = obid() * 512 + otid(p.wv); i < TG * 16; i += gridDim.x * 512) stz[i] = 0.f;
      nj = 2;
      jmode0 = MD_G1A; jA0 = U + (size_t)g * TG * 1024; jB0 = WB + W1A; jM0 = TG; jN0 = 4096; jK0 = 1024;
      jmode1 = MD_G1S; jA1 = WB + W1S; jB1 = U + (size_t)g * TG * 1024; jM1 = 4096; jN1 = TG; jK1 = 1024;
    } else if (stg == ST_S1) {
      const int bid = obid();
      if (bid < 128) ret_item(lds, p, bid); else hgrn_item(lds, p, bid - 128);
    } else if (stg == ST_G1B) {
      nj = 1; jmode0 = MD_G1B; jA0 = U + (size_t)g * TG * 1024; jB0 = WB + W1B; jM0 = TG; jN0 = 5120; jK0 = 1024;
    } else if (stg == ST_G2) {
      nj = 2;
      jmode0 = MD_G2A; jA0 = (const bf16_t*)(R0 + R_ORA); jB0 = WB + WPA; jM0 = TG; jN0 = 1024; jK0 = 1024;
      jmode1 = MD_G2B; jA1 = (const bf16_t*)(R0 + R_ORB); jB1 = WB + WPB; jM1 = TG; jN1 = 1024; jK1 = 2048;
    } else if (stg == ST_G3) {
      nj = 1; jmode0 = MD_G3; jA0 = (const bf16_t*)(R0 + R_MG); jB0 = WB + WO; jM0 = TG; jN0 = 1024; jK0 = 1024;
    } else if (stg == ST_L1) {
      phase_ln(p, p.ln1_g + l * 1024, p.ln1_b + l * 1024, l, 3, false);
    } else if (stg == ST_G4) {
      nj = 1; jmode0 = MD_G4; jA0 = U; jB0 = WB + WUP; jM0 = T_ALL; jN0 = 4096; jK0 = 1024;
    } else if (stg == ST_G5) {
      nj = 1; jmode0 = MD_G5; jA0 = (const bf16_t*)R0; jB0 = WB + WDN; jM0 = T_ALL; jN0 = 1024; jK0 = 4096;
    } else {
      phase_ln(p, p.ln2_g + l * 1024, p.ln2_b + l * 1024, l == 0 ? 1 : 0, 0, l == 1);
      if (l == 0) phase_conv(lds, p, 1);
    }
    for (int j = 0; j < nj; ++j) {
      pg8::Gemm gm; gm.A = j ? jA1 : jA0; gm.Bt = j ? jB1 : jB0; gm.M = j ? jM1 : jM0; gm.N = j ? jN1 : jN0; gm.K = j ? jK1 : jK0;
      pg8::StaticOrder S; S.init(gm.M, gm.N, (int)gridDim.x, obid());
      EpiP E; E.mode = j ? jmode1 : jmode0; E.l = l; E.g = g; E.pp = &p;
      pg8::gemm_phase<EpiP, pg8::StaticOrder, false>((PG8_LAS unsigned char*)shm, gm, S, E, nullptr);
    }
    grid.sync();
  }
}

extern "C" void kernel_launch(void* const* d_in, const int* in_sizes, int n_in, void* d_out, int out_size,
                              void* d_ws, size_t ws_size, hipStream_t stream) {
  constexpr size_t kDynLds = 131072;
  static int configured = 0;
  if (!configured) {
    (void)hipFuncSetAttribute((const void*)mega, hipFuncAttributeMaxDynamicSharedMemorySize, (int)kDynLds);
    configured = 1;
  }
  Params p{};
  p.x = (const float*)d_in[0]; p.c = (const float*)d_in[1]; p.pos = (const int*)d_in[2]; p.lb_logits = (const float*)d_in[3];
  p.w_ada = (const float*)d_in[4]; p.b_ada = (const float*)d_in[5]; p.w_in = (const float*)d_in[6]; p.w_pa = (const float*)d_in[7];
  p.w_pb = (const float*)d_in[8]; p.w_o = (const float*)d_in[9]; p.ln1_g = (const float*)d_in[10]; p.ln1_b = (const float*)d_in[11];
  p.w_up = (const float*)d_in[12]; p.b_up = (const float*)d_in[13]; p.w_down = (const float*)d_in[14]; p.b_down = (const float*)d_in[15];
  p.ln2_g = (const float*)d_in[16]; p.ln2_b = (const float*)d_in[17];
  p.out = (float*)d_out; p.ws = (unsigned char*)d_ws;
  if (ws_size < 512ull * 1024 * 1024) { fprintf(stderr, "workspace too small\n"); return; }
  void* args[] = {&p};
  hipError_t e = hipLaunchCooperativeKernel((void*)mega, dim3(256), dim3(512), args, kDynLds, stream);
  if (e != hipSuccess) fprintf(stderr, "cooperative launch failed: %s\n", hipGetErrorString(e));
}
```

```cpp
#include <hip/hip_runtime.h>
#include <hip/hip_cooperative_groups.h>
#include <cstdio>
namespace cg = cooperative_groups;
__device__ __forceinline__ int otid(int wv) { int t = (wv << 6) | (int)__builtin_amdgcn_mbcnt_hi(~0u, __builtin_amdgcn_mbcnt_lo(~0u, 0u)); asm volatile("" : "+v"(t)); return t; }
__device__ __forceinline__ int obid() { int t = blockIdx.x; asm volatile("" : "+s"(t)); return t; }
template <class T> __device__ __forceinline__ T* oaddr(T* q) { asm volatile("" : "+s"(q)); return q; }
namespace pg8 {
#define PG8_LAS __attribute__((address_space(3)))
typedef unsigned short bf16_t;
typedef short bf16x8 __attribute__((ext_vector_type(8)));
typedef float f32x4 __attribute__((ext_vector_type(4)));
typedef unsigned u32x4 __attribute__((ext_vector_type(4)));
constexpr int BM = 256, BK = 64, HALF = 128, HTB = HALF * BK * 2  , STAGE_BYTES = 8 * HTB, NXCD = 8, WGM = 8;

__host__ __device__ __forceinline__ int lds_byte(int r, int c) { const int st = (r >> 4) * 2 + (c >> 5), rr = r & 15, cc = c & 31, ob = rr * 64 + cc * 2; return st * 1024 + (ob ^ (((ob >> 9) & 1) << 5)); }
__host__ __device__ __forceinline__ void stage_rc(int b, int& R, int& C) { const int st = b / 1024, sb = b % 1024, swz = sb ^ (((sb >> 9) & 1) << 5); R = (st >> 1) * 16 + swz / 64; C = (st & 1) * 32 + (swz % 64) / 2; }
__host__ __device__ __forceinline__ int perm32(int rho) { const int n = rho >> 4, i = rho & 15; return 8 * (i >> 2) + 4 * n + (i & 3); }

struct Unit { int pm, pn; };
struct Gemm { const bf16_t* A; const bf16_t* Bt; int M, N, K; };

struct StaticOrder {
    int nM, nN, nwg, G, c;
    __host__ __device__ void init(int M, int N, int G_, int c_) { nM = M / BM; nN = N / BM; nwg = nM * nN; G = G_; c = c_; }
    __host__ __device__ bool next(int i, Unit& u) const {
        const long L = (long)i * G + c; if (L >= nwg) return false;
        int wgid = (int)L; { const int q = nwg / NXCD, r = nwg % NXCD, xcd = wgid % NXCD, off = wgid / NXCD; wgid = (xcd < r ? xcd * (q + 1) : r * (q + 1) + (xcd - r) * q) + off; }
        const int nig = WGM * nN, gid = wgid / nig, fm = gid * WGM, gsz = (nM - fm) < WGM ? (nM - fm) : WGM;
        u.pm = fm + ((wgid % nig) % gsz); u.pn = (wgid % nig) / gsz; return true;
    }
    __device__ __forceinline__ void a_ready(const Unit&) const {}
    __device__ __forceinline__ void done(const Unit&) const {}
};
__device__ __forceinline__ unsigned cvt_pk_bf16(float lo, float hi) { unsigned r; asm volatile("v_cvt_pk_bf16_f32 %0, %1, %2" : "=v"(r) : "v"(lo), "v"(hi)); return r; }

template <class Epi, class Sched, bool STAMP = false>
__device__ __forceinline__ void gemm_phase(PG8_LAS unsigned char* lds, const Gemm g, const Sched& S, const Epi& E, unsigned long long* stamps) {
    const int tid = otid(E.pp->wv), wid = __builtin_amdgcn_readfirstlane(tid >> 6), lane = tid & 63, wr = wid >> 2, wc = wid & 3, fr = lane & 15, fq = lane >> 4;
    const int K = g.K, nt = K / BK;
    int ts_lo = 0, ts_hi = 0, nts = 0; const unsigned long long rt_entry = STAMP ? (unsigned long long)wall_clock64() : 0ull;
#define PG8_STAMP() do { if (STAMP && wid == 0 && nts < 64) { const unsigned long long _c = (unsigned long long)clock64(); \
        ts_lo = (lane == nts) ? (int)(unsigned)_c : ts_lo; ts_hi = (lane == nts) ? (int)(unsigned)(_c >> 32) : ts_hi; ++nts; } } while (0)
    PG8_STAMP();
    unsigned voffA[2], voffB[2];
#pragma unroll
    for (int i = 0; i < 2; ++i) { int R, C; stage_rc(tid * 16 + i * 8192, R, C); const int Rb = Epi::PERM ? ((R & ~31) + perm32(R & 31)) : R;
        voffA[i] = (unsigned)(R * K + C) * 2u; voffB[i] = (unsigned)(Rb * K + C) * 2u; }
    const size_t kstep = (size_t)(BK * 2);
    const size_t hstep = (size_t)HALF * K * 2;
    const size_t tstep = 2 * hstep;
    const unsigned ldsw = (unsigned)wid * 1024u;
    const int aoff = lds_byte(wr * 64 + fr, fq * 8), boff = lds_byte(wc * 32 + fr, fq * 8);
#define PG8_SA(b, h) (((b) * 2 + (h)) * HTB)
#define PG8_SB(b, h) ((4 + (b) * 2 + (h)) * HTB)
#define PG8_STAGE(bufoff, gbase, voff) do { _Pragma("unroll") for (int _i = 0; _i < 2; ++_i) \
        __builtin_amdgcn_global_load_lds((const unsigned*)((const char*)(gbase) + (voff)[_i]), (PG8_LAS unsigned*)(lds + (bufoff) + ldsw + _i * 8192), 16, 0, 0); } while (0)
#define PG8_LDA(dst, b, h) do { _Pragma("unroll") for (int m = 0; m < 4; ++m) _Pragma("unroll") for (int k = 0; k < 2; ++k) dst[m][k] = *(const PG8_LAS bf16x8*)(lds + PG8_SA(b, h) + aoff + m * 2048 + k * 1024); } while (0)
#define PG8_LDB(dst, b, h) do { _Pragma("unroll") for (int n = 0; n < 2; ++n) _Pragma("unroll") for (int k = 0; k < 2; ++k) dst[n][k] = *(const PG8_LAS bf16x8*)(lds + PG8_SB(b, h) + boff + n * 2048 + k * 1024); } while (0)
#define PG8_MMA(ai, bj, At, Bt) do { __builtin_amdgcn_s_setprio(1); _Pragma("unroll") for (int m = 0; m < 4; ++m) _Pragma("unroll") for (int n = 0; n < 2; ++n) _Pragma("unroll") for (int k = 0; k < 2; ++k) \
        acc[ai][bj][m][n] = __builtin_amdgcn_mfma_f32_16x16x32_bf16(Bt[n][k], At[m][k], acc[ai][bj][m][n], 0, 0, 0); __builtin_amdgcn_s_setprio(0); } while (0)
#define PG8_WAIT_V(n) asm volatile("s_waitcnt vmcnt(" #n ")" ::: "memory")
#define PG8_WAIT_L(n) asm volatile("s_waitcnt lgkmcnt(" #n ")" ::: "memory")
#define PG8_BAR __builtin_amdgcn_s_barrier()
#define PG8_SCHED __builtin_amdgcn_sched_barrier(0)
    Unit cur, nxt; int ui = 0;
    if (!S.next(0, cur)) return;
    f32x4 acc[2][2][4][2];
#pragma unroll
    for (int a = 0; a < 2; ++a)
#pragma unroll
        for (int b = 0; b < 2; ++b)
#pragma unroll
            for (int m = 0; m < 4; ++m)
#pragma unroll
                for (int n = 0; n < 2; ++n) acc[a][b][m][n] = (f32x4){0.f, 0.f, 0.f, 0.f};
    bf16x8 At[4][2], B0[2][2], B1[2][2];
    const char* cA = (const char*)g.A + (size_t)cur.pm * tstep; const char* cB = (const char*)g.Bt + (size_t)cur.pn * tstep;
    S.a_ready(cur);
    PG8_STAGE(PG8_SB(0, 0), cB, voffB); PG8_STAGE(PG8_SA(0, 0), cA, voffA); PG8_STAGE(PG8_SB(0, 1), cB + hstep, voffB); PG8_STAGE(PG8_SA(0, 1), cA + hstep, voffA);
    if (wr == 1) PG8_BAR;
    PG8_WAIT_V(4); PG8_BAR;
    PG8_STAGE(PG8_SB(1, 0), cB + kstep, voffB); PG8_STAGE(PG8_SA(1, 0), cA + kstep, voffA); PG8_STAGE(PG8_SB(1, 1), cB + hstep + kstep, voffB);
    PG8_WAIT_V(6); PG8_BAR;
    PG8_STAMP();
    for (;;) {
        const bool has_next = S.next(ui + 1, nxt);
        const char* nA = has_next ? (const char*)g.A + (size_t)nxt.pm * tstep : cA; const char* nB = has_next ? (const char*)g.Bt + (size_t)nxt.pn * tstep : cB;
        for (int t = 0; t < nt; t += 2) {
            const bool last = (t == nt - 2);
            const char* a1 = cA + (size_t)(t + 1) * kstep;
            const char* a2 = last ? nA : cA + (size_t)(t + 2) * kstep; const char* b2 = last ? nB : cB + (size_t)(t + 2) * kstep;
            const char* a3 = a2 + kstep; const char* b3 = b2 + kstep;
            if (last && has_next) S.a_ready(nxt);
            PG8_LDB(B0, 0, 0); PG8_SCHED; PG8_LDA(At, 0, 0); PG8_STAGE(PG8_SA(1, 1), a1 + hstep, voffA);
            PG8_WAIT_L(8); PG8_BAR; PG8_WAIT_L(0); PG8_MMA(0, 0, At, B0); PG8_BAR; PG8_SCHED;
            PG8_LDB(B1, 0, 1); PG8_STAGE(PG8_SB(0, 0), b2, voffB);
            PG8_BAR; PG8_WAIT_L(0); PG8_MMA(0, 1, At, B1); PG8_BAR;
            PG8_LDA(At, 0, 1); PG8_STAGE(PG8_SA(0, 0), a2, voffA);
            PG8_BAR; PG8_WAIT_L(0); PG8_MMA(1, 0, At, B0); PG8_BAR; PG8_SCHED;
            PG8_STAGE(PG8_SB(0, 1), b2 + hstep, voffB);
            PG8_WAIT_V(6); PG8_BAR; PG8_MMA(1, 1, At, B1); PG8_BAR;
            PG8_LDB(B0, 1, 0); PG8_SCHED; PG8_LDA(At, 1, 0); PG8_STAGE(PG8_SA(0, 1), a2 + hstep, voffA);
            PG8_WAIT_L(8); PG8_BAR; PG8_WAIT_L(0); PG8_MMA(0, 0, At, B0); PG8_BAR; PG8_SCHED;
            PG8_LDB(B1, 1, 1); PG8_STAGE(PG8_SB(1, 0), b3, voffB);
            PG8_BAR; PG8_WAIT_L(0); PG8_MMA(0, 1, At, B1); PG8_BAR;
            PG8_LDA(At, 1, 1); PG8_STAGE(PG8_SA(1, 0), a3, voffA);
            PG8_BAR; PG8_WAIT_L(0); PG8_MMA(1, 0, At, B0); PG8_BAR; PG8_SCHED;
            PG8_STAGE(PG8_SB(1, 1), b3 + hstep, voffB);
            PG8_WAIT_V(6); PG8_BAR; PG8_MMA(1, 1, At, B1); PG8_BAR;
        }
        PG8_STAMP();
        if constexpr (!Epi::AFTER_DRAIN) { E(acc, cur, wr, wc, fr, fq); S.done(cur); }
        PG8_STAMP();
        if (!has_next) break;
#pragma unroll
        for (int a = 0; a < 2; ++a)
#pragma unroll
            for (int b = 0; b < 2; ++b)
#pragma unroll
                for (int m = 0; m < 4; ++m)
#pragma unroll
                    for (int n = 0; n < 2; ++n) acc[a][b][m][n] = (f32x4){0.f, 0.f, 0.f, 0.f};
        cur = nxt; cA = nA; cB = nB; ++ui;
    }
    PG8_WAIT_V(0);
    if (wr == 0) PG8_BAR;
    PG8_BAR;
    if constexpr (Epi::AFTER_DRAIN) { E.fused(acc, cur, wr, wc, fr, fq, lds, wid, lane); S.done(cur); }
    PG8_STAMP();
    if (STAMP && wid == 0) { stamps[lane] = lane < nts ? (((unsigned long long)(unsigned)ts_hi << 32) | (unsigned)ts_lo) : 0ull;
        if (lane == 62) stamps[62] = rt_entry; if (lane == 63) stamps[63] = (unsigned long long)wall_clock64(); }
#undef PG8_STAMP
#undef PG8_SA
#undef PG8_SB
#undef PG8_STAGE
#undef PG8_LDA
#undef PG8_LDB
#undef PG8_MMA
#undef PG8_WAIT_V
#undef PG8_WAIT_L
#undef PG8_BAR
#undef PG8_SCHED
}
}
using pg8::bf16_t; using pg8::bf16x8; using pg8::f32x4; using pg8::u32x4; using pg8::Unit;
typedef unsigned u32x2 __attribute__((ext_vector_type(2)));
#define LAS __attribute__((address_space(3)))
typedef LAS unsigned char* ldsp;

constexpr int T_ALL = 32768, TG = 16384, DM = 1024, SEQ = 4096;
constexpr float ALPHA = 1.4142135623730951f;
constexpr size_t MB = 1024ull * 1024ull;
constexpr size_t OFF_XB = 0, OFF_WB = 128 * MB, OFF_U = 184 * MB, OFF_SMALL = 248 * MB, OFF_R0 = 256 * MB;
constexpr size_t W1A = 0, W1S = W1A + 4096ull * 1024, W1B = W1S + 4096ull * 1024, WPA = W1B + 5120ull * 1024, WPB = WPA + 1024ull * 1024,
                 WO = WPB + 1024ull * 2048, WUP = WO + 1024ull * 1024, WDN = WUP + 4096ull * 1024, W_END = WDN + 4096ull * 1024;
static_assert(W_END * 2 <= 56 * MB, "weights");
constexpr size_t SM_MOD = 0  , SM_LB = 2 * 8 * 6144  , SM_STR = SM_LB + 2048  , SM_STH = SM_STR + (size_t)TG * 8  , SM_END = SM_STH + (size_t)TG * 8;
constexpr size_t SM_BAR_BYTES = 7 * MB;
static_assert(SM_END * 4 <= 7 * MB, "small");
constexpr size_t R_QH = 0, R_VIT = 32 * MB, R_QR = 64 * MB, R_KR = 96 * MB, R_KRT = 128 * MB, R_ORA = 160 * MB, R_ORB = 192 * MB;
constexpr size_t R_SGA = R_QH, R_SGB = R_VIT, R_M1 = R_QR, R_MG = R_KRT;
constexpr size_t D_LF = 0, D_VRT = 64 * MB;

struct Params {
  const float* x; const float* c; const int* pos; const float* lb_logits; const float* w_ada; const float* b_ada; const float* w_in; const float* w_pa; const float* w_pb;
  const float* w_o; const float* ln1_g; const float* ln1_b; const float* w_up; const float* b_up; const float* w_down; const float* b_down; const float* ln2_g; const float* ln2_b;
  float* out; unsigned char* ws; int wv; int pad;
};

__device__ __forceinline__ float bf2f(unsigned short b) { return __uint_as_float(((unsigned)b) << 16); }
__device__ __forceinline__ float bflo(unsigned u) { return __uint_as_float(u << 16); }
__device__ __forceinline__ float bfhi(unsigned u) { return __uint_as_float(u & 0xffff0000u); }
__device__ __forceinline__ unsigned pk2(float lo, float hi) { return pg8::cvt_pk_bf16(lo, hi); }
__device__ __forceinline__ float sigmoidf_(float v) { return 1.0f / (1.0f + __expf(-v)); }
__device__ __forceinline__ float siluf_(float v) { return v * sigmoidf_(v); }
__device__ __forceinline__ f32x4 mfma16(bf16x8 a, bf16x8 b, f32x4 c) { return __builtin_amdgcn_mfma_f32_16x16x32_bf16(a, b, c, 0, 0, 0); }
__device__ __forceinline__ bf16x8 ldfrag(ldsp base, int off) { return *(const LAS bf16x8*)(base + off); }
__device__ __forceinline__ float shx(float v, int mask, int lane) { return __int_as_float(__builtin_amdgcn_ds_bpermute((lane ^ mask) << 2, __float_as_int(v))); }
__device__ __forceinline__ float wave_sum(float v, int lane) {
#pragma unroll
  for (int o = 32; o > 0; o >>= 1) v += shx(v, o, lane);
  return v;
}

enum { MD_G1A = 0, MD_G1S, MD_G1B, MD_G2A, MD_G2B, MD_G3, MD_G4, MD_G5 };
struct EpiP {
  static constexpr bool PERM = true, AFTER_DRAIN = false;
  int mode, l, g;
  const Params* pp;
  template <int MODE, int ai, int m> __device__ __forceinline__ void rowf(const f32x4 (&acc)[2][2][4][2], const Unit& u, int wr, int wc, int fr, int fq) const {
    const Params& p = *pp;
    unsigned char* R0 = p.ws + OFF_R0; unsigned char* DO = (unsigned char*)p.out;
    float* small = (float*)(p.ws + OFF_SMALL);
    const float* mod = small + SM_MOD + (size_t)l * 8 * 6144;
      {
        const int row = u.pm * 256 + ai * 128 + wr * 64 + m * 16 + fr;
#pragma unroll
        for (int bj = 0; bj < 2; ++bj) {
          const int col = u.pn * 256 + bj * 128 + wc * 32 + 8 * fq;
          float v[8];
#pragma unroll
          for (int i = 0; i < 4; ++i) { v[i] = acc[ai][bj][m][0][i]; v[4 + i] = acc[ai][bj][m][1][i]; }
          if constexpr (MODE == MD_G1A) {
            const int sec = col >> 10, cs = col & 1023;
            if (sec == 0) {
              u32x4 o;
#pragma unroll
              for (int i = 0; i < 4; ++i) o[i] = pk2(siluf_(v[2 * i]), siluf_(v[2 * i + 1]));
              *(u32x4*)(R0 + R_QH + ((size_t)row * 1024 + cs) * 2) = o;
            } else if (sec == 1) {
              const float* lbp = small + SM_LB + l * 1024 + cs;
              const f32x4 l0 = *(const f32x4*)lbp, l1 = *(const f32x4*)(lbp + 4);
              float o[8];
#pragma unroll
              for (int i = 0; i < 8; ++i) {
                const float lbv = i < 4 ? l0[i & 3] : l1[i & 3];
                const float z = v[i];
                const float ls = fminf(z, 0.f) - log1pf(__expf(-fabsf(z)));
                const float f = lbv + (1.f - lbv) * sigmoidf_(z);
                o[i] = (lbv == 0.f) ? ls : __logf(f);
              }
              float* dst = (float*)(DO + D_LF) + (size_t)row * 1024 + cs;
              *(f32x4*)dst = (f32x4){o[0], o[1], o[2], o[3]}; *(f32x4*)(dst + 4) = (f32x4){o[4], o[5], o[6], o[7]};
            } else {
              const float posf = (float)p.pos[g * TG + row];
              const float sc = sec == 3 ? 0.0625f : 1.0f;
              const int p0 = (cs & 255) >> 1;
              u32x4 o;
#pragma unroll
              for (int i = 0; i < 4; ++i) {
                const float theta = __builtin_amdgcn_exp2f(-13.287712379549449f * (float)(p0 + i) * (1.0f / 127.0f));
                float rev = posf * theta * 0.15915494309189535f; rev -= floorf(rev);
                const float sn = __builtin_amdgcn_sinf(rev), cn = __builtin_amdgcn_cosf(rev);
                const float t1 = v[2 * i], t2 = v[2 * i + 1];
                o[i] = pk2((t1 * cn - t2 * sn) * sc, (t1 * sn + t2 * cn) * sc);
              }
              *(u32x4*)(R0 + (sec == 2 ? R_QR : R_KR) + ((size_t)row * 1024 + cs) * 2) = o;
            }
          } else if constexpr (MODE == MD_G1S) {
            const int sec = row >> 10;
            if (sec == 0) {
              u32x4 o;
#pragma unroll
              for (int i = 0; i < 4; ++i) o[i] = pk2(v[2 * i], v[2 * i + 1]);
              *(u32x4*)(R0 + R_VIT + ((size_t)row * TG + col) * 2) = o;
            } else if (sec == 1) {
              const int f = row - 1024;
              const float theta = __builtin_amdgcn_exp2f(-13.287712379549449f * (float)((f & 255) >> 1) * (1.0f / 127.0f));
              const bool odd = (f & 1) != 0;
              const int* pp_ = p.pos + g * TG + col;
              float o[8];
#pragma unroll
              for (int i = 0; i < 8; ++i) {
                const float pv = shx(v[i], 1, (fq << 4) | fr);
                float rev = (float)pp_[i] * theta * 0.15915494309189535f; rev -= floorf(rev);
                const float sn = __builtin_amdgcn_sinf(rev), cn = __builtin_amdgcn_cosf(rev);
                o[i] = (odd ? (pv * sn + v[i] * cn) : (v[i] * cn - pv * sn)) * 0.0625f;
              }
              u32x4 ov;
#pragma unroll
              for (int i = 0; i < 4; ++i) ov[i] = pk2(o[2 * i], o[2 * i + 1]);
              *(u32x4*)(R0 + R_KRT + ((size_t)f * TG + col) * 2) = ov;
            } else {
              const int f = row - 2048, h = f >> 9;
              const float lg2 = __log2f(1.0f - __builtin_amdgcn_exp2f(-5.0f - (float)h));
              float o[8];
#pragma unroll
              for (int i = 0; i < 8; ++i) o[i] = v[i] * __builtin_amdgcn_exp2f(lg2 * (float)(63 - ((col + i) & 63)));
              u32x4 ov;
#pragma unroll
              for (int i = 0; i < 4; ++i) ov[i] = pk2(o[2 * i], o[2 * i + 1]);
              *(u32x4*)(DO + D_VRT + ((size_t)f * TG + col) * 2) = ov;
            }
          } else if constexpr (MODE == MD_G1B) {
            const int sec = col >> 10, cs = col & 1023;
            if (sec == 0) {
              const float ss = (small + SM_STH)[(size_t)row * 8 + (cs >> 7)];
              const float rstd = rsqrtf(ss * (1.0f / 128.0f) + 1e-6f);
              u32x4* ptr = (u32x4*)(R0 + R_ORA + ((size_t)row * 1024 + cs) * 2);
              const u32x4 ov = *ptr; u32x4 o;
#pragma unroll
              for (int i = 0; i < 4; ++i) o[i] = pk2(bflo(ov[i]) * rstd * siluf_(v[2 * i]), bfhi(ov[i]) * rstd * siluf_(v[2 * i + 1]));
              *ptr = o;
            } else if (sec < 3) {
              const int c2 = col - 1024;
              const float* st = small + SM_STR + ((size_t)row * 4 + (c2 >> 9)) * 2;
              const float mean = st[0] * (1.0f / 512.0f);
              const float var = fmaxf(st[1] * (1.0f / 512.0f) - mean * mean, 0.f);
              const float rstd = rsqrtf(var + 1e-6f);
              u32x4* ptr = (u32x4*)(R0 + R_ORB + ((size_t)row * 2048 + c2) * 2);
              const u32x4 ov = *ptr; u32x4 o;
#pragma unroll
              for (int i = 0; i < 4; ++i) o[i] = pk2((bflo(ov[i]) - mean) * rstd * siluf_(v[2 * i]), (bfhi(ov[i]) - mean) * rstd * siluf_(v[2 * i + 1]));
              *ptr = o;
            } else {
              u32x4 o;
#pragma unroll
              for (int i = 0; i < 4; ++i) o[i] = pk2(sigmoidf_(v[2 * i]), sigmoidf_(v[2 * i + 1]));
              *(u32x4*)(R0 + (sec == 3 ? R_SGA : R_SGB) + ((size_t)row * 1024 + cs) * 2) = o;
            }
          } else if constexpr (MODE == MD_G2A) {
            const u32x4 gv = *(const u32x4*)(R0 + R_SGA + ((size_t)row * 1024 + col) * 2);
            float* dst = (float*)(R0 + R_M1) + (size_t)row * 1024 + col;
            *(f32x4*)dst = (f32x4){bflo(gv[0]) * v[0], bfhi(gv[0]) * v[1], bflo(gv[1]) * v[2], bfhi(gv[1]) * v[3]};
            *(f32x4*)(dst + 4) = (f32x4){bflo(gv[2]) * v[4], bfhi(gv[2]) * v[5], bflo(gv[3]) * v[6], bfhi(gv[3]) * v[7]};
          } else if constexpr (MODE == MD_G2B) {
            const u32x4 gv = *(const u32x4*)(R0 + R_SGB + ((size_t)row * 1024 + col) * 2);
            const float* src = (const float*)(R0 + R_M1) + (size_t)row * 1024 + col;
            const f32x4 m0 = *(const f32x4*)src, m1 = *(const f32x4*)(src + 4);
            u32x4 o;
            o[0] = pk2(m0[0] + bflo(gv[0]) * v[0], m0[1] + bfhi(gv[0]) * v[1]);
            o[1] = pk2(m0[2] + bflo(gv[1]) * v[2], m0[3] + bfhi(gv[1]) * v[3]);
            o[2] = pk2(m1[0] + bflo(gv[2]) * v[4], m1[1] + bfhi(gv[2]) * v[5]);
            o[3] = pk2(m1[2] + bflo(gv[3]) * v[6], m1[3] + bfhi(gv[3]) * v[7]);
            *(u32x4*)(R0 + R_MG + ((size_t)row * 1024 + col) * 2) = o;
          } else if constexpr (MODE == MD_G3) {
            const int tg = g * TG + row, b = tg >> 12;
            const float* xin = (l == 0 ? p.x : (const float*)(p.ws + OFF_XB)) + (size_t)tg * 1024 + col;
            const float* gt = mod + (size_t)b * 6144 + 2 * 1024 + col;
            const f32x4 x0 = *(const f32x4*)xin, x1 = *(const f32x4*)(xin + 4), g0 = *(const f32x4*)gt, g1 = *(const f32x4*)(gt + 4);
            float* dst = (float*)(p.ws + OFF_XB) + (size_t)tg * 1024 + col;
            f32x4 o0, o1;
#pragma unroll
            for (int i = 0; i < 4; ++i) { o0[i] = ALPHA * x0[i] + (1.f + g0[i]) * v[i]; o1[i] = ALPHA * x1[i] + (1.f + g1[i]) * v[4 + i]; }
            *(f32x4*)dst = o0; *(f32x4*)(dst + 4) = o1;
          } else if constexpr (MODE == MD_G4) {
            const float* bp = p.b_up + (size_t)l * 4096 + col;
            const f32x4 b0 = *(const f32x4*)bp, b1 = *(const f32x4*)(bp + 4);
            float o[8];
#pragma unroll
            for (int i = 0; i < 8; ++i) { const float hh = fmaxf(v[i] + (i < 4 ? b0[i & 3] : b1[i & 3]), 0.f); o[i] = hh * hh; }
            u32x4 ov;
#pragma unroll
            for (int i = 0; i < 4; ++i) ov[i] = pk2(o[2 * i], o[2 * i + 1]);
            *(u32x4*)(R0 + ((size_t)row * 4096 + col) * 2) = ov;
          } else if constexpr (MODE == MD_G5) {
            const int b = row >> 12;
            float* dst = (float*)(p.ws + OFF_XB) + (size_t)row * 1024 + col;
            const float* gt = mod + (size_t)b * 6144 + 5 * 1024 + col;
            const float* bp = p.b_down + (size_t)l * 1024 + col;
            const f32x4 x0 = *(const f32x4*)dst, x1 = *(const f32x4*)(dst + 4), g0 = *(const f32x4*)gt, g1 = *(const f32x4*)(gt + 4), b0 = *(const f32x4*)bp, b1 = *(const f32x4*)(bp + 4);
            f32x4 o0, o1;
#pragma unroll
            for (int i = 0; i < 4; ++i) { o0[i] = ALPHA * x0[i] + (1.f + g0[i]) * (v[i] + b0[i]); o1[i] = ALPHA * x1[i] + (1.f + g1[i]) * (v[4 + i] + b1[i]); }
            *(f32x4*)dst = o0; *(f32x4*)(dst + 4) = o1;
          }
        }
      }
  }
  template <int MODE> __device__ __forceinline__ void run(const f32x4 (&acc)[2][2][4][2], const Unit& u, int wr, int wc, int fr, int fq) const {
    #define RW(a, b) rowf<MODE, a, b>(acc, u, wr, wc, fr, fq);
    RW(0, 0) RW(0, 1) RW(0, 2) RW(0, 3) RW(1, 0) RW(1, 1) RW(1, 2) RW(1, 3)
#undef RW
  }
  __device__ __forceinline__ void operator()(const f32x4 (&acc)[2][2][4][2], const Unit& u, int wr, int wc, int fr, int fq) const {
    switch (mode) {
      case MD_G1A: run<MD_G1A>(acc, u, wr, wc, fr, fq); break;
      case MD_G1S: run<MD_G1S>(acc, u, wr, wc, fr, fq); break;
      case MD_G1B: run<MD_G1B>(acc, u, wr, wc, fr, fq); break;
      case MD_G2A: run<MD_G2A>(acc, u, wr, wc, fr, fq); break;
      case MD_G2B: run<MD_G2B>(acc, u, wr, wc, fr, fq); break;
      case MD_G3: run<MD_G3>(acc, u, wr, wc, fr, fq); break;
      case MD_G4: run<MD_G4>(acc, u, wr, wc, fr, fq); break;
      default: run<MD_G5>(acc, u, wr, wc, fr, fq); break;
    }
  }
};
#define XB_TMO      128
#define XB_XCNT(j)  (256  + 64 * (j))
#define XB_XSUB(j)  (1280 + 64 * (j))
#define XB_XGEN(j)  (2304 + 64 * (j))
#define XB_TOP      3328
#define XB_TOPGEN   3392
#define XCD_BAR_WORDS 3456
#define XB_SPIN_CAP (1u << 18)

__device__ __forceinline__ unsigned xb_ld(unsigned* p)              { return __hip_atomic_load(p, __ATOMIC_RELAXED, __HIP_MEMORY_SCOPE_AGENT); }
__device__ __forceinline__ unsigned xb_add(unsigned* p, unsigned v) { return __hip_atomic_fetch_add(p, v, __ATOMIC_RELAXED, __HIP_MEMORY_SCOPE_AGENT); }
__device__ __forceinline__ unsigned xb_xcc_id() { return (unsigned)__builtin_amdgcn_s_getreg((3 << 11) | 20) & 0xFu; }
#define XB_SPIN(cond, bar) do { unsigned _sp = 0; while (cond) { __builtin_amdgcn_s_sleep(1); \
    if ((++_sp & 255u) == 0u) { if (xb_ld(&(bar)[XB_TMO])) break; if (_sp > XB_SPIN_CAP) { atomicAdd(&(bar)[XB_TMO], 1u); break; } } } } while (0)

struct XcdBarrier {
    unsigned* bar; unsigned x;
    volatile LAS unsigned* st;
};

__device__ __forceinline__ XcdBarrier xcd_barrier_post(unsigned* bar, volatile LAS unsigned* st) {
    XcdBarrier b; b.bar = bar; b.x = xb_xcc_id(); b.st = st;
    if (threadIdx.x == 0) (void)xb_add(&bar[XB_XCNT(b.x)], 1u);
    return b;
}
__device__ __forceinline__ void xcd_barrier_complete(unsigned* bar, unsigned x, unsigned& nloc, unsigned& nx) {
    const unsigned G = gridDim.x * gridDim.y * gridDim.z;
    unsigned sum, cnt, mine, sp = 0u;
    for (;;) {
        sum = 0u; cnt = 0u; mine = 0u;
#pragma unroll
        for (unsigned j = 0; j < 16; ++j) { const unsigned c = xb_ld(&bar[XB_XCNT(j)]); sum += c; cnt += (c > 0u) ? 1u : 0u; mine = (j == x) ? c : mine; }
        if (sum == G) break;
        __builtin_amdgcn_s_sleep(1);
        if ((++sp & 255u) == 0u) { if (xb_ld(&bar[XB_TMO])) break; if (sp > XB_SPIN_CAP) { atomicAdd(&bar[XB_TMO], 1u); break; } }
    }
    nloc = mine > 0u ? mine : 1u; nx = cnt > 0u ? cnt : 1u;
}

__device__ __forceinline__ void xcd_barrier(const XcdBarrier& b) {
    asm volatile("s_waitcnt vmcnt(0)" ::: "memory");
    __syncthreads();
    if (threadIdx.x == 0) {
        unsigned* bar = b.bar;
        __builtin_amdgcn_s_waitcnt(0);
        unsigned nloc = b.st[0], nx = b.st[1];
        if (nloc == 0u) { xcd_barrier_complete(bar, b.x, nloc, nx); b.st[0] = nloc; b.st[1] = nx; }
        const unsigned old = xb_add(&bar[XB_XSUB(b.x)], 1u);
        const unsigned gen = old / nloc;
        if (old + 1u == (gen + 1u) * nloc) {
            __builtin_amdgcn_fence(__ATOMIC_RELEASE, "agent");
            asm volatile("s_waitcnt vmcnt(0)" ::: "memory");
            const unsigned og = xb_add(&bar[XB_TOP], 1u);
            const unsigned tg = og / nx;
            if (og + 1u == (tg + 1u) * nx) xb_add(&bar[XB_TOPGEN], 1u);
            else XB_SPIN(xb_ld(&bar[XB_TOPGEN]) == tg, bar);
            __builtin_amdgcn_fence(__ATOMIC_ACQUIRE, "agent");
            xb_add(&bar[XB_XGEN(b.x)], 1u);
            asm volatile("s_waitcnt vmcnt(0)" ::: "memory");
        } else {
            XB_SPIN(xb_ld(&bar[XB_XGEN(b.x)]) == gen, bar);
            __builtin_amdgcn_fence(__ATOMIC_ACQUIRE, "agent");
            asm volatile("s_waitcnt vmcnt(0)" ::: "memory");
        }
    }
    __syncthreads();
}

__device__ __forceinline__ void gbar(unsigned* bar0, volatile LAS unsigned* st) {
    XcdBarrier b; b.bar = bar0; asm volatile("" : "+s"(b.bar)); b.x = (unsigned)__builtin_amdgcn_readfirstlane((int)xb_xcc_id()); asm volatile("" : "+s"(b.x)); b.st = st; xcd_barrier(b);
}
__device__ __forceinline__ void conv_job(ldsp lds, int wv, const float* src, int ld, int K, int c0, int ncols, bf16_t* dst) {
  LAS float* tile = (LAS float*)lds;
  const int tid = otid(wv), ntk = K >> 6, ntn = ncols >> 6, nt = ntk * ntn;
  for (int t = obid(); t < nt; t += gridDim.x) {
    const int tk = t / ntn, tn = t - tk * ntn, k0 = tk << 6, n0 = tn << 6;
    __syncthreads();
#pragma unroll
    for (int i = 0; i < 8; ++i) { const int r = i * 8 + (tid >> 6), cc = tid & 63; tile[r * 65 + cc] = src[(size_t)(k0 + r) * ld + c0 + n0 + cc]; }
    __syncthreads();
    const int kp = tid & 31, nn = tid >> 5;
#pragma unroll
    for (int i = 0; i < 4; ++i) { const int n = nn + 16 * i; *(unsigned*)(dst + (size_t)(n0 + n) * K + k0 + 2 * kp) = pk2(tile[(2 * kp) * 65 + n], tile[(2 * kp + 1) * 65 + n]); }
  }
  __syncthreads();
}
__device__ __forceinline__ void phase_conv(ldsp lds, const Params& p, int l) {
  bf16_t* WB = (bf16_t*)(p.ws + OFF_WB);
  const float* win = p.w_in + (size_t)l * 1024 * 12288;
  conv_job(lds, p.wv, win, 12288, 1024, 0, 1024, WB + W1A);
  conv_job(lds, p.wv, win, 12288, 1024, 1024, 1024, WB + W1A + 1024ull * 1024);
  conv_job(lds, p.wv, win, 12288, 1024, 4096, 2048, WB + W1A + 2048ull * 1024);
  conv_job(lds, p.wv, win, 12288, 1024, 2048, 1024, WB + W1S);
  conv_job(lds, p.wv, win, 12288, 1024, 5120, 3072, WB + W1S + 1024ull * 1024);
  conv_job(lds, p.wv, win, 12288, 1024, 3072, 1024, WB + W1B);
  conv_job(lds, p.wv, win, 12288, 1024, 8192, 4096, WB + W1B + 1024ull * 1024);
  conv_job(lds, p.wv, p.w_pa + (size_t)l * 1024 * 1024, 1024, 1024, 0, 1024, WB + WPA);
  conv_job(lds, p.wv, p.w_pb + (size_t)l * 2048 * 1024, 1024, 2048, 0, 1024, WB + WPB);
  conv_job(lds, p.wv, p.w_o + (size_t)l * 1024 * 1024, 1024, 1024, 0, 1024, WB + WO);
  conv_job(lds, p.wv, p.w_up + (size_t)l * 1024 * 4096, 4096, 1024, 0, 4096, WB + WUP);
  conv_job(lds, p.wv, p.w_down + (size_t)l * 4096 * 1024, 1024, 4096, 0, 1024, WB + WDN);
}
__device__ __forceinline__ void phase_mod(ldsp lds, const Params& p) {
  float* small = (float*)(p.ws + OFF_SMALL);
  const int tid = otid(p.wv);
  const int bid = obid();
  if (bid < 24) {
    LAS float* cond = (LAS float*)lds;
    for (int i = tid; i < 8192; i += 512) cond[i] = siluf_(p.c[i]);
    __syncthreads();
    const int o = bid * 512 + tid, l = o / 6144, n = o - l * 6144;
    const float* w = p.w_ada + (size_t)l * 1024 * 6144 + n;
    float a[8];
#pragma unroll
    for (int b = 0; b < 8; ++b) a[b] = 0.f;
    for (int k = 0; k < 1024; ++k) {
      const float wv = w[(size_t)k * 6144];
#pragma unroll
      for (int b = 0; b < 8; ++b) a[b] += cond[b * 1024 + k] * wv;
    }
    const float bb = p.b_ada[l * 6144 + n];
#pragma unroll
    for (int b = 0; b < 8; ++b) small[SM_MOD + (size_t)l * 8 * 6144 + b * 6144 + n] = a[b] + bb;
    __syncthreads();
  } else if (bid == 24) {
    for (int i = tid; i < 1024; i += 512) {
      const float a = p.lb_logits[i], b = p.lb_logits[1024 + i], mx = fmaxf(a, b);
      const float ea = __expf(a - mx), eb = __expf(b - mx);
      small[SM_LB + i] = 0.f; small[SM_LB + 1024 + i] = eb / (ea + eb);
    }
  }
}
__device__ __forceinline__ void phase_u0(const Params& p) {
  const float* mod = (const float*)(p.ws + OFF_SMALL) + SM_MOD;
  bf16_t* U = (bf16_t*)(p.ws + OFF_U);
  const size_t n4 = (size_t)T_ALL * 1024 / 4;
  for (size_t i = (size_t)obid() * 512 + otid(p.wv); i < n4; i += (size_t)gridDim.x * 512) {
    const size_t e = i * 4; const int t = (int)(e >> 10), cc = (int)(e & 1023), b = t >> 12;
    const f32x4 xv = *(const f32x4*)(p.x + e), sh = *(const f32x4*)(mod + b * 6144 + cc), sc = *(const f32x4*)(mod + b * 6144 + 1024 + cc);
    u32x2 o; o[0] = pk2(xv[0] * (1.f + sc[0]) + sh[0], xv[1] * (1.f + sc[1]) + sh[1]); o[1] = pk2(xv[2] * (1.f + sc[2]) + sh[2], xv[3] * (1.f + sc[3]) + sh[3]);
    *(u32x2*)(U + e) = o;
  }
}
__device__ __forceinline__ void phase_ln(const Params& p, const float* gam, const float* bet, int lm, int s_shift, bool fin) {
  float* XB = (float*)(p.ws + OFF_XB);
  const float* mod = (const float*)(p.ws + OFF_SMALL) + SM_MOD + (size_t)lm * 8 * 6144;
  bf16_t* U = (bf16_t*)(p.ws + OFF_U);
  const int tid_ = otid(p.wv); const int lane = tid_ & 63, gw = obid() * 8 + (tid_ >> 6), nw = gridDim.x * 8;
  for (int row = gw; row < T_ALL; row += nw) {
    const float* src = XB + (size_t)row * 1024;
    f32x4 v[4]; float s = 0.f;
#pragma unroll
    for (int k = 0; k < 4; ++k) { v[k] = *(const f32x4*)(src + 256 * k + 4 * lane); s += v[k][0] + v[k][1] + v[k][2] + v[k][3]; }
    const float mu = wave_sum(s, lane) * (1.0f / 1024.0f);
    float q = 0.f;
#pragma unroll
    for (int k = 0; k < 4; ++k)
#pragma unroll
      for (int i = 0; i < 4; ++i) { const float d = v[k][i] - mu; q += d * d; }
    const float rstd = rsqrtf(wave_sum(q, lane) * (1.0f / 1024.0f) + 1e-5f);
    const int b = row >> 12;
#pragma unroll
    for (int k = 0; k < 4; ++k) {
      const int cc = 256 * k + 4 * lane;
      const f32x4 gg = *(const f32x4*)(gam + cc), bb = *(const f32x4*)(bet + cc);
      f32x4 y;
#pragma unroll
      for (int i = 0; i < 4; ++i) y[i] = (v[k][i] - mu) * rstd * gg[i] + bb[i];
      if (fin) { *(f32x4*)(p.out + (size_t)row * 1024 + cc) = y; }
      else {
        *(f32x4*)(XB + (size_t)row * 1024 + cc) = y;
        const f32x4 sh = *(const f32x4*)(mod + b * 6144 + s_shift * 1024 + cc), sc = *(const f32x4*)(mod + b * 6144 + (s_shift + 1) * 1024 + cc);
        u32x2 o; o[0] = pk2(y[0] * (1.f + sc[0]) + sh[0], y[1] * (1.f + sc[1]) + sh[1]); o[1] = pk2(y[2] * (1.f + sc[2]) + sh[2], y[3] * (1.f + sc[3]) + sh[3]);
        *(u32x2*)(U + (size_t)row * 1024 + cc) = o;
      }
    }
  }
}
template <class T> __device__ __forceinline__ T* vaddr(T* q) { asm volatile("" : "+v"(q)); return q; }
__device__ __forceinline__ void ret_item(ldsp lds, const Params& p, int item) {
  constexpr int KS = 0, KTS = 33792, VTS = 70656, STS = 79872, PS = 113664;
  const int es = item & 7, h = (item >> 3) & 3, bl = item >> 5;
  const int tid = otid(p.wv), w = tid >> 6, lane = tid & 63, fr = lane & 15, fq = lane >> 4;
  unsigned char* R0 = oaddr(p.ws) + OFF_R0; unsigned char* DO = (unsigned char*)oaddr(p.out);
  const bf16_t* Qr = (const bf16_t*)(R0 + R_QR); const bf16_t* Kr = (const bf16_t*)(R0 + R_KR); const bf16_t* KrT = (const bf16_t*)(R0 + R_KRT);
  const bf16_t* VrT = (const bf16_t*)(DO + D_VRT); bf16_t* OrB = (bf16_t*)(R0 + R_ORB);
  float* stR = (float*)(p.ws + OFF_SMALL) + SM_STR;
  const float gam = 1.0f - __builtin_amdgcn_exp2f(-5.0f - (float)h), lg2 = __log2f(gam), g64 = __builtin_amdgcn_exp2f(lg2 * 64.0f);
  const int it = w >> 1, eh = w & 1;
  f32x4 st[2][4];
#pragma unroll
  for (int a = 0; a < 2; ++a)
#pragma unroll
    for (int b = 0; b < 4; ++b) st[a][b] = (f32x4){0.f, 0.f, 0.f, 0.f};
  const float rowscale = __builtin_amdgcn_exp2f(lg2 * (float)(16 * it + fr - 63));
  u32x4 kreg[4], ktreg[4], vtreg; bf16x8 qn[8];
#define RET_LOADS(TOK) do { \
    const bf16_t* kbase = vaddr(Kr + (size_t)((TOK) + (tid >> 5)) * 1024 + h * 256 + (tid & 31) * 8); \
    const bf16_t* ktbase = vaddr(KrT + (size_t)(h * 256 + (tid >> 3)) * TG + (TOK) + (tid & 7) * 8); \
    const bf16_t* vtbase = vaddr(VrT + (size_t)(h * 512 + es * 64 + (tid >> 3)) * TG + (TOK) + (tid & 7) * 8); \
    const bf16_t* qbase = vaddr(Qr + (size_t)((TOK) + 16 * it + fr) * 1024 + h * 256 + fq * 8); \
    _Pragma("unroll") for (int i = 0; i < 4; ++i) kreg[i] = *(const u32x4*)(kbase + (size_t)i * 16 * 1024); \
    _Pragma("unroll") for (int i = 0; i < 4; ++i) ktreg[i] = *(const u32x4*)(ktbase + (size_t)i * 64 * TG); \
    vtreg = *(const u32x4*)vtbase; \
    _Pragma("unroll") for (int ks = 0; ks < 8; ++ks) qn[ks] = *(const bf16x8*)(qbase + ks * 32); } while (0)
  RET_LOADS(bl * SEQ);
  for (int n = 0; n < 64; ++n) {
    const int tok0 = bl * SEQ + n * 64;
    bf16x8 qf[8];
    bf16_t* obase = vaddr(OrB + (size_t)(tok0 + 16 * it + fr) * 2048 + h * 512 + es * 64 + 32 * eh + 4 * fq);
    float* sbase = vaddr(stR + ((size_t)(tok0 + 16 * it + fr) * 4 + h) * 2);
#pragma unroll
    for (int ks = 0; ks < 8; ++ks) qf[ks] = qn[ks];
    __builtin_amdgcn_sched_barrier(0);
#pragma unroll
    for (int dt = 0; dt < 2; ++dt)
#pragma unroll
      for (int et = 0; et < 4; ++et) {
        u32x2 o; o[0] = pk2(st[dt][et][0], st[dt][et][1]); o[1] = pk2(st[dt][et][2], st[dt][et][3]);
        *(LAS u32x2*)(lds + STS + (16 * et + fr) * 528 + (32 * w + 16 * dt + 4 * fq) * 2) = o;
      }
#pragma unroll
    for (int i = 0; i < 4; ++i) { const int c = tid + 512 * i, r = c >> 5, ch = c & 31; *(LAS u32x4*)(lds + KS + r * 528 + ch * 16) = kreg[i]; }
#pragma unroll
    for (int i = 0; i < 4; ++i) { const int c = tid + 512 * i, r = c >> 3, ch = c & 7; *(LAS u32x4*)(lds + KTS + r * 144 + ch * 16) = ktreg[i]; }
    { const int r = tid >> 3, ch = tid & 7; *(LAS u32x4*)(lds + VTS + r * 144 + ch * 16) = vtreg; }
    __syncthreads();
    { const int tokn = bl * SEQ + (n < 63 ? n + 1 : 63) * 64; RET_LOADS(tokn); }
    __builtin_amdgcn_sched_barrier(0);
#pragma unroll
    for (int jj = 0; jj < 2; ++jj) {
      const int jt = 2 * eh + jj;
      f32x4 sc = (f32x4){0.f, 0.f, 0.f, 0.f};
#pragma unroll
      for (int ks = 0; ks < 8; ++ks) sc = mfma16(ldfrag(lds, KS + (16 * jt + fr) * 528 + (32 * ks + 8 * fq) * 2), qf[ks], sc);
      const int i_ = 16 * it + fr, j0 = 16 * jt + 4 * fq;
      u32x2 o; o[0] = pk2(j0 + 0 <= i_ ? sc[0] : 0.f, j0 + 1 <= i_ ? sc[1] : 0.f); o[1] = pk2(j0 + 2 <= i_ ? sc[2] : 0.f, j0 + 3 <= i_ ? sc[3] : 0.f);
      *(LAS u32x2*)(lds + PS + i_ * 144 + j0 * 2) = o;
    }
    __syncthreads();
    __builtin_amdgcn_sched_barrier(0);
    float s1 = 0.f, s2 = 0.f;
#pragma unroll
    for (int ee = 0; ee < 2; ++ee) {
      const int et = 2 * eh + ee;
      f32x4 o = (f32x4){0.f, 0.f, 0.f, 0.f};
#pragma unroll
      for (int k2 = 0; k2 < 2; ++k2) o = mfma16(ldfrag(lds, VTS + (16 * et + fr) * 144 + (32 * k2 + 8 * fq) * 2), ldfrag(lds, PS + (16 * it + fr) * 144 + (32 * k2 + 8 * fq) * 2), o);
#pragma unroll
      for (int ks = 0; ks < 8; ++ks) o = mfma16(ldfrag(lds, STS + (16 * et + fr) * 528 + (32 * ks + 8 * fq) * 2), qf[ks], o);
#pragma unroll
      for (int r = 0; r < 4; ++r) { o[r] *= rowscale; s1 += o[r]; s2 += o[r] * o[r]; }
      u32x2 ov; ov[0] = pk2(o[0], o[1]); ov[1] = pk2(o[2], o[3]);
      *(u32x2*)(obase + 16 * ee) = ov;
    }
    s1 += shx(s1, 16, lane); s1 += shx(s1, 32, lane); s2 += shx(s2, 16, lane); s2 += shx(s2, 32, lane);
    if (fq == 0) { unsafeAtomicAdd(sbase, s1); unsafeAtomicAdd(sbase + 1, s2); }
    __builtin_amdgcn_sched_barrier(0);
#pragma unroll
    for (int k2 = 0; k2 < 2; ++k2) {
      bf16x8 vf[4];
#pragma unroll
      for (int et = 0; et < 4; ++et) vf[et] = ldfrag(lds, VTS + (16 * et + fr) * 144 + (32 * k2 + 8 * fq) * 2);
#pragma unroll
      for (int dt = 0; dt < 2; ++dt) {
        const bf16x8 kf = ldfrag(lds, KTS + (32 * w + 16 * dt + fr) * 144 + (32 * k2 + 8 * fq) * 2);
#pragma unroll
        for (int et = 0; et < 4; ++et) st[dt][et] = mfma16(kf, vf[et], st[dt][et]);
      }
    }
#pragma unroll
    for (int dt = 0; dt < 2; ++dt)
#pragma unroll
      for (int et = 0; et < 4; ++et)
#pragma unroll
        for (int r = 0; r < 4; ++r) st[dt][et][r] *= g64;
    __syncthreads();
  }
}
__device__ __forceinline__ void hgrn_item(ldsp lds, const Params& p, int item) {
  constexpr int QT = 0, KT = 17408, QB = 34816, KBT = 52224, VTS = 70656, STS = 75264, PS = 83968, TOT = 93184, DEC = 97280;
  const int es = item & 3, h = (item >> 2) & 7, bl = item >> 5;
  const int tid = otid(p.wv), w = tid >> 6, lane = tid & 63, fr = lane & 15, fq = lane >> 4;
  unsigned char* R0 = oaddr(p.ws) + OFF_R0; unsigned char* DO = (unsigned char*)oaddr(p.out);
  const bf16_t* Qh = (const bf16_t*)(R0 + R_QH); const float* LF = (const float*)(DO + D_LF); const bf16_t* ViT = (const bf16_t*)(R0 + R_VIT);
  bf16_t* OrA = (bf16_t*)(R0 + R_ORA);
  float* stH = (float*)(p.ws + OFF_SMALL) + SM_STH;
  LAS float* tot = (LAS float*)(lds + TOT); LAS float* dec = (LAS float*)(lds + DEC);
  const int it = w >> 1, eh = w & 1, d0 = 2 * lane;
  f32x4 st[2];
  st[0] = (f32x4){0.f, 0.f, 0.f, 0.f}; st[1] = (f32x4){0.f, 0.f, 0.f, 0.f};
  float lxn[8], lyn[8]; unsigned q2n[8]; u32x4 vtreg;
#define HG_LOADS(TOK) do { \
    const float* lfbase = vaddr(LF + (size_t)((TOK) + 8 * w) * 1024 + h * 128 + d0); \
    const bf16_t* qhbase = vaddr(Qh + (size_t)((TOK) + 8 * w) * 1024 + h * 128 + d0); \
    const bf16_t* vtbase = vaddr(ViT + (size_t)(h * 128 + es * 32 + ((tid & 255) >> 3)) * TG + (TOK) + (tid & 7) * 8); \
    _Pragma("unroll") for (int jj = 0; jj < 8; ++jj) { \
      const float2 t = *(const float2*)(lfbase + (size_t)jj * 1024); lxn[jj] = t.x; lyn[jj] = t.y; q2n[jj] = *(const unsigned*)(qhbase + (size_t)jj * 1024); } \
    vtreg = *(const u32x4*)vtbase; } while (0)
  HG_LOADS(bl * SEQ);
  for (int n = 0; n < 64; ++n) {
    const int tok0 = bl * SEQ + n * 64;
    float lx[8], ly[8]; unsigned q2[8];
    bf16_t* obase = vaddr(OrA + (size_t)(tok0 + 16 * it + fr) * 1024 + h * 128 + es * 32 + 16 * eh + 4 * fq);
    float* sbase = vaddr(stH + (size_t)(tok0 + 16 * it + fr) * 8 + h);
#pragma unroll
    for (int jj = 0; jj < 8; ++jj) { lx[jj] = lxn[jj]; ly[jj] = lyn[jj]; q2[jj] = q2n[jj]; }
    __builtin_amdgcn_sched_barrier(0);
    float px[8], py[8]; float cx = 0.f, cy = 0.f;
#pragma unroll
    for (int jj = 0; jj < 8; ++jj) { cx += lx[jj]; cy += ly[jj]; px[jj] = cx; py[jj] = cy; }
    tot[w * 128 + d0] = cx; tot[w * 128 + d0 + 1] = cy;
#pragma unroll
    for (int et = 0; et < 2; ++et) {
      u32x2 o; o[0] = pk2(st[et][0], st[et][1]); o[1] = pk2(st[et][2], st[et][3]);
      *(LAS u32x2*)(lds + STS + (16 * et + fr) * 272 + (16 * w + 4 * fq) * 2) = o;
    }
    if (tid < 256) { const int r = tid >> 3, ch = tid & 7; *(LAS u32x4*)(lds + VTS + r * 144 + ch * 16) = vtreg; }
    __syncthreads();
    { const int tokn = bl * SEQ + (n < 63 ? n + 1 : 63) * 64; HG_LOADS(tokn); }
    float offx = 0.f, offy = 0.f, rx = 0.f, ry = 0.f, bx = 0.f, by = 0.f;
#pragma unroll
    for (int q = 0; q < 8; ++q) {
      const float tx = tot[q * 128 + d0], ty = tot[q * 128 + d0 + 1];
      if (q < w) { offx += tx; offy += ty; }
      if (q < 4) { rx += tx; ry += ty; }
      bx += tx; by += ty;
    }
    if (w == 0) { dec[d0] = __expf(bx); dec[d0 + 1] = __expf(by); }
    unsigned kbx[4], kby[4];
#pragma unroll
    for (int jj = 0; jj < 8; ++jj) {
      const float Bx = offx + px[jj], By = offy + py[jj];
      const float qx = bflo(q2[jj]), qy = bfhi(q2[jj]);
      const float kx = 1.0f - __expf(lx[jj]), ky = 1.0f - __expf(ly[jj]);
      const float e1x = __expf(fminf(fmaxf(Bx - rx, -80.f), 80.f)), e1y = __expf(fminf(fmaxf(By - ry, -80.f), 80.f));
      const float e2x = __expf(fminf(fmaxf(rx - Bx, -80.f), 80.f)), e2y = __expf(fminf(fmaxf(ry - By, -80.f), 80.f));
      const int j = 8 * w + jj;
      *(LAS unsigned*)(lds + QT + j * 272 + d0 * 2) = pk2(qx * e1x, qy * e1y);
      *(LAS unsigned*)(lds + KT + j * 272 + d0 * 2) = pk2(kx * e2x, ky * e2y);
      *(LAS unsigned*)(lds + QB + j * 272 + d0 * 2) = pk2(qx * __expf(Bx), qy * __expf(By));
      const float kbvx = kx * __expf(bx - Bx), kbvy = ky * __expf(by - By);
      if (jj & 1) { kbx[jj >> 1] = pk2(__uint_as_float(kbx[jj >> 1]), kbvx); kby[jj >> 1] = pk2(__uint_as_float(kby[jj >> 1]), kbvy); }
      else { kbx[jj >> 1] = __float_as_uint(kbvx); kby[jj >> 1] = __float_as_uint(kbvy); }
    }
    *(LAS u32x4*)(lds + KBT + d0 * 144 + (8 * w) * 2) = (u32x4){kbx[0], kbx[1], kbx[2], kbx[3]};
    *(LAS u32x4*)(lds + KBT + (d0 + 1) * 144 + (8 * w) * 2) = (u32x4){kby[0], kby[1], kby[2], kby[3]};
    __syncthreads();
    __builtin_amdgcn_sched_barrier(0);
#pragma unroll
    for (int jj = 0; jj < 2; ++jj) {
      const int jt = 2 * eh + jj;
      f32x4 sc = (f32x4){0.f, 0.f, 0.f, 0.f};
#pragma unroll
      for (int ks = 0; ks < 4; ++ks) sc = mfma16(ldfrag(lds, KT + (16 * jt + fr) * 272 + (32 * ks + 8 * fq) * 2), ldfrag(lds, QT + (16 * it + fr) * 272 + (32 * ks + 8 * fq) * 2), sc);
      const int i_ = 16 * it + fr, j0 = 16 * jt + 4 * fq;
      u32x2 o; o[0] = pk2(j0 + 0 <= i_ ? sc[0] : 0.f, j0 + 1 <= i_ ? sc[1] : 0.f); o[1] = pk2(j0 + 2 <= i_ ? sc[2] : 0.f, j0 + 3 <= i_ ? sc[3] : 0.f);
      *(LAS u32x2*)(lds + PS + i_ * 144 + j0 * 2) = o;
    }
    __syncthreads();
    __builtin_amdgcn_sched_barrier(0);
    {
      f32x4 o = (f32x4){0.f, 0.f, 0.f, 0.f};
#pragma unroll
      for (int k2 = 0; k2 < 2; ++k2) o = mfma16(ldfrag(lds, VTS + (16 * eh + fr) * 144 + (32 * k2 + 8 * fq) * 2), ldfrag(lds, PS + (16 * it + fr) * 144 + (32 * k2 + 8 * fq) * 2), o);
#pragma unroll
      for (int ks = 0; ks < 4; ++ks) o = mfma16(ldfrag(lds, STS + (16 * eh + fr) * 272 + (32 * ks + 8 * fq) * 2), ldfrag(lds, QB + (16 * it + fr) * 272 + (32 * ks + 8 * fq) * 2), o);
      float s2 = o[0] * o[0] + o[1] * o[1] + o[2] * o[2] + o[3] * o[3];
      u32x2 ov; ov[0] = pk2(o[0], o[1]); ov[1] = pk2(o[2], o[3]);
      *(u32x2*)obase = ov;
      s2 += shx(s2, 16, lane); s2 += shx(s2, 32, lane);
      if (fq == 0) unsafeAtomicAdd(sbase, s2);
    }
    __builtin_amdgcn_sched_barrier(0);
    {
      const f32x4 dv = *(const LAS f32x4*)(dec + 16 * w + 4 * fq);
#pragma unroll
      for (int et = 0; et < 2; ++et)
#pragma unroll
        for (int r = 0; r < 4; ++r) st[et][r] *= dv[r];
#pragma unroll
      for (int k2 = 0; k2 < 2; ++k2) {
        const bf16x8 kf = ldfrag(lds, KBT + (16 * w + fr) * 144 + (32 * k2 + 8 * fq) * 2);
#pragma unroll
        for (int et = 0; et < 2; ++et) st[et] = mfma16(kf, ldfrag(lds, VTS + (16 * et + fr) * 144 + (32 * k2 + 8 * fq) * 2), st[et]);
      }
    }
    __syncthreads();
  }
}
#ifndef REP_G4
#define REP_G4 1
#endif
#ifndef REP_SYNC
#define REP_SYNC 1
#endif
#ifndef REP_PRO
#define REP_PRO 1
#endif
#ifndef REP_S1
#define REP_S1 1
#endif
enum { ST_G1 = 0, ST_S1, ST_G1B, ST_G2, ST_G3, ST_L1, ST_G4, ST_G5, ST_L2 };
__global__ void __launch_bounds__(512, 2) mega(Params p0) {
  extern __shared__ __attribute__((aligned(16))) unsigned char shm[];
  ldsp lds = (ldsp)shm;
  cg::grid_group grid = cg::this_grid();
  Params p = p0; p.ws = oaddr(p0.ws); p.out = oaddr(p0.out); p.wv = __builtin_amdgcn_readfirstlane((int)(threadIdx.x >> 6));
  volatile LAS unsigned* xst = (volatile LAS unsigned*)(lds + 131072);
  if (threadIdx.x < 4) xst[threadIdx.x] = 0u;
  __syncthreads();
  (void)xcd_barrier_post((unsigned*)(p0.ws + OFF_SMALL + SM_BAR_BYTES), xst);
  for (int r = 0; r < REP_PRO; ++r) {
    p.ws = oaddr(p0.ws);
    phase_mod(lds, p);
    phase_conv(lds, p, 0);
    grid.sync();
  }
  phase_u0(p);
  gbar((unsigned*)(p0.ws + OFF_SMALL + SM_BAR_BYTES), xst);
  for (int pc = 0; pc < 28; ++pc) {
    p.ws = oaddr(p0.ws); p.out = oaddr(p0.out);
    const bf16_t* WB = (const bf16_t*)(p.ws + OFF_WB);
    const bf16_t* U = (const bf16_t*)(p.ws + OFF_U);
    unsigned char* R0 = p.ws + OFF_R0;
    const int l = pc / 14, k = pc - l * 14;
    int g = 0, stg;
    if (k < 10) { g = k / 5; stg = k - g * 5; } else stg = ST_L1 + (k - 10);
    int nj = 0, jmode0 = 0, jmode1 = 0; const bf16_t* jA0 = nullptr; const bf16_t* jA1 = nullptr; const bf16_t* jB0 = nullptr; const bf16_t* jB1 = nullptr;
    int jM0 = 0, jM1 = 0, jN0 = 0, jN1 = 0, jK0 = 0, jK1 = 0;
    if (stg == ST_G1) {
      float* stz = (float*)(p.ws + OFF_SMALL) + SM_STR;
      for (int i = obid() * 512 + otid(p.wv); i < TG * 16; i += gridDim.x * 512) stz[i] = 0.f;
      nj = 2;
      jmode0 = MD_G1A; jA0 = U + (size_t)g * TG * 1024; jB0 = WB + W1A; jM0 = TG; jN0 = 4096; jK0 = 1024;
      jmode1 = MD_G1S; jA1 = WB + W1S; jB1 = U + (size_t)g * TG * 1024; jM1 = 4096; jN1 = TG; jK1 = 1024;
    } else if (stg == ST_S1) {
      for (int rep = 0; rep < REP_S1; ++rep) {
        if (rep) { gbar((unsigned*)(p0.ws + OFF_SMALL + SM_BAR_BYTES), xst); float* stz = (float*)(p.ws + OFF_SMALL) + SM_STR; for (int i = obid() * 512 + otid(p.wv); i < TG * 16; i += gridDim.x * 512) stz[i] = 0.f; gbar((unsigned*)(p0.ws + OFF_SMALL + SM_BAR_BYTES), xst); }
        const int bid = obid();
        if (bid < 128) ret_item(lds, p, bid); else hgrn_item(lds, p, bid - 128);
      }
    } else if (stg == ST_G1B) {
      nj = 1; jmode0 = MD_G1B; jA0 = U + (size_t)g * TG * 1024; jB0 = WB + W1B; jM0 = TG; jN0 = 5120; jK0 = 1024;
    } else if (stg == ST_G2) {
      nj = 2;
      jmode0 = MD_G2A; jA0 = (const bf16_t*)(R0 + R_ORA); jB0 = WB + WPA; jM0 = TG; jN0 = 1024; jK0 = 1024;
      jmode1 = MD_G2B; jA1 = (const bf16_t*)(R0 + R_ORB); jB1 = WB + WPB; jM1 = TG; jN1 = 1024; jK1 = 2048;
    } else if (stg == ST_G3) {
      nj = 1; jmode0 = MD_G3; jA0 = (const bf16_t*)(R0 + R_MG); jB0 = WB + WO; jM0 = TG; jN0 = 1024; jK0 = 1024;
    } else if (stg == ST_L1) {
      phase_ln(p, p.ln1_g + l * 1024, p.ln1_b + l * 1024, l, 3, false);
    } else if (stg == ST_G4) {
      nj = 1; jmode0 = MD_G4; jA0 = U; jB0 = WB + WUP; jM0 = T_ALL; jN0 = 4096; jK0 = 1024;
    } else if (stg == ST_G5) {
      nj = 1; jmode0 = MD_G5; jA0 = (const bf16_t*)R0; jB0 = WB + WDN; jM0 = T_ALL; jN0 = 1024; jK0 = 4096;
    } else {
      phase_ln(p, p.ln2_g + l * 1024, p.ln2_b + l * 1024, l == 0 ? 1 : 0, 0, l == 1);
      if (l == 0) phase_conv(lds, p, 1);
    }
    for (int j = 0; j < nj * (stg == ST_G4 ? REP_G4 : 1); ++j) {
      pg8::Gemm gm; const bool j1 = (nj == 2 && j == 1); gm.A = j1 ? jA1 : jA0; gm.Bt = j1 ? jB1 : jB0; gm.M = j1 ? jM1 : jM0; gm.N = j1 ? jN1 : jN0; gm.K = j1 ? jK1 : jK0;
      pg8::StaticOrder S; S.init(gm.M, gm.N, (int)gridDim.x, obid());
      EpiP E; E.mode = j1 ? jmode1 : jmode0; E.l = l; E.g = g; E.pp = &p;
      pg8::gemm_phase<EpiP, pg8::StaticOrder, false>((PG8_LAS unsigned char*)shm, gm, S, E, nullptr);
    }
    for (int r = 0; r < REP_SYNC; ++r) gbar((unsigned*)(p0.ws + OFF_SMALL + SM_BAR_BYTES), xst);
  }
}

extern "C" void kernel_launch(void* const* d_in, const int* in_sizes, int n_in, void* d_out, int out_size,
                              void* d_ws, size_t ws_size, hipStream_t stream) {
  constexpr size_t kDynLds = 131072 + 16;
  static int configured = 0;
  if (!configured) {
    (void)hipFuncSetAttribute((const void*)mega, hipFuncAttributeMaxDynamicSharedMemorySize, (int)kDynLds);
    configured = 1;
  }
  Params p{};
  p.x = (const float*)d_in[0]; p.c = (const float*)d_in[1]; p.pos = (const int*)d_in[2]; p.lb_logits = (const float*)d_in[3];
  p.w_ada = (const float*)d_in[4]; p.b_ada = (const float*)d_in[5]; p.w_in = (const float*)d_in[6]; p.w_pa = (const float*)d_in[7];
  p.w_pb = (const float*)d_in[8]; p.w_o = (const float*)d_in[9]; p.ln1_g = (const float*)d_in[10]; p.ln1_b = (const float*)d_in[11];
  p.w_up = (const float*)d_in[12]; p.b_up = (const float*)d_in[13]; p.w_down = (const float*)d_in[14]; p.b_down = (const float*)d_in[15];
  p.ln2_g = (const float*)d_in[16]; p.ln2_b = (const float*)d_in[17];
  p.out = (float*)d_out; p.ws = (unsigned char*)d_ws;
  if (ws_size < 512ull * 1024 * 1024) { fprintf(stderr, "workspace too small\n"); return; }
  (void)hipMemsetAsync((unsigned char*)d_ws + OFF_SMALL + SM_BAR_BYTES, 0, XCD_BAR_WORDS * 4, stream);
  void* args[] = {&p};
  hipError_t e = hipLaunchCooperativeKernel((void*)mega, dim3(256), dim3(512), args, kDynLds, stream);
  if (e != hipSuccess) fprintf(stderr, "cooperative launch failed: %s\n", hipGetErrorString(e));
}
```

```cpp
#include <hip/hip_runtime.h>
#include <hip/hip_cooperative_groups.h>
#include <cstdio>
namespace cg = cooperative_groups;
__device__ __forceinline__ int otid(int wv) { int t = (wv << 6) | (int)__builtin_amdgcn_mbcnt_hi(~0u, __builtin_amdgcn_mbcnt_lo(~0u, 0u)); asm volatile("" : "+v"(t)); return t; }
__device__ __forceinline__ int obid() { int t = blockIdx.x; asm volatile("" : "+s"(t)); return t; }
template <class T> __device__ __forceinline__ T* oaddr(T* q) { asm volatile("" : "+s"(q)); return q; }
namespace pg8 {
#define PG8_LAS __attribute__((address_space(3)))
typedef unsigned short bf16_t;
typedef short bf16x8 __attribute__((ext_vector_type(8)));
typedef float f32x4 __attribute__((ext_vector_type(4)));
typedef unsigned u32x4 __attribute__((ext_vector_type(4)));
constexpr int BM = 256, BK = 64, HALF = 128, HTB = HALF * BK * 2  , STAGE_BYTES = 8 * HTB, NXCD = 8, WGM = 8;

__host__ __device__ __forceinline__ int lds_byte(int r, int c) { const int st = (r >> 4) * 2 + (c >> 5), rr = r & 15, cc = c & 31, ob = rr * 64 + cc * 2; return st * 1024 + (ob ^ (((ob >> 9) & 1) << 5)); }
__host__ __device__ __forceinline__ void stage_rc(int b, int& R, int& C) { const int st = b / 1024, sb = b % 1024, swz = sb ^ (((sb >> 9) & 1) << 5); R = (st >> 1) * 16 + swz / 64; C = (st & 1) * 32 + (swz % 64) / 2; }
__host__ __device__ __forceinline__ int perm32(int rho) { const int n = rho >> 4, i = rho & 15; return 8 * (i >> 2) + 4 * n + (i & 3); }

struct Unit { int pm, pn; };
struct Gemm { const bf16_t* A; const bf16_t* Bt; int M, N, K; };

struct StaticOrder {
    int nM, nN, nwg, G, c;
    __host__ __device__ void init(int M, int N, int G_, int c_) { nM = M / BM; nN = N / BM; nwg = nM * nN; G = G_; c = c_; }
    __host__ __device__ bool next(int i, Unit& u) const {
        const long L = (long)i * G + c; if (L >= nwg) return false;
        int wgid = (int)L; { const int q = nwg / NXCD, r = nwg % NXCD, xcd = wgid % NXCD, off = wgid / NXCD; wgid = (xcd < r ? xcd * (q + 1) : r * (q + 1) + (xcd - r) * q) + off; }
        const int nig = WGM * nN, gid = wgid / nig, fm = gid * WGM, gsz = (nM - fm) < WGM ? (nM - fm) : WGM;
        u.pm = fm + ((wgid % nig) % gsz); u.pn = (wgid % nig) / gsz; return true;
    }
    __device__ __forceinline__ void a_ready(const Unit&) const {}
    __device__ __forceinline__ void done(const Unit&) const {}
};
__device__ __forceinline__ unsigned cvt_pk_bf16(float lo, float hi) { unsigned r; asm volatile("v_cvt_pk_bf16_f32 %0, %1, %2" : "=v"(r) : "v"(lo), "v"(hi)); return r; }

template <class Epi, class Sched, bool STAMP = false>
__device__ __forceinline__ void gemm_phase(PG8_LAS unsigned char* lds, const Gemm g, const Sched& S, const Epi& E, unsigned long long* stamps) {
    const int tid = otid(E.pp->wv), wid = __builtin_amdgcn_readfirstlane(tid >> 6), lane = tid & 63, wr = wid >> 2, wc = wid & 3, fr = lane & 15, fq = lane >> 4;
    const int K = g.K, nt = K / BK;
    int ts_lo = 0, ts_hi = 0, nts = 0; const unsigned long long rt_entry = STAMP ? (unsigned long long)wall_clock64() : 0ull;
#define PG8_STAMP() do { if (STAMP && wid == 0 && nts < 64) { const unsigned long long _c = (unsigned long long)clock64(); \
        ts_lo = (lane == nts) ? (int)(unsigned)_c : ts_lo; ts_hi = (lane == nts) ? (int)(unsigned)(_c >> 32) : ts_hi; ++nts; } } while (0)
    PG8_STAMP();
    unsigned voffA[2], voffB[2];
#pragma unroll
    for (int i = 0; i < 2; ++i) { int R, C; stage_rc(tid * 16 + i * 8192, R, C); const int Rb = Epi::PERM ? ((R & ~31) + perm32(R & 31)) : R;
        voffA[i] = (unsigned)(R * K + C) * 2u; voffB[i] = (unsigned)(Rb * K + C) * 2u; }
    const size_t kstep = (size_t)(BK * 2);
    const size_t hstep = (size_t)HALF * K * 2;
    const size_t tstep = 2 * hstep;
    const unsigned ldsw = (unsigned)wid * 1024u;
    const int aoff = lds_byte(wr * 64 + fr, fq * 8), boff = lds_byte(wc * 32 + fr, fq * 8);
#define PG8_SA(b, h) (((b) * 2 + (h)) * HTB)
#define PG8_SB(b, h) ((4 + (b) * 2 + (h)) * HTB)
#define PG8_STAGE(bufoff, gbase, voff) do { _Pragma("unroll") for (int _i = 0; _i < 2; ++_i) \
        __builtin_amdgcn_global_load_lds((const unsigned*)((const char*)(gbase) + (voff)[_i]), (PG8_LAS unsigned*)(lds + (bufoff) + ldsw + _i * 8192), 16, 0, 0); } while (0)
#define PG8_LDA(dst, b, h) do { _Pragma("unroll") for (int m = 0; m < 4; ++m) _Pragma("unroll") for (int k = 0; k < 2; ++k) dst[m][k] = *(const PG8_LAS bf16x8*)(lds + PG8_SA(b, h) + aoff + m * 2048 + k * 1024); } while (0)
#define PG8_LDB(dst, b, h) do { _Pragma("unroll") for (int n = 0; n < 2; ++n) _Pragma("unroll") for (int k = 0; k < 2; ++k) dst[n][k] = *(const PG8_LAS bf16x8*)(lds + PG8_SB(b, h) + boff + n * 2048 + k * 1024); } while (0)
#define PG8_MMA(ai, bj, At, Bt) do { __builtin_amdgcn_s_setprio(1); _Pragma("unroll") for (int m = 0; m < 4; ++m) _Pragma("unroll") for (int n = 0; n < 2; ++n) _Pragma("unroll") for (int k = 0; k < 2; ++k) \
        acc[ai][bj][m][n] = __builtin_amdgcn_mfma_f32_16x16x32_bf16(Bt[n][k], At[m][k], acc[ai][bj][m][n], 0, 0, 0); __builtin_amdgcn_s_setprio(0); } while (0)
#define PG8_WAIT_V(n) asm volatile("s_waitcnt vmcnt(" #n ")" ::: "memory")
#define PG8_WAIT_L(n) asm volatile("s_waitcnt lgkmcnt(" #n ")" ::: "memory")
#define PG8_BAR __builtin_amdgcn_s_barrier()
#define PG8_SCHED __builtin_amdgcn_sched_barrier(0)
    Unit cur, nxt; int ui = 0;
    if (!S.next(0, cur)) return;
    f32x4 acc[2][2][4][2];
#pragma unroll
    for (int a = 0; a < 2; ++a)
#pragma unroll
        for (int b = 0; b < 2; ++b)
#pragma unroll
            for (int m = 0; m < 4; ++m)
#pragma unroll
                for (int n = 0; n < 2; ++n) acc[a][b][m][n] = (f32x4){0.f, 0.f, 0.f, 0.f};
    bf16x8 At[4][2], B0[2][2], B1[2][2];
    const char* cA = (const char*)g.A + (size_t)cur.pm * tstep; const char* cB = (const char*)g.Bt + (size_t)cur.pn * tstep;
    S.a_ready(cur);
    PG8_STAGE(PG8_SB(0, 0), cB, voffB); PG8_STAGE(PG8_SA(0, 0), cA, voffA); PG8_STAGE(PG8_SB(0, 1), cB + hstep, voffB); PG8_STAGE(PG8_SA(0, 1), cA + hstep, voffA);
    if (wr == 1) PG8_BAR;
    PG8_WAIT_V(4); PG8_BAR;
    PG8_STAGE(PG8_SB(1, 0), cB + kstep, voffB); PG8_STAGE(PG8_SA(1, 0), cA + kstep, voffA); PG8_STAGE(PG8_SB(1, 1), cB + hstep + kstep, voffB);
    PG8_WAIT_V(6); PG8_BAR;
    PG8_STAMP();
    for (;;) {
        const bool has_next = S.next(ui + 1, nxt);
        const char* nA = has_next ? (const char*)g.A + (size_t)nxt.pm * tstep : cA; const char* nB = has_next ? (const char*)g.Bt + (size_t)nxt.pn * tstep : cB;
        for (int t = 0; t < nt; t += 2) {
            const bool last = (t == nt - 2);
            const char* a1 = cA + (size_t)(t + 1) * kstep;
            const char* a2 = last ? nA : cA + (size_t)(t + 2) * kstep; const char* b2 = last ? nB : cB + (size_t)(t + 2) * kstep;
            const char* a3 = a2 + kstep; const char* b3 = b2 + kstep;
            if (last && has_next) S.a_ready(nxt);
            PG8_LDB(B0, 0, 0); PG8_SCHED; PG8_LDA(At, 0, 0); PG8_STAGE(PG8_SA(1, 1), a1 + hstep, voffA);
            PG8_WAIT_L(8); PG8_BAR; PG8_WAIT_L(0); PG8_MMA(0, 0, At, B0); PG8_BAR; PG8_SCHED;
            PG8_LDB(B1, 0, 1); PG8_STAGE(PG8_SB(0, 0), b2, voffB);
            PG8_BAR; PG8_WAIT_L(0); PG8_MMA(0, 1, At, B1); PG8_BAR;
            PG8_LDA(At, 0, 1); PG8_STAGE(PG8_SA(0, 0), a2, voffA);
            PG8_BAR; PG8_WAIT_L(0); PG8_MMA(1, 0, At, B0); PG8_BAR; PG8_SCHED;
            PG8_STAGE(PG8_SB(0, 1), b2 + hstep, voffB);
            PG8_WAIT_V(6); PG8_BAR; PG8_MMA(1, 1, At, B1); PG8_BAR;
            PG8_LDB(B0, 1, 0); PG8_SCHED; PG8_LDA(At, 1, 0); PG8_STAGE(PG8_SA(0, 1), a2 + hstep, voffA);
            PG8_WAIT_L(8); PG8_BAR; PG8_WAIT_L(0); PG8_MMA(0, 0, At, B0); PG8_BAR; PG8_SCHED;
            PG8_LDB(B1, 1, 1); PG8_STAGE(PG8_SB(1, 0), b3, voffB);
            PG8_BAR; PG8_WAIT_L(0); PG8_MMA(0, 1, At, B1); PG8_BAR;
            PG8_LDA(At, 1, 1); PG8_STAGE(PG8_SA(1, 0), a3, voffA);
            PG8_BAR; PG8_WAIT_L(0); PG8_MMA(1, 0, At, B0); PG8_BAR; PG8_SCHED;
            PG8_STAGE(PG8_SB(1, 1), b3 + hstep, voffB);
            PG8_WAIT_V(6); PG8_BAR; PG8_MMA(1, 1, At, B1); PG8_BAR;
        }
        PG8_STAMP();
        if constexpr (!Epi::AFTER_DRAIN) { E(acc, cur, wr, wc, fr, fq); S.done(cur); }
        PG8_STAMP();
        if (!has_next) break;
#pragma unroll
        for (int a = 0; a < 2; ++a)
#pragma unroll
            for (int b = 0; b < 2; ++b)
#pragma unroll
                for (int m = 0; m < 4; ++m)
#pragma unroll
                    for (int n = 0; n < 2; ++n) acc[a][b][m][n] = (f32x4){0.f, 0.f, 0.f, 0.f};
        cur = nxt; cA = nA; cB = nB; ++ui;
    }
    PG8_WAIT_V(0);
    if (wr == 0) PG8_BAR;
    PG8_BAR;
    if constexpr (Epi::AFTER_DRAIN) { E.fused(acc, cur, wr, wc, fr, fq, lds, wid, lane); S.done(cur); }
    PG8_STAMP();
    if (STAMP && wid == 0) { stamps[lane] = lane < nts ? (((unsigned long long)(unsigned)ts_hi << 32) | (unsigned)ts_lo) : 0ull;
        if (lane == 62) stamps[62] = rt_entry; if (lane == 63) stamps[63] = (unsigned long long)wall_clock64(); }
#undef PG8_STAMP
#undef PG8_SA
#undef PG8_SB
#undef PG8_STAGE
#undef PG8_LDA
#undef PG8_LDB
#undef PG8_MMA
#undef PG8_WAIT_V
#undef PG8_WAIT_L
#undef PG8_BAR
#undef PG8_SCHED
}
}
using pg8::bf16_t; using pg8::bf16x8; using pg8::f32x4; using pg8::u32x4; using pg8::Unit;
typedef unsigned u32x2 __attribute__((ext_vector_type(2)));
#define LAS __attribute__((address_space(3)))
typedef LAS unsigned char* ldsp;

constexpr int T_ALL = 32768, TG = 16384, DM = 1024, SEQ = 4096;
constexpr float ALPHA = 1.4142135623730951f;
constexpr size_t MB = 1024ull * 1024ull;
constexpr size_t OFF_XB = 0, OFF_WB = 128 * MB, OFF_U = 184 * MB, OFF_SMALL = 248 * MB, OFF_R0 = 256 * MB;
constexpr size_t W1A = 0, W1S = W1A + 4096ull * 1024, W1B = W1S + 3072ull * 1024, WPA = W1B + 5120ull * 1024, WPB = WPA + 1024ull * 1024,
                 WO = WPB + 1024ull * 2048, WUP = WO + 1024ull * 1024, WDN = WUP + 4096ull * 1024, W_END = WDN + 4096ull * 1024;
static_assert(W_END * 2 <= 56 * MB, "weights");
constexpr size_t SM_MOD = 0  , SM_LB = 2 * 8 * 6144  , SM_STR = SM_LB + 2048  , SM_STH = SM_STR + (size_t)TG * 8  , SM_END = SM_STH + (size_t)TG * 8;
constexpr size_t SM_BAR_BYTES = 7 * MB;
static_assert(SM_END * 4 <= 7 * MB, "small");
constexpr size_t R_QH = 0, R_VIT = 32 * MB, R_QR = 64 * MB, R_KR = 96 * MB, R_KRT = 128 * MB, R_ORA = 160 * MB, R_ORB = 192 * MB;
constexpr size_t R_SGA = R_QH, R_SGB = R_VIT, R_M1 = R_QR, R_MG = R_KRT;
constexpr size_t D_LF = 0, D_VRT = 64 * MB;

struct Params {
  const float* x; const float* c; const int* pos; const float* lb_logits; const float* w_ada; const float* b_ada; const float* w_in; const float* w_pa; const float* w_pb;
  const float* w_o; const float* ln1_g; const float* ln1_b; const float* w_up; const float* b_up; const float* w_down; const float* b_down; const float* ln2_g; const float* ln2_b;
  float* out; unsigned char* ws; int wv; int pad;
};

__device__ __forceinline__ float bf2f(unsigned short b) { return __uint_as_float(((unsigned)b) << 16); }
__device__ __forceinline__ float bflo(unsigned u) { return __uint_as_float(u << 16); }
__device__ __forceinline__ float bfhi(unsigned u) { return __uint_as_float(u & 0xffff0000u); }
__device__ __forceinline__ unsigned pk2(float lo, float hi) { return pg8::cvt_pk_bf16(lo, hi); }
__device__ __forceinline__ float sigmoidf_(float v) { return 1.0f / (1.0f + __expf(-v)); }
__device__ __forceinline__ float siluf_(float v) { return v * sigmoidf_(v); }
__device__ __forceinline__ f32x4 mfma16(bf16x8 a, bf16x8 b, f32x4 c) { return __builtin_amdgcn_mfma_f32_16x16x32_bf16(a, b, c, 0, 0, 0); }
__device__ __forceinline__ bf16x8 ldfrag(ldsp base, int off) { return *(const LAS bf16x8*)(base + off); }
__device__ __forceinline__ float shx(float v, int mask, int lane) { return __int_as_float(__builtin_amdgcn_ds_bpermute((lane ^ mask) << 2, __float_as_int(v))); }
__device__ __forceinline__ float wave_sum(float v, int lane) {
#pragma unroll
  for (int o = 32; o > 0; o >>= 1) v += shx(v, o, lane);
  return v;
}

enum { MD_G1A = 0, MD_G1S, MD_G1B, MD_G2A, MD_G2B, MD_G3, MD_G4, MD_G5 };
struct EpiP {
  static constexpr bool PERM = true, AFTER_DRAIN = false;
  int mode, l, g;
  const Params* pp;
  template <int MODE, int ai, int m> __device__ __forceinline__ void rowf(const f32x4 (&acc)[2][2][4][2], const Unit& u, int wr, int wc, int fr, int fq) const {
    const Params& p = *pp;
    unsigned char* R0 = p.ws + OFF_R0; unsigned char* DO = (unsigned char*)p.out;
    float* small = (float*)(p.ws + OFF_SMALL);
    const float* mod = small + SM_MOD + (size_t)l * 8 * 6144;
      {
        const int row = u.pm * 256 + ai * 128 + wr * 64 + m * 16 + fr;
#pragma unroll
        for (int bj = 0; bj < 2; ++bj) {
          const int col = u.pn * 256 + bj * 128 + wc * 32 + 8 * fq;
          float v[8];
#pragma unroll
          for (int i = 0; i < 4; ++i) { v[i] = acc[ai][bj][m][0][i]; v[4 + i] = acc[ai][bj][m][1][i]; }
          if constexpr (MODE == MD_G1A) {
            const int sec = col >> 10, cs = col & 1023;
            if (sec == 0) {
              u32x4 o;
#pragma unroll
              for (int i = 0; i < 4; ++i) o[i] = pk2(siluf_(v[2 * i]), siluf_(v[2 * i + 1]));
              *(u32x4*)(R0 + R_QH + ((size_t)row * 1024 + cs) * 2) = o;
            } else if (sec == 1) {
              const float* lbp = small + SM_LB + l * 1024 + cs;
              const f32x4 l0 = *(const f32x4*)lbp, l1 = *(const f32x4*)(lbp + 4);
              float o[8];
#pragma unroll
              for (int i = 0; i < 8; ++i) {
                const float lbv = i < 4 ? l0[i & 3] : l1[i & 3];
                const float z = v[i];
                const float ls = fminf(z, 0.f) - log1pf(__expf(-fabsf(z)));
                const float f = lbv + (1.f - lbv) * sigmoidf_(z);
                o[i] = (lbv == 0.f) ? ls : __logf(f);
              }
              float* dst = (float*)(DO + D_LF) + (size_t)row * 1024 + cs;
              *(f32x4*)dst = (f32x4){o[0], o[1], o[2], o[3]}; *(f32x4*)(dst + 4) = (f32x4){o[4], o[5], o[6], o[7]};
            } else {
              const float posf = (float)p.pos[g * TG + row];
              const float sc = sec == 3 ? 0.0625f : 1.0f;
              const int p0 = (cs & 255) >> 1;
              u32x4 o;
#pragma unroll
              for (int i = 0; i < 4; ++i) {
                const float theta = __builtin_amdgcn_exp2f(-13.287712379549449f * (float)(p0 + i) * (1.0f / 127.0f));
                float rev = posf * theta * 0.15915494309189535f; rev -= floorf(rev);
                const float sn = __builtin_amdgcn_sinf(rev), cn = __builtin_amdgcn_cosf(rev);
                const float t1 = v[2 * i], t2 = v[2 * i + 1];
                o[i] = pk2((t1 * cn - t2 * sn) * sc, (t1 * sn + t2 * cn) * sc);
              }
              *(u32x4*)(R0 + (sec == 2 ? R_QR : R_KR) + ((size_t)row * 1024 + cs) * 2) = o;
            }
          } else if constexpr (MODE == MD_G1S) {
            const int sec = row >> 10;
            if (sec == 0) {
              u32x4 o;
#pragma unroll
              for (int i = 0; i < 4; ++i) o[i] = pk2(v[2 * i], v[2 * i + 1]);
              *(u32x4*)(R0 + R_VIT + ((size_t)row * TG + col) * 2) = o;
            } else {
              const int f = row - 1024, h = (u.pm * 256 - 1024) >> 9;
              const float lg2 = __log2f(1.0f - __builtin_amdgcn_exp2f(-5.0f - (float)h));
              float o[8];
#pragma unroll
              for (int i = 0; i < 8; ++i) o[i] = v[i] * __builtin_amdgcn_exp2f(lg2 * (float)(63 - ((col + i) & 63)));
              u32x4 ov;
#pragma unroll
              for (int i = 0; i < 4; ++i) ov[i] = pk2(o[2 * i], o[2 * i + 1]);
              *(u32x4*)(DO + D_VRT + ((size_t)f * TG + col) * 2) = ov;
            }
          } else if constexpr (MODE == MD_G1B) {
            const int sec = col >> 10, cs = col & 1023;
            if (sec == 0) {
              const float ss = (small + SM_STH)[(size_t)row * 8 + (cs >> 7)];
              const float rstd = rsqrtf(ss * (1.0f / 128.0f) + 1e-6f);
              u32x4* ptr = (u32x4*)(R0 + R_ORA + ((size_t)row * 1024 + cs) * 2);
              const u32x4 ov = *ptr; u32x4 o;
#pragma unroll
              for (int i = 0; i < 4; ++i) o[i] = pk2(bflo(ov[i]) * rstd * siluf_(v[2 * i]), bfhi(ov[i]) * rstd * siluf_(v[2 * i + 1]));
              *ptr = o;
            } else if (sec < 3) {
              const int c2 = col - 1024;
              const float* st = small + SM_STR + ((size_t)row * 4 + (c2 >> 9)) * 2;
              const float mean = st[0] * (1.0f / 512.0f);
              const float var = fmaxf(st[1] * (1.0f / 512.0f) - mean * mean, 0.f);
              const float rstd = rsqrtf(var + 1e-6f);
              u32x4* ptr = (u32x4*)(R0 + R_ORB + ((size_t)row * 2048 + c2) * 2);
              const u32x4 ov = *ptr; u32x4 o;
#pragma unroll
              for (int i = 0; i < 4; ++i) o[i] = pk2((bflo(ov[i]) - mean) * rstd * siluf_(v[2 * i]), (bfhi(ov[i]) - mean) * rstd * siluf_(v[2 * i + 1]));
              *ptr = o;
            } else {
              u32x4 o;
#pragma unroll
              for (int i = 0; i < 4; ++i) o[i] = pk2(sigmoidf_(v[2 * i]), sigmoidf_(v[2 * i + 1]));
              *(u32x4*)(R0 + (sec == 3 ? R_SGA : R_SGB) + ((size_t)row * 1024 + cs) * 2) = o;
            }
          } else if constexpr (MODE == MD_G2A) {
            const u32x4 gv = *(const u32x4*)(R0 + R_SGA + ((size_t)row * 1024 + col) * 2);
            float* dst = (float*)(R0 + R_M1) + (size_t)row * 1024 + col;
            *(f32x4*)dst = (f32x4){bflo(gv[0]) * v[0], bfhi(gv[0]) * v[1], bflo(gv[1]) * v[2], bfhi(gv[1]) * v[3]};
            *(f32x4*)(dst + 4) = (f32x4){bflo(gv[2]) * v[4], bfhi(gv[2]) * v[5], bflo(gv[3]) * v[6], bfhi(gv[3]) * v[7]};
          } else if constexpr (MODE == MD_G2B) {
            const u32x4 gv = *(const u32x4*)(R0 + R_SGB + ((size_t)row * 1024 + col) * 2);
            const float* src = (const float*)(R0 + R_M1) + (size_t)row * 1024 + col;
            const f32x4 m0 = *(const f32x4*)src, m1 = *(const f32x4*)(src + 4);
            u32x4 o;
            o[0] = pk2(m0[0] + bflo(gv[0]) * v[0], m0[1] + bfhi(gv[0]) * v[1]);
            o[1] = pk2(m0[2] + bflo(gv[1]) * v[2], m0[3] + bfhi(gv[1]) * v[3]);
            o[2] = pk2(m1[0] + bflo(gv[2]) * v[4], m1[1] + bfhi(gv[2]) * v[5]);
            o[3] = pk2(m1[2] + bflo(gv[3]) * v[6], m1[3] + bfhi(gv[3]) * v[7]);
            *(u32x4*)(R0 + R_MG + ((size_t)row * 1024 + col) * 2) = o;
          } else if constexpr (MODE == MD_G3) {
            const int tg = g * TG + row, b = tg >> 12;
            const float* xin = (l == 0 ? p.x : (const float*)(p.ws + OFF_XB)) + (size_t)tg * 1024 + col;
            const float* gt = mod + (size_t)b * 6144 + 2 * 1024 + col;
            const f32x4 x0 = *(const f32x4*)xin, x1 = *(const f32x4*)(xin + 4), g0 = *(const f32x4*)gt, g1 = *(const f32x4*)(gt + 4);
            float* dst = (float*)(p.ws + OFF_XB) + (size_t)tg * 1024 + col;
            f32x4 o0, o1;
#pragma unroll
            for (int i = 0; i < 4; ++i) { o0[i] = ALPHA * x0[i] + (1.f + g0[i]) * v[i]; o1[i] = ALPHA * x1[i] + (1.f + g1[i]) * v[4 + i]; }
            *(f32x4*)dst = o0; *(f32x4*)(dst + 4) = o1;
          } else if constexpr (MODE == MD_G4) {
            const float* bp = p.b_up + (size_t)l * 4096 + col;
            const f32x4 b0 = *(const f32x4*)bp, b1 = *(const f32x4*)(bp + 4);
            float o[8];
#pragma unroll
            for (int i = 0; i < 8; ++i) { const float hh = fmaxf(v[i] + (i < 4 ? b0[i & 3] : b1[i & 3]), 0.f); o[i] = hh * hh; }
            u32x4 ov;
#pragma unroll
            for (int i = 0; i < 4; ++i) ov[i] = pk2(o[2 * i], o[2 * i + 1]);
            *(u32x4*)(R0 + ((size_t)row * 4096 + col) * 2) = ov;
          } else if constexpr (MODE == MD_G5) {
            const int b = row >> 12;
            float* dst = (float*)(p.ws + OFF_XB) + (size_t)row * 1024 + col;
            const float* gt = mod + (size_t)b * 6144 + 5 * 1024 + col;
            const float* bp = p.b_down + (size_t)l * 1024 + col;
            const f32x4 x0 = *(const f32x4*)dst, x1 = *(const f32x4*)(dst + 4), g0 = *(const f32x4*)gt, g1 = *(const f32x4*)(gt + 4), b0 = *(const f32x4*)bp, b1 = *(const f32x4*)(bp + 4);
            f32x4 o0, o1;
#pragma unroll
            for (int i = 0; i < 4; ++i) { o0[i] = ALPHA * x0[i] + (1.f + g0[i]) * (v[i] + b0[i]); o1[i] = ALPHA * x1[i] + (1.f + g1[i]) * (v[4 + i] + b1[i]); }
            *(f32x4*)dst = o0; *(f32x4*)(dst + 4) = o1;
          }
        }
      }
  }
  template <int MODE> __device__ __forceinline__ void run(const f32x4 (&acc)[2][2][4][2], const Unit& u, int wr, int wc, int fr, int fq) const {
    #define RW(a, b) rowf<MODE, a, b>(acc, u, wr, wc, fr, fq);
    RW(0, 0) RW(0, 1) RW(0, 2) RW(0, 3) RW(1, 0) RW(1, 1) RW(1, 2) RW(1, 3)
#undef RW
  }
  __device__ __forceinline__ void operator()(const f32x4 (&acc)[2][2][4][2], const Unit& u, int wr, int wc, int fr, int fq) const {
    switch (mode) {
      case MD_G1A: run<MD_G1A>(acc, u, wr, wc, fr, fq); break;
      case MD_G1S: run<MD_G1S>(acc, u, wr, wc, fr, fq); break;
      case MD_G1B: run<MD_G1B>(acc, u, wr, wc, fr, fq); break;
      case MD_G2A: run<MD_G2A>(acc, u, wr, wc, fr, fq); break;
      case MD_G2B: run<MD_G2B>(acc, u, wr, wc, fr, fq); break;
      case MD_G3: run<MD_G3>(acc, u, wr, wc, fr, fq); break;
      case MD_G4: run<MD_G4>(acc, u, wr, wc, fr, fq); break;
      default: run<MD_G5>(acc, u, wr, wc, fr, fq); break;
    }
  }
};
#define XB_TMO      128
#define XB_XCNT(j)  (256  + 64 * (j))
#define XB_XSUB(j)  (1280 + 64 * (j))
#define XB_XGEN(j)  (2304 + 64 * (j))
#define XB_TOP      3328
#define XB_TOPGEN   3392
#define XCD_BAR_WORDS 3456
#define XB_SPIN_CAP (1u << 18)

__device__ __forceinline__ unsigned xb_ld(unsigned* p)              { return __hip_atomic_load(p, __ATOMIC_RELAXED, __HIP_MEMORY_SCOPE_AGENT); }
__device__ __forceinline__ unsigned xb_add(unsigned* p, unsigned v) { return __hip_atomic_fetch_add(p, v, __ATOMIC_RELAXED, __HIP_MEMORY_SCOPE_AGENT); }
__device__ __forceinline__ unsigned xb_xcc_id() { return (unsigned)__builtin_amdgcn_s_getreg((3 << 11) | 20) & 0xFu; }
#define XB_SPIN(cond, bar) do { unsigned _sp = 0; while (cond) { __builtin_amdgcn_s_sleep(1); \
    if ((++_sp & 255u) == 0u) { if (xb_ld(&(bar)[XB_TMO])) break; if (_sp > XB_SPIN_CAP) { atomicAdd(&(bar)[XB_TMO], 1u); break; } } } } while (0)

struct XcdBarrier {
    unsigned* bar; unsigned x;
    volatile LAS unsigned* st;
};

__device__ __forceinline__ XcdBarrier xcd_barrier_post(unsigned* bar, volatile LAS unsigned* st) {
    XcdBarrier b; b.bar = bar; b.x = xb_xcc_id(); b.st = st;
    if (threadIdx.x == 0) (void)xb_add(&bar[XB_XCNT(b.x)], 1u);
    return b;
}
__device__ __forceinline__ void xcd_barrier_complete(unsigned* bar, unsigned x, unsigned& nloc, unsigned& nx) {
    const unsigned G = gridDim.x * gridDim.y * gridDim.z;
    unsigned sum, cnt, mine, sp = 0u;
    for (;;) {
        sum = 0u; cnt = 0u; mine = 0u;
#pragma unroll
        for (unsigned j = 0; j < 16; ++j) { const unsigned c = xb_ld(&bar[XB_XCNT(j)]); sum += c; cnt += (c > 0u) ? 1u : 0u; mine = (j == x) ? c : mine; }
        if (sum == G) break;
        __builtin_amdgcn_s_sleep(1);
        if ((++sp & 255u) == 0u) { if (xb_ld(&bar[XB_TMO])) break; if (sp > XB_SPIN_CAP) { atomicAdd(&bar[XB_TMO], 1u); break; } }
    }
    nloc = mine > 0u ? mine : 1u; nx = cnt > 0u ? cnt : 1u;
}

__device__ __forceinline__ void xcd_barrier(const XcdBarrier& b) {
    asm volatile("s_waitcnt vmcnt(0)" ::: "memory");
    __syncthreads();
    if (threadIdx.x == 0) {
        unsigned* bar = b.bar;
        __builtin_amdgcn_s_waitcnt(0);
        unsigned nloc = b.st[0], nx = b.st[1];
        if (nloc == 0u) { xcd_barrier_complete(bar, b.x, nloc, nx); b.st[0] = nloc; b.st[1] = nx; }
        const unsigned old = xb_add(&bar[XB_XSUB(b.x)], 1u);
        const unsigned gen = old / nloc;
        if (old + 1u == (gen + 1u) * nloc) {
            __builtin_amdgcn_fence(__ATOMIC_RELEASE, "agent");
            asm volatile("s_waitcnt vmcnt(0)" ::: "memory");
            const unsigned og = xb_add(&bar[XB_TOP], 1u);
            const unsigned tg = og / nx;
            if (og + 1u == (tg + 1u) * nx) xb_add(&bar[XB_TOPGEN], 1u);
            else XB_SPIN(xb_ld(&bar[XB_TOPGEN]) == tg, bar);
            __builtin_amdgcn_fence(__ATOMIC_ACQUIRE, "agent");
            xb_add(&bar[XB_XGEN(b.x)], 1u);
            asm volatile("s_waitcnt vmcnt(0)" ::: "memory");
        } else {
            XB_SPIN(xb_ld(&bar[XB_XGEN(b.x)]) == gen, bar);
            __builtin_amdgcn_fence(__ATOMIC_ACQUIRE, "agent");
            asm volatile("s_waitcnt vmcnt(0)" ::: "memory");
        }
    }
    __syncthreads();
}

__device__ __forceinline__ void gbar(unsigned* bar0, volatile LAS unsigned* st) {
    XcdBarrier b; b.bar = bar0; asm volatile("" : "+s"(b.bar)); b.x = (unsigned)__builtin_amdgcn_readfirstlane((int)xb_xcc_id()); asm volatile("" : "+s"(b.x)); b.st = st; xcd_barrier(b);
}
__device__ __forceinline__ void conv_job(ldsp lds, int wv, const float* src, int ld, int K, int c0, int ncols, bf16_t* dst) {
  LAS float* tile = (LAS float*)lds;
  const int tid = otid(wv), ntk = K >> 6, ntn = ncols >> 6, nt = ntk * ntn;
  for (int t = obid(); t < nt; t += gridDim.x) {
    const int tk = t / ntn, tn = t - tk * ntn, k0 = tk << 6, n0 = tn << 6;
    __syncthreads();
#pragma unroll
    for (int i = 0; i < 8; ++i) { const int r = i * 8 + (tid >> 6), cc = tid & 63; tile[r * 65 + cc] = src[(size_t)(k0 + r) * ld + c0 + n0 + cc]; }
    __syncthreads();
    const int kp = tid & 31, nn = tid >> 5;
#pragma unroll
    for (int i = 0; i < 4; ++i) { const int n = nn + 16 * i; *(unsigned*)(dst + (size_t)(n0 + n) * K + k0 + 2 * kp) = pk2(tile[(2 * kp) * 65 + n], tile[(2 * kp + 1) * 65 + n]); }
  }
  __syncthreads();
}
__device__ __forceinline__ void phase_conv(ldsp lds, const Params& p, int l) {
  bf16_t* WB = (bf16_t*)(p.ws + OFF_WB);
  const float* win = p.w_in + (size_t)l * 1024 * 12288;
  conv_job(lds, p.wv, win, 12288, 1024, 0, 1024, WB + W1A);
  conv_job(lds, p.wv, win, 12288, 1024, 1024, 1024, WB + W1A + 1024ull * 1024);
  conv_job(lds, p.wv, win, 12288, 1024, 4096, 2048, WB + W1A + 2048ull * 1024);
  conv_job(lds, p.wv, win, 12288, 1024, 2048, 1024, WB + W1S);
  conv_job(lds, p.wv, win, 12288, 1024, 6144, 2048, WB + W1S + 1024ull * 1024);
  conv_job(lds, p.wv, win, 12288, 1024, 3072, 1024, WB + W1B);
  conv_job(lds, p.wv, win, 12288, 1024, 8192, 4096, WB + W1B + 1024ull * 1024);
  conv_job(lds, p.wv, p.w_pa + (size_t)l * 1024 * 1024, 1024, 1024, 0, 1024, WB + WPA);
  conv_job(lds, p.wv, p.w_pb + (size_t)l * 2048 * 1024, 1024, 2048, 0, 1024, WB + WPB);
  conv_job(lds, p.wv, p.w_o + (size_t)l * 1024 * 1024, 1024, 1024, 0, 1024, WB + WO);
  conv_job(lds, p.wv, p.w_up + (size_t)l * 1024 * 4096, 4096, 1024, 0, 4096, WB + WUP);
  conv_job(lds, p.wv, p.w_down + (size_t)l * 4096 * 1024, 1024, 4096, 0, 1024, WB + WDN);
}
__device__ __forceinline__ void phase_mod(ldsp lds, const Params& p) {
  float* small = (float*)(p.ws + OFF_SMALL);
  const int tid = otid(p.wv);
  const int bid = obid();
  if (bid < 192) {
    LAS float* cond = (LAS float*)lds;
    LAS float* part = (LAS float*)(lds + 32768);
    for (int i = tid; i < 8192; i += 512) cond[i] = siluf_(p.c[i]);
    __syncthreads();
    const int o0 = bid * 64, l = o0 / 6144, n0 = o0 - l * 6144, nl = tid & 63, kq = tid >> 6;
    const float* w = p.w_ada + (size_t)l * 1024 * 6144 + n0 + nl + (size_t)(kq * 128) * 6144;
    float a[8];
#pragma unroll
    for (int b = 0; b < 8; ++b) a[b] = 0.f;
#pragma unroll 8
    for (int k = 0; k < 128; ++k) {
      const float wv = w[(size_t)k * 6144];
#pragma unroll
      for (int b = 0; b < 8; ++b) a[b] += cond[b * 1024 + kq * 128 + k] * wv;
    }
#pragma unroll
    for (int b = 0; b < 8; ++b) part[(kq * 8 + b) * 64 + nl] = a[b];
    __syncthreads();
    {
      const int b = tid >> 6; float s = 0.f;
#pragma unroll
      for (int q = 0; q < 8; ++q) s += part[(q * 8 + b) * 64 + nl];
      small[SM_MOD + (size_t)l * 8 * 6144 + b * 6144 + n0 + nl] = s + p.b_ada[l * 6144 + n0 + nl];
    }
    __syncthreads();
  } else if (bid == 192) {
    for (int i = tid; i < 1024; i += 512) {
      const float a = p.lb_logits[i], b = p.lb_logits[1024 + i], mx = fmaxf(a, b);
      const float ea = __expf(a - mx), eb = __expf(b - mx);
      small[SM_LB + i] = 0.f; small[SM_LB + 1024 + i] = eb / (ea + eb);
    }
  }
}
__device__ __forceinline__ void phase_u0(const Params& p) {
  const float* mod = (const float*)(p.ws + OFF_SMALL) + SM_MOD;
  bf16_t* U = (bf16_t*)(p.ws + OFF_U);
  const size_t n4 = (size_t)T_ALL * 1024 / 4;
  for (size_t i = (size_t)obid() * 512 + otid(p.wv); i < n4; i += (size_t)gridDim.x * 512) {
    const size_t e = i * 4; const int t = (int)(e >> 10), cc = (int)(e & 1023), b = t >> 12;
    const f32x4 xv = *(const f32x4*)(p.x + e), sh = *(const f32x4*)(mod + b * 6144 + cc), sc = *(const f32x4*)(mod + b * 6144 + 1024 + cc);
    u32x2 o; o[0] = pk2(xv[0] * (1.f + sc[0]) + sh[0], xv[1] * (1.f + sc[1]) + sh[1]); o[1] = pk2(xv[2] * (1.f + sc[2]) + sh[2], xv[3] * (1.f + sc[3]) + sh[3]);
    *(u32x2*)(U + e) = o;
  }
}
__device__ __forceinline__ void phase_ln(const Params& p, const float* gam, const float* bet, int lm, int s_shift, bool fin) {
  float* XB = (float*)(p.ws + OFF_XB);
  const float* mod = (const float*)(p.ws + OFF_SMALL) + SM_MOD + (size_t)lm * 8 * 6144;
  bf16_t* U = (bf16_t*)(p.ws + OFF_U);
  const int tid_ = otid(p.wv); const int lane = tid_ & 63, gw = obid() * 8 + (tid_ >> 6), nw = gridDim.x * 8;
  for (int row = gw; row < T_ALL; row += nw) {
    const float* src = XB + (size_t)row * 1024;
    f32x4 v[4]; float s = 0.f;
#pragma unroll
    for (int k = 0; k < 4; ++k) { v[k] = *(const f32x4*)(src + 256 * k + 4 * lane); s += v[k][0] + v[k][1] + v[k][2] + v[k][3]; }
    const float mu = wave_sum(s, lane) * (1.0f / 1024.0f);
    float q = 0.f;
#pragma unroll
    for (int k = 0; k < 4; ++k)
#pragma unroll
      for (int i = 0; i < 4; ++i) { const float d = v[k][i] - mu; q += d * d; }
    const float rstd = rsqrtf(wave_sum(q, lane) * (1.0f / 1024.0f) + 1e-5f);
    const int b = row >> 12;
#pragma unroll
    for (int k = 0; k < 4; ++k) {
      const int cc = 256 * k + 4 * lane;
      const f32x4 gg = *(const f32x4*)(gam + cc), bb = *(const f32x4*)(bet + cc);
      f32x4 y;
#pragma unroll
      for (int i = 0; i < 4; ++i) y[i] = (v[k][i] - mu) * rstd * gg[i] + bb[i];
      if (fin) { *(f32x4*)(p.out + (size_t)row * 1024 + cc) = y; }
      else {
        *(f32x4*)(XB + (size_t)row * 1024 + cc) = y;
        const f32x4 sh = *(const f32x4*)(mod + b * 6144 + s_shift * 1024 + cc), sc = *(const f32x4*)(mod + b * 6144 + (s_shift + 1) * 1024 + cc);
        u32x2 o; o[0] = pk2(y[0] * (1.f + sc[0]) + sh[0], y[1] * (1.f + sc[1]) + sh[1]); o[1] = pk2(y[2] * (1.f + sc[2]) + sh[2], y[3] * (1.f + sc[3]) + sh[3]);
        *(u32x2*)(U + (size_t)row * 1024 + cc) = o;
      }
    }
  }
}
typedef short s16x4 __attribute__((ext_vector_type(4)));
template <class T> __device__ __forceinline__ T* vaddr(T* q) { asm volatile("" : "+v"(q)); return q; }
__device__ __forceinline__ void ret_item(ldsp lds, const Params& p, int item, bool do_stats) {
  constexpr int KS = 0, VTS = 33792, STS = 43008, PS = 76800;
  const int es = item & 7, h = (item >> 3) & 3, bl = item >> 5;
  const int tid = otid(p.wv), w = tid >> 6, lane = tid & 63, fr = lane & 15, fq = lane >> 4;
  unsigned char* R0 = oaddr(p.ws) + OFF_R0; unsigned char* DO = (unsigned char*)oaddr(p.out);
  const bf16_t* Qr = (const bf16_t*)(R0 + R_QR); const bf16_t* Kr = (const bf16_t*)(R0 + R_KR);
  const bf16_t* VrT = (const bf16_t*)(DO + D_VRT); bf16_t* OrB = (bf16_t*)(R0 + R_ORB);
  float* stR = (float*)(p.ws + OFF_SMALL) + SM_STR;
  const float gam = 1.0f - __builtin_amdgcn_exp2f(-5.0f - (float)h), lg2 = __log2f(gam), g64 = __builtin_amdgcn_exp2f(lg2 * 64.0f);
  const int it = w >> 1, eh = w & 1;
  f32x4 st[2][4];
#pragma unroll
  for (int a = 0; a < 2; ++a)
#pragma unroll
    for (int b = 0; b < 4; ++b) st[a][b] = (f32x4){0.f, 0.f, 0.f, 0.f};
  const float rowscale = __builtin_amdgcn_exp2f(lg2 * (float)(16 * it + fr - 63));
  u32x4 kreg[4], vtreg; bf16x8 qn[8];
#define RET_LOADS(TOK) do { \
    const bf16_t* kbase = vaddr(Kr + (size_t)((TOK) + (tid >> 5)) * 1024 + h * 256 + (tid & 31) * 8); \
    const bf16_t* vtbase = vaddr(VrT + (size_t)(h * 512 + es * 64 + (tid >> 3)) * TG + (TOK) + (tid & 7) * 8); \
    const bf16_t* qbase = vaddr(Qr + (size_t)((TOK) + 16 * it + fr) * 1024 + h * 256 + fq * 8); \
    _Pragma("unroll") for (int i = 0; i < 4; ++i) kreg[i] = *(const u32x4*)(kbase + (size_t)i * 16 * 1024); \
    vtreg = *(const u32x4*)vtbase; \
    _Pragma("unroll") for (int ks = 0; ks < 8; ++ks) qn[ks] = *(const bf16x8*)(qbase + ks * 32); } while (0)
  RET_LOADS(bl * SEQ);
  for (int n = 0; n < 64; ++n) {
    const int tok0 = bl * SEQ + n * 64;
    bf16x8 qf[8];
    bf16_t* obase = vaddr(OrB + (size_t)(tok0 + 16 * it + fr) * 2048 + h * 512 + es * 64 + 32 * eh + 4 * fq);
    float* sbase = vaddr(stR + ((size_t)(tok0 + 16 * it + fr) * 4 + h) * 2);
#pragma unroll
    for (int ks = 0; ks < 8; ++ks) qf[ks] = qn[ks];
    __builtin_amdgcn_sched_barrier(0);
#pragma unroll
    for (int dt = 0; dt < 2; ++dt)
#pragma unroll
      for (int et = 0; et < 4; ++et) {
        u32x2 o; o[0] = pk2(st[dt][et][0], st[dt][et][1]); o[1] = pk2(st[dt][et][2], st[dt][et][3]);
        *(LAS u32x2*)(lds + STS + (16 * et + fr) * 528 + (32 * w + 16 * dt + 4 * fq) * 2) = o;
      }
#pragma unroll
    for (int i = 0; i < 4; ++i) { const int c = tid + 512 * i, r = c >> 5, ch = c & 31; *(LAS u32x4*)(lds + KS + r * 528 + ch * 16) = kreg[i]; }
    { const int r = tid >> 3, ch = tid & 7; *(LAS u32x4*)(lds + VTS + r * 144 + ch * 16) = vtreg; }
    __syncthreads();
    { const int tokn = bl * SEQ + (n < 63 ? n + 1 : 63) * 64; RET_LOADS(tokn); }
    __builtin_amdgcn_sched_barrier(0);
#pragma unroll
    for (int jj = 0; jj < 2; ++jj) {
      const int jt = 2 * eh + jj;
      f32x4 sc = (f32x4){0.f, 0.f, 0.f, 0.f};
#pragma unroll
      for (int ks = 0; ks < 8; ++ks) sc = mfma16(ldfrag(lds, KS + (16 * jt + fr) * 528 + (32 * ks + 8 * fq) * 2), qf[ks], sc);
      const int i_ = 16 * it + fr, j0 = 16 * jt + 4 * fq;
      u32x2 o; o[0] = pk2(j0 + 0 <= i_ ? sc[0] : 0.f, j0 + 1 <= i_ ? sc[1] : 0.f); o[1] = pk2(j0 + 2 <= i_ ? sc[2] : 0.f, j0 + 3 <= i_ ? sc[3] : 0.f);
      *(LAS u32x2*)(lds + PS + i_ * 144 + j0 * 2) = o;
    }
    __syncthreads();
    __builtin_amdgcn_sched_barrier(0);
    float s1 = 0.f, s2 = 0.f;
#pragma unroll
    for (int ee = 0; ee < 2; ++ee) {
      const int et = 2 * eh + ee;
      f32x4 o = (f32x4){0.f, 0.f, 0.f, 0.f};
#pragma unroll
      for (int k2 = 0; k2 < 2; ++k2) o = mfma16(ldfrag(lds, VTS + (16 * et + fr) * 144 + (32 * k2 + 8 * fq) * 2), ldfrag(lds, PS + (16 * it + fr) * 144 + (32 * k2 + 8 * fq) * 2), o);
#pragma unroll
      for (int ks = 0; ks < 8; ++ks) o = mfma16(ldfrag(lds, STS + (16 * et + fr) * 528 + (32 * ks + 8 * fq) * 2), qf[ks], o);
#pragma unroll
      for (int r = 0; r < 4; ++r) { o[r] *= rowscale; s1 += o[r]; s2 += o[r] * o[r]; }
      u32x2 ov; ov[0] = pk2(o[0], o[1]); ov[1] = pk2(o[2], o[3]);
      *(u32x2*)(obase + 16 * ee) = ov;
    }
    s1 += shx(s1, 16, lane); s1 += shx(s1, 32, lane); s2 += shx(s2, 16, lane); s2 += shx(s2, 32, lane);
    if (fq == 0 && do_stats) { unsafeAtomicAdd(sbase, s1); unsafeAtomicAdd(sbase + 1, s2); }
    __builtin_amdgcn_sched_barrier(0);
#pragma unroll
    for (int k2 = 0; k2 < 2; ++k2) {
      bf16x8 vf[4];
#pragma unroll
      for (int et = 0; et < 4; ++et) vf[et] = ldfrag(lds, VTS + (16 * et + fr) * 144 + (32 * k2 + 8 * fq) * 2);
#pragma unroll
      for (int dt = 0; dt < 2; ++dt) {
        bf16x8 kf;
        {
          const int a0 = KS + (32 * k2 + 8 * fq + (fr >> 2)) * 528 + (32 * w + 16 * dt + 4 * (fr & 3)) * 2;
          const s16x4 t0 = __builtin_amdgcn_ds_read_tr16_b64_v4i16((LAS s16x4*)(lds + a0));
          const s16x4 t1 = __builtin_amdgcn_ds_read_tr16_b64_v4i16((LAS s16x4*)(lds + a0 + 4 * 528));
          kf = (bf16x8){t0[0], t0[1], t0[2], t0[3], t1[0], t1[1], t1[2], t1[3]};
        }
#pragma unroll
        for (int et = 0; et < 4; ++et) st[dt][et] = mfma16(kf, vf[et], st[dt][et]);
      }
    }
#pragma unroll
    for (int dt = 0; dt < 2; ++dt)
#pragma unroll
      for (int et = 0; et < 4; ++et)
#pragma unroll
        for (int r = 0; r < 4; ++r) st[dt][et][r] *= g64;
    __syncthreads();
  }
}
__device__ __forceinline__ void hgrn_item(ldsp lds, const Params& p, int item, bool do_stats) {
  constexpr int QT = 0, KT = 17408, QB = 34816, KBT = 52224, VTS = 70656, STS = 75264, PS = 83968, TOT = 93184, DEC = 97280;
  const int es = item & 3, h = (item >> 2) & 7, bl = item >> 5;
  const int tid = otid(p.wv), w = tid >> 6, lane = tid & 63, fr = lane & 15, fq = lane >> 4;
  unsigned char* R0 = oaddr(p.ws) + OFF_R0; unsigned char* DO = (unsigned char*)oaddr(p.out);
  const bf16_t* Qh = (const bf16_t*)(R0 + R_QH); const float* LF = (const float*)(DO + D_LF); const bf16_t* ViT = (const bf16_t*)(R0 + R_VIT);
  bf16_t* OrA = (bf16_t*)(R0 + R_ORA);
  float* stH = (float*)(p.ws + OFF_SMALL) + SM_STH;
  LAS float* tot = (LAS float*)(lds + TOT); LAS float* dec = (LAS float*)(lds + DEC);
  const int it = w >> 1, eh = w & 1, d0 = 2 * lane;
  f32x4 st[2];
  st[0] = (f32x4){0.f, 0.f, 0.f, 0.f}; st[1] = (f32x4){0.f, 0.f, 0.f, 0.f};
  float lxn[8], lyn[8]; unsigned q2n[8]; u32x4 vtreg;
#define HG_LOADS(TOK) do { \
    const float* lfbase = vaddr(LF + (size_t)((TOK) + 8 * w) * 1024 + h * 128 + d0); \
    const bf16_t* qhbase = vaddr(Qh + (size_t)((TOK) + 8 * w) * 1024 + h * 128 + d0); \
    const bf16_t* vtbase = vaddr(ViT + (size_t)(h * 128 + es * 32 + ((tid & 255) >> 3)) * TG + (TOK) + (tid & 7) * 8); \
    _Pragma("unroll") for (int jj = 0; jj < 8; ++jj) { \
      const float2 t = *(const float2*)(lfbase + (size_t)jj * 1024); lxn[jj] = t.x; lyn[jj] = t.y; q2n[jj] = *(const unsigned*)(qhbase + (size_t)jj * 1024); } \
    vtreg = *(const u32x4*)vtbase; } while (0)
  HG_LOADS(bl * SEQ);
  for (int n = 0; n < 64; ++n) {
    const int tok0 = bl * SEQ + n * 64;
    float lx[8], ly[8]; unsigned q2[8];
    bf16_t* obase = vaddr(OrA + (size_t)(tok0 + 16 * it + fr) * 1024 + h * 128 + es * 32 + 16 * eh + 4 * fq);
    float* sbase = vaddr(stH + (size_t)(tok0 + 16 * it + fr) * 8 + h);
#pragma unroll
    for (int jj = 0; jj < 8; ++jj) { lx[jj] = lxn[jj]; ly[jj] = lyn[jj]; q2[jj] = q2n[jj]; }
    __builtin_amdgcn_sched_barrier(0);
    float px[8], py[8]; float cx = 0.f, cy = 0.f;
#pragma unroll
    for (int jj = 0; jj < 8; ++jj) { cx += lx[jj]; cy += ly[jj]; px[jj] = cx; py[jj] = cy; }
    tot[w * 128 + d0] = cx; tot[w * 128 + d0 + 1] = cy;
#pragma unroll
    for (int et = 0; et < 2; ++et) {
      u32x2 o; o[0] = pk2(st[et][0], st[et][1]); o[1] = pk2(st[et][2], st[et][3]);
      *(LAS u32x2*)(lds + STS + (16 * et + fr) * 272 + (16 * w + 4 * fq) * 2) = o;
    }
    if (tid < 256) { const int r = tid >> 3, ch = tid & 7; *(LAS u32x4*)(lds + VTS + r * 144 + ch * 16) = vtreg; }
    __syncthreads();
    { const int tokn = bl * SEQ + (n < 63 ? n + 1 : 63) * 64; HG_LOADS(tokn); }
    float offx = 0.f, offy = 0.f, rx = 0.f, ry = 0.f, bx = 0.f, by = 0.f;
#pragma unroll
    for (int q = 0; q < 8; ++q) {
      const float tx = tot[q * 128 + d0], ty = tot[q * 128 + d0 + 1];
      if (q < w) { offx += tx; offy += ty; }
      if (q < 4) { rx += tx; ry += ty; }
      bx += tx; by += ty;
    }
    if (w == 0) { dec[d0] = __expf(bx); dec[d0 + 1] = __expf(by); }
    unsigned kbx[4], kby[4];
#pragma unroll
    for (int jj = 0; jj < 8; ++jj) {
      const float Bx = offx + px[jj], By = offy + py[jj];
      const float qx = bflo(q2[jj]), qy = bfhi(q2[jj]);
      const float kx = 1.0f - __expf(lx[jj]), ky = 1.0f - __expf(ly[jj]);
      const float e1x = __expf(fminf(fmaxf(Bx - rx, -80.f), 80.f)), e1y = __expf(fminf(fmaxf(By - ry, -80.f), 80.f));
      const float e2x = __expf(fminf(fmaxf(rx - Bx, -80.f), 80.f)), e2y = __expf(fminf(fmaxf(ry - By, -80.f), 80.f));
      const int j = 8 * w + jj;
      *(LAS unsigned*)(lds + QT + j * 272 + d0 * 2) = pk2(qx * e1x, qy * e1y);
      *(LAS unsigned*)(lds + KT + j * 272 + d0 * 2) = pk2(kx * e2x, ky * e2y);
      *(LAS unsigned*)(lds + QB + j * 272 + d0 * 2) = pk2(qx * __expf(Bx), qy * __expf(By));
      const float kbvx = kx * __expf(bx - Bx), kbvy = ky * __expf(by - By);
      if (jj & 1) { kbx[jj >> 1] = pk2(__uint_as_float(kbx[jj >> 1]), kbvx); kby[jj >> 1] = pk2(__uint_as_float(kby[jj >> 1]), kbvy); }
      else { kbx[jj >> 1] = __float_as_uint(kbvx); kby[jj >> 1] = __float_as_uint(kbvy); }
    }
    *(LAS u32x4*)(lds + KBT + d0 * 144 + (8 * w) * 2) = (u32x4){kbx[0], kbx[1], kbx[2], kbx[3]};
    *(LAS u32x4*)(lds + KBT + (d0 + 1) * 144 + (8 * w) * 2) = (u32x4){kby[0], kby[1], kby[2], kby[3]};
    __syncthreads();
    __builtin_amdgcn_sched_barrier(0);
#pragma unroll
    for (int jj = 0; jj < 2; ++jj) {
      const int jt = 2 * eh + jj;
      f32x4 sc = (f32x4){0.f, 0.f, 0.f, 0.f};
#pragma unroll
      for (int ks = 0; ks < 4; ++ks) sc = mfma16(ldfrag(lds, KT + (16 * jt + fr) * 272 + (32 * ks + 8 * fq) * 2), ldfrag(lds, QT + (16 * it + fr) * 272 + (32 * ks + 8 * fq) * 2), sc);
      const int i_ = 16 * it + fr, j0 = 16 * jt + 4 * fq;
      u32x2 o; o[0] = pk2(j0 + 0 <= i_ ? sc[0] : 0.f, j0 + 1 <= i_ ? sc[1] : 0.f); o[1] = pk2(j0 + 2 <= i_ ? sc[2] : 0.f, j0 + 3 <= i_ ? sc[3] : 0.f);
      *(LAS u32x2*)(lds + PS + i_ * 144 + j0 * 2) = o;
    }
    __syncthreads();
    __builtin_amdgcn_sched_barrier(0);
    {
      f32x4 o = (f32x4){0.f, 0.f, 0.f, 0.f};
#pragma unroll
      for (int k2 = 0; k2 < 2; ++k2) o = mfma16(ldfrag(lds, VTS + (16 * eh + fr) * 144 + (32 * k2 + 8 * fq) * 2), ldfrag(lds, PS + (16 * it + fr) * 144 + (32 * k2 + 8 * fq) * 2), o);
#pragma unroll
      for (int ks = 0; ks < 4; ++ks) o = mfma16(ldfrag(lds, STS + (16 * eh + fr) * 272 + (32 * ks + 8 * fq) * 2), ldfrag(lds, QB + (16 * it + fr) * 272 + (32 * ks + 8 * fq) * 2), o);
      float s2 = o[0] * o[0] + o[1] * o[1] + o[2] * o[2] + o[3] * o[3];
      u32x2 ov; ov[0] = pk2(o[0], o[1]); ov[1] = pk2(o[2], o[3]);
      *(u32x2*)obase = ov;
      s2 += shx(s2, 16, lane); s2 += shx(s2, 32, lane);
      if (fq == 0 && do_stats) unsafeAtomicAdd(sbase, s2);
    }
    __builtin_amdgcn_sched_barrier(0);
    {
      const f32x4 dv = *(const LAS f32x4*)(dec + 16 * w + 4 * fq);
#pragma unroll
      for (int et = 0; et < 2; ++et)
#pragma unroll
        for (int r = 0; r < 4; ++r) st[et][r] *= dv[r];
#pragma unroll
      for (int k2 = 0; k2 < 2; ++k2) {
        const bf16x8 kf = ldfrag(lds, KBT + (16 * w + fr) * 144 + (32 * k2 + 8 * fq) * 2);
#pragma unroll
        for (int et = 0; et < 2; ++et) st[et] = mfma16(kf, ldfrag(lds, VTS + (16 * et + fr) * 144 + (32 * k2 + 8 * fq) * 2), st[et]);
      }
    }
    __syncthreads();
  }
}
#ifndef REP_RET
#define REP_RET 1
#endif
#ifndef REP_HG
#define REP_HG 1
#endif
#ifndef REP_G1
#define REP_G1 1
#endif
#ifndef REP_G2
#define REP_G2 1
#endif
#ifndef REP_G4
#define REP_G4 1
#endif
#ifndef REP_SYNC
#define REP_SYNC 1
#endif
#ifndef REP_PRO
#define REP_PRO 1
#endif
#ifndef REP_S1
#define REP_S1 1
#endif
enum { ST_G1 = 0, ST_S1, ST_G1B, ST_G2, ST_G3, ST_L1, ST_G4, ST_G5, ST_L2 };
__global__ void __launch_bounds__(512, 2) mega(Params p0) {
  extern __shared__ __attribute__((aligned(16))) unsigned char shm[];
  ldsp lds = (ldsp)shm;
  cg::grid_group grid = cg::this_grid();
  Params p = p0; p.ws = oaddr(p0.ws); p.out = oaddr(p0.out); p.wv = __builtin_amdgcn_readfirstlane((int)(threadIdx.x >> 6));
  volatile LAS unsigned* xst = (volatile LAS unsigned*)(lds + 131072);
  if (threadIdx.x < 4) xst[threadIdx.x] = 0u;
  __syncthreads();
  (void)xcd_barrier_post((unsigned*)(p0.ws + OFF_SMALL + SM_BAR_BYTES), xst);
  for (int r = 0; r < REP_PRO; ++r) {
    p.ws = oaddr(p0.ws);
    phase_mod(lds, p);
    phase_conv(lds, p, 0);
    grid.sync();
  }
  phase_u0(p);
  gbar((unsigned*)(p0.ws + OFF_SMALL + SM_BAR_BYTES), xst);
  for (int pc = 0; pc < 28; ++pc) {
    p.ws = oaddr(p0.ws); p.out = oaddr(p0.out);
    const bf16_t* WB = (const bf16_t*)(p.ws + OFF_WB);
    const bf16_t* U = (const bf16_t*)(p.ws + OFF_U);
    unsigned char* R0 = p.ws + OFF_R0;
    const int l = pc / 14, k = pc - l * 14;
    int g = 0, stg;
    if (k < 10) { g = k / 5; stg = k - g * 5; } else stg = ST_L1 + (k - 10);
    int nj = 0, jmode0 = 0, jmode1 = 0; const bf16_t* jA0 = nullptr; const bf16_t* jA1 = nullptr; const bf16_t* jB0 = nullptr; const bf16_t* jB1 = nullptr;
    int jM0 = 0, jM1 = 0, jN0 = 0, jN1 = 0, jK0 = 0, jK1 = 0;
    if (stg == ST_G1) {
      float* stz = (float*)(p.ws + OFF_SMALL) + SM_STR;
      for (int i = obid() * 512 + otid(p.wv); i < TG * 16; i += gridDim.x * 512) stz[i] = 0.f;
      nj = 2;
      jmode0 = MD_G1A; jA0 = U + (size_t)g * TG * 1024; jB0 = WB + W1A; jM0 = TG; jN0 = 4096; jK0 = 1024;
      jmode1 = MD_G1S; jA1 = WB + W1S; jB1 = U + (size_t)g * TG * 1024; jM1 = 3072; jN1 = TG; jK1 = 1024;
    } else if (stg == ST_S1) {
      for (int rep = 0; rep < REP_S1; ++rep) {
        if (rep) { gbar((unsigned*)(p0.ws + OFF_SMALL + SM_BAR_BYTES), xst); float* stz = (float*)(p.ws + OFF_SMALL) + SM_STR; for (int i = obid() * 512 + otid(p.wv); i < TG * 16; i += gridDim.x * 512) stz[i] = 0.f; gbar((unsigned*)(p0.ws + OFF_SMALL + SM_BAR_BYTES), xst); }
        const int bid = obid();
        if (bid < 128) { for (int r2 = 0; r2 < REP_RET; ++r2) ret_item(lds, p, bid, r2 == REP_RET - 1); } else { for (int r2 = 0; r2 < REP_HG; ++r2) hgrn_item(lds, p, bid - 128, r2 == REP_HG - 1); }
      }
    } else if (stg == ST_G1B) {
      nj = 1; jmode0 = MD_G1B; jA0 = U + (size_t)g * TG * 1024; jB0 = WB + W1B; jM0 = TG; jN0 = 5120; jK0 = 1024;
    } else if (stg == ST_G2) {
      nj = 2;
      jmode0 = MD_G2A; jA0 = (const bf16_t*)(R0 + R_ORA); jB0 = WB + WPA; jM0 = TG; jN0 = 1024; jK0 = 1024;
      jmode1 = MD_G2B; jA1 = (const bf16_t*)(R0 + R_ORB); jB1 = WB + WPB; jM1 = TG; jN1 = 1024; jK1 = 2048;
    } else if (stg == ST_G3) {
      nj = 1; jmode0 = MD_G3; jA0 = (const bf16_t*)(R0 + R_MG); jB0 = WB + WO; jM0 = TG; jN0 = 1024; jK0 = 1024;
    } else if (stg == ST_L1) {
      phase_ln(p, p.ln1_g + l * 1024, p.ln1_b + l * 1024, l, 3, false);
    } else if (stg == ST_G4) {
      nj = 1; jmode0 = MD_G4; jA0 = U; jB0 = WB + WUP; jM0 = T_ALL; jN0 = 4096; jK0 = 1024;
    } else if (stg == ST_G5) {
      nj = 1; jmode0 = MD_G5; jA0 = (const bf16_t*)R0; jB0 = WB + WDN; jM0 = T_ALL; jN0 = 1024; jK0 = 4096;
    } else {
      phase_ln(p, p.ln2_g + l * 1024, p.ln2_b + l * 1024, l == 0 ? 1 : 0, 0, l == 1);
      if (l == 0) phase_conv(lds, p, 1);
    }
    for (int j = 0; j < nj * (stg == ST_G4 ? REP_G4 : 1) * (stg == ST_G1 ? REP_G1 : 1) * (stg == ST_G2 ? REP_G2 : 1); ++j) {
      pg8::Gemm gm; const bool j1 = (nj == 2 && (j & 1) == 1); gm.A = j1 ? jA1 : jA0; gm.Bt = j1 ? jB1 : jB0; gm.M = j1 ? jM1 : jM0; gm.N = j1 ? jN1 : jN0; gm.K = j1 ? jK1 : jK0;
      pg8::StaticOrder S; S.init(gm.M, gm.N, (int)gridDim.x, obid());
      EpiP E; E.mode = j1 ? jmode1 : jmode0; E.l = l; E.g = g; E.pp = &p;
      pg8::gemm_phase<EpiP, pg8::StaticOrder, false>((PG8_LAS unsigned char*)shm, gm, S, E, nullptr);
    }
    for (int r = 0; r < REP_SYNC; ++r) gbar((unsigned*)(p0.ws + OFF_SMALL + SM_BAR_BYTES), xst);
  }
}

extern "C" void kernel_launch(void* const* d_in, const int* in_sizes, int n_in, void* d_out, int out_size,
                              void* d_ws, size_t ws_size, hipStream_t stream) {
  constexpr size_t kDynLds = 131072 + 16;
  static int configured = 0;
  if (!configured) {
    (void)hipFuncSetAttribute((const void*)mega, hipFuncAttributeMaxDynamicSharedMemorySize, (int)kDynLds);
    configured = 1;
  }
  Params p{};
  p.x = (const float*)d_in[0]; p.c = (const float*)d_in[1]; p.pos = (const int*)d_in[2]; p.lb_logits = (const float*)d_in[3];
  p.w_ada = (const float*)d_in[4]; p.b_ada = (const float*)d_in[5]; p.w_in = (const float*)d_in[6]; p.w_pa = (const float*)d_in[7];
  p.w_pb = (const float*)d_in[8]; p.w_o = (const float*)d_in[9]; p.ln1_g = (const float*)d_in[10]; p.ln1_b = (const float*)d_in[11];
  p.w_up = (const float*)d_in[12]; p.b_up = (const float*)d_in[13]; p.w_down = (const float*)d_in[14]; p.b_down = (const float*)d_in[15];
  p.ln2_g = (const float*)d_in[16]; p.ln2_b = (const float*)d_in[17];
  p.out = (float*)d_out; p.ws = (unsigned char*)d_ws;
  if (ws_size < 512ull * 1024 * 1024) { fprintf(stderr, "workspace too small\n"); return; }
  (void)hipMemsetAsync((unsigned char*)d_ws + OFF_SMALL + SM_BAR_BYTES, 0, XCD_BAR_WORDS * 4, stream);
  void* args[] = {&p};
  hipError_t e = hipLaunchCooperativeKernel((void*)mega, dim3(256), dim3(512), args, kDynLds, stream);
  if (e != hipSuccess) fprintf(stderr, "cooperative launch failed: %s\n", hipGetErrorString(e));
}
```

```cpp
#include <hip/hip_runtime.h>
#include <hip/hip_cooperative_groups.h>
#include <cstdio>
namespace cg = cooperative_groups;
__device__ __forceinline__ int otid(int wv) { int t = (wv << 6) | (int)__builtin_amdgcn_mbcnt_hi(~0u, __builtin_amdgcn_mbcnt_lo(~0u, 0u)); asm volatile("" : "+v"(t)); return t; }
__device__ __forceinline__ int obid() { int t = blockIdx.x; asm volatile("" : "+s"(t)); return t; }
template <class T> __device__ __forceinline__ T* oaddr(T* q) { asm volatile("" : "+s"(q)); return q; }
namespace pg8 {
#define PG8_LAS __attribute__((address_space(3)))
typedef unsigned short bf16_t;
typedef short bf16x8 __attribute__((ext_vector_type(8)));
typedef float f32x4 __attribute__((ext_vector_type(4)));
typedef unsigned u32x4 __attribute__((ext_vector_type(4)));
constexpr int BM = 256, BK = 64, HALF = 128, HTB = HALF * BK * 2  , STAGE_BYTES = 8 * HTB, NXCD = 8, WGM = 8;

__host__ __device__ __forceinline__ int lds_byte(int r, int c) { const int st = (r >> 4) * 2 + (c >> 5), rr = r & 15, cc = c & 31, ob = rr * 64 + cc * 2; return st * 1024 + (ob ^ (((ob >> 9) & 1) << 5)); }
__host__ __device__ __forceinline__ void stage_rc(int b, int& R, int& C) { const int st = b / 1024, sb = b % 1024, swz = sb ^ (((sb >> 9) & 1) << 5); R = (st >> 1) * 16 + swz / 64; C = (st & 1) * 32 + (swz % 64) / 2; }
__host__ __device__ __forceinline__ int perm32(int rho) { const int n = rho >> 4, i = rho & 15; return 8 * (i >> 2) + 4 * n + (i & 3); }

struct Unit { int pm, pn; };
struct Gemm { const bf16_t* A; const bf16_t* Bt; int M, N, K; };

struct StaticOrder {
    int nM, nN, nwg, G, c;
    __host__ __device__ void init(int M, int N, int G_, int c_) { nM = M / BM; nN = N / BM; nwg = nM * nN; G = G_; c = c_; }
    __host__ __device__ bool next(int i, Unit& u) const {
        const long L = (long)i * G + c; if (L >= nwg) return false;
        int wgid = (int)L; { const int q = nwg / NXCD, r = nwg % NXCD, xcd = wgid % NXCD, off = wgid / NXCD; wgid = (xcd < r ? xcd * (q + 1) : r * (q + 1) + (xcd - r) * q) + off; }
        const int nig = WGM * nN, gid = wgid / nig, fm = gid * WGM, gsz = (nM - fm) < WGM ? (nM - fm) : WGM;
        u.pm = fm + ((wgid % nig) % gsz); u.pn = (wgid % nig) / gsz; return true;
    }
    __device__ __forceinline__ void a_ready(const Unit&) const {}
    __device__ __forceinline__ void done(const Unit&) const {}
};
__device__ __forceinline__ unsigned cvt_pk_bf16(float lo, float hi) { unsigned r; asm volatile("v_cvt_pk_bf16_f32 %0, %1, %2" : "=v"(r) : "v"(lo), "v"(hi)); return r; }

template <class Epi, class Sched, bool STAMP = false>
__device__ __forceinline__ void gemm_phase(PG8_LAS unsigned char* lds, const Gemm g, const Sched& S, const Epi& E, unsigned long long* stamps) {
    const int tid = otid(E.pp->wv), wid = __builtin_amdgcn_readfirstlane(tid >> 6), lane = tid & 63, wr = wid >> 2, wc = wid & 3, fr = lane & 15, fq = lane >> 4;
    const int K = g.K, nt = K / BK;
    int ts_lo = 0, ts_hi = 0, nts = 0; const unsigned long long rt_entry = STAMP ? (unsigned long long)wall_clock64() : 0ull;
#define PG8_STAMP() do { if (STAMP && wid == 0 && nts < 64) { const unsigned long long _c = (unsigned long long)clock64(); \
        ts_lo = (lane == nts) ? (int)(unsigned)_c : ts_lo; ts_hi = (lane == nts) ? (int)(unsigned)(_c >> 32) : ts_hi; ++nts; } } while (0)
    PG8_STAMP();
    unsigned voffA[2], voffB[2];
#pragma unroll
    for (int i = 0; i < 2; ++i) { int R, C; stage_rc(tid * 16 + i * 8192, R, C); const int Rb = Epi::PERM ? ((R & ~31) + perm32(R & 31)) : R;
        voffA[i] = (unsigned)(R * K + C) * 2u; voffB[i] = (unsigned)(Rb * K + C) * 2u; }
    const size_t kstep = (size_t)(BK * 2);
    const size_t hstep = (size_t)HALF * K * 2;
    const size_t tstep = 2 * hstep;
    const unsigned ldsw = (unsigned)wid * 1024u;
    const int aoff = lds_byte(wr * 64 + fr, fq * 8), boff = lds_byte(wc * 32 + fr, fq * 8);
#define PG8_SA(b, h) (((b) * 2 + (h)) * HTB)
#define PG8_SB(b, h) ((4 + (b) * 2 + (h)) * HTB)
#define PG8_STAGE(bufoff, gbase, voff) do { _Pragma("unroll") for (int _i = 0; _i < 2; ++_i) \
        __builtin_amdgcn_global_load_lds((const unsigned*)((const char*)(gbase) + (voff)[_i]), (PG8_LAS unsigned*)(lds + (bufoff) + ldsw + _i * 8192), 16, 0, 0); } while (0)
#define PG8_LDA(dst, b, h) do { _Pragma("unroll") for (int m = 0; m < 4; ++m) _Pragma("unroll") for (int k = 0; k < 2; ++k) dst[m][k] = *(const PG8_LAS bf16x8*)(lds + PG8_SA(b, h) + aoff + m * 2048 + k * 1024); } while (0)
#define PG8_LDB(dst, b, h) do { _Pragma("unroll") for (int n = 0; n < 2; ++n) _Pragma("unroll") for (int k = 0; k < 2; ++k) dst[n][k] = *(const PG8_LAS bf16x8*)(lds + PG8_SB(b, h) + boff + n * 2048 + k * 1024); } while (0)
#define PG8_MMA(ai, bj, At, Bt) do { __builtin_amdgcn_s_setprio(1); _Pragma("unroll") for (int m = 0; m < 4; ++m) _Pragma("unroll") for (int n = 0; n < 2; ++n) _Pragma("unroll") for (int k = 0; k < 2; ++k) \
        acc[ai][bj][m][n] = __builtin_amdgcn_mfma_f32_16x16x32_bf16(Bt[n][k], At[m][k], acc[ai][bj][m][n], 0, 0, 0); __builtin_amdgcn_s_setprio(0); } while (0)
#define PG8_WAIT_V(n) asm volatile("s_waitcnt vmcnt(" #n ")" ::: "memory")
#define PG8_WAIT_L(n) asm volatile("s_waitcnt lgkmcnt(" #n ")" ::: "memory")
#define PG8_BAR __builtin_amdgcn_s_barrier()
#define PG8_SCHED __builtin_amdgcn_sched_barrier(0)
    Unit cur, nxt; int ui = 0;
    if (!S.next(0, cur)) return;
    f32x4 acc[2][2][4][2];
#pragma unroll
    for (int a = 0; a < 2; ++a)
#pragma unroll
        for (int b = 0; b < 2; ++b)
#pragma unroll
            for (int m = 0; m < 4; ++m)
#pragma unroll
                for (int n = 0; n < 2; ++n) acc[a][b][m][n] = (f32x4){0.f, 0.f, 0.f, 0.f};
    bf16x8 At[4][2], B0[2][2], B1[2][2];
    const char* cA = (const char*)g.A + (size_t)cur.pm * tstep; const char* cB = (const char*)g.Bt + (size_t)cur.pn * tstep;
    S.a_ready(cur);
    PG8_STAGE(PG8_SB(0, 0), cB, voffB); PG8_STAGE(PG8_SA(0, 0), cA, voffA); PG8_STAGE(PG8_SB(0, 1), cB + hstep, voffB); PG8_STAGE(PG8_SA(0, 1), cA + hstep, voffA);
    if (wr == 1) PG8_BAR;
    PG8_WAIT_V(4); PG8_BAR;
    PG8_STAGE(PG8_SB(1, 0), cB + kstep, voffB); PG8_STAGE(PG8_SA(1, 0), cA + kstep, voffA); PG8_STAGE(PG8_SB(1, 1), cB + hstep + kstep, voffB);
    PG8_WAIT_V(6); PG8_BAR;
    PG8_STAMP();
    for (;;) {
        const bool has_next = S.next(ui + 1, nxt);
        const char* nA = has_next ? (const char*)g.A + (size_t)nxt.pm * tstep : cA; const char* nB = has_next ? (const char*)g.Bt + (size_t)nxt.pn * tstep : cB;
        for (int t = 0; t < nt; t += 2) {
            const bool last = (t == nt - 2);
            const char* a1 = cA + (size_t)(t + 1) * kstep;
            const char* a2 = last ? nA : cA + (size_t)(t + 2) * kstep; const char* b2 = last ? nB : cB + (size_t)(t + 2) * kstep;
            const char* a3 = a2 + kstep; const char* b3 = b2 + kstep;
            if (last && has_next) S.a_ready(nxt);
            PG8_LDB(B0, 0, 0); PG8_SCHED; PG8_LDA(At, 0, 0); PG8_STAGE(PG8_SA(1, 1), a1 + hstep, voffA);
            PG8_WAIT_L(8); PG8_BAR; PG8_WAIT_L(0); PG8_MMA(0, 0, At, B0); PG8_BAR; PG8_SCHED;
            PG8_LDB(B1, 0, 1); PG8_STAGE(PG8_SB(0, 0), b2, voffB);
            PG8_BAR; PG8_WAIT_L(0); PG8_MMA(0, 1, At, B1); PG8_BAR;
            PG8_LDA(At, 0, 1); PG8_STAGE(PG8_SA(0, 0), a2, voffA);
            PG8_BAR; PG8_WAIT_L(0); PG8_MMA(1, 0, At, B0); PG8_BAR; PG8_SCHED;
            PG8_STAGE(PG8_SB(0, 1), b2 + hstep, voffB);
            PG8_WAIT_V(6); PG8_BAR; PG8_MMA(1, 1, At, B1); PG8_BAR;
            PG8_LDB(B0, 1, 0); PG8_SCHED; PG8_LDA(At, 1, 0); PG8_STAGE(PG8_SA(0, 1), a2 + hstep, voffA);
            PG8_WAIT_L(8); PG8_BAR; PG8_WAIT_L(0); PG8_MMA(0, 0, At, B0); PG8_BAR; PG8_SCHED;
            PG8_LDB(B1, 1, 1); PG8_STAGE(PG8_SB(1, 0), b3, voffB);
            PG8_BAR; PG8_WAIT_L(0); PG8_MMA(0, 1, At, B1); PG8_BAR;
            PG8_LDA(At, 1, 1); PG8_STAGE(PG8_SA(1, 0), a3, voffA);
            PG8_BAR; PG8_WAIT_L(0); PG8_MMA(1, 0, At, B0); PG8_BAR; PG8_SCHED;
            PG8_STAGE(PG8_SB(1, 1), b3 + hstep, voffB);
            PG8_WAIT_V(6); PG8_BAR; PG8_MMA(1, 1, At, B1); PG8_BAR;
        }
        PG8_STAMP();
        if constexpr (!Epi::AFTER_DRAIN) { E(acc, cur, wr, wc, fr, fq); S.done(cur); }
        PG8_STAMP();
        if (!has_next) break;
#pragma unroll
        for (int a = 0; a < 2; ++a)
#pragma unroll
            for (int b = 0; b < 2; ++b)
#pragma unroll
                for (int m = 0; m < 4; ++m)
#pragma unroll
                    for (int n = 0; n < 2; ++n) acc[a][b][m][n] = (f32x4){0.f, 0.f, 0.f, 0.f};
        cur = nxt; cA = nA; cB = nB; ++ui;
    }
    PG8_WAIT_V(0);
    if (wr == 0) PG8_BAR;
    PG8_BAR;
    if constexpr (Epi::AFTER_DRAIN) { E.fused(acc, cur, wr, wc, fr, fq, lds, wid, lane); S.done(cur); }
    PG8_STAMP();
    if (STAMP && wid == 0) { stamps[lane] = lane < nts ? (((unsigned long long)(unsigned)ts_hi << 32) | (unsigned)ts_lo) : 0ull;
        if (lane == 62) stamps[62] = rt_entry; if (lane == 63) stamps[63] = (unsigned long long)wall_clock64(); }
#undef PG8_STAMP
#undef PG8_SA
#undef PG8_SB
#undef PG8_STAGE
#undef PG8_LDA
#undef PG8_LDB
#undef PG8_MMA
#undef PG8_WAIT_V
#undef PG8_WAIT_L
#undef PG8_BAR
#undef PG8_SCHED
}
}
using pg8::bf16_t; using pg8::bf16x8; using pg8::f32x4; using pg8::u32x4; using pg8::Unit;
typedef unsigned u32x2 __attribute__((ext_vector_type(2)));
#define LAS __attribute__((address_space(3)))
typedef LAS unsigned char* ldsp;

constexpr int T_ALL = 32768, TG = 16384, DM = 1024, SEQ = 4096;
constexpr float ALPHA = 1.4142135623730951f;
constexpr size_t MB = 1024ull * 1024ull;
constexpr size_t OFF_XB = 0, OFF_WB = 128 * MB, OFF_U = 184 * MB, OFF_SMALL = 248 * MB, OFF_R0 = 256 * MB;
constexpr size_t W1A = 0, W1S = W1A + 4096ull * 1024, W1B = W1S + 3072ull * 1024, WPA = W1B + 5120ull * 1024, WPB = WPA + 1024ull * 1024,
                 WO = WPB + 1024ull * 2048, WUP = WO + 1024ull * 1024, WDN = WUP + 4096ull * 1024, W_END = WDN + 4096ull * 1024;
static_assert(W_END * 2 <= 56 * MB, "weights");
constexpr size_t SM_MOD = 0  , SM_LB = 2 * 8 * 6144  , SM_STR = SM_LB + 2048  , SM_STH = SM_STR + (size_t)TG * 8  , SM_END = SM_STH + (size_t)TG * 8;
constexpr size_t SM_BAR_BYTES = 7 * MB;
static_assert(SM_END * 4 <= 7 * MB, "small");
constexpr size_t R_QH = 0, R_VIT = 32 * MB, R_QR = 64 * MB, R_KR = 96 * MB, R_KRT = 128 * MB, R_ORA = 160 * MB, R_ORB = 192 * MB;
constexpr size_t R_SGA = R_QH, R_SGB = R_VIT, R_M1 = R_QR, R_MG = R_KRT;
constexpr size_t D_LF = 0, D_VRT = 64 * MB;

struct Params {
  const float* x; const float* c; const int* pos; const float* lb_logits; const float* w_ada; const float* b_ada; const float* w_in; const float* w_pa; const float* w_pb;
  const float* w_o; const float* ln1_g; const float* ln1_b; const float* w_up; const float* b_up; const float* w_down; const float* b_down; const float* ln2_g; const float* ln2_b;
  float* out; unsigned char* ws; int wv; int pad;
};

__device__ __forceinline__ float bf2f(unsigned short b) { return __uint_as_float(((unsigned)b) << 16); }
__device__ __forceinline__ float bflo(unsigned u) { return __uint_as_float(u << 16); }
__device__ __forceinline__ float bfhi(unsigned u) { return __uint_as_float(u & 0xffff0000u); }
typedef float f32x2_ __attribute__((ext_vector_type(2)));
typedef __bf16 bf16x2_ __attribute__((ext_vector_type(2)));
__device__ __forceinline__ unsigned pk2(float lo, float hi) { const f32x2_ v = {lo, hi}; const bf16x2_ b = __builtin_convertvector(v, bf16x2_); return __builtin_bit_cast(unsigned, b); }
__device__ __forceinline__ float sigmoidf_(float v) { return __builtin_amdgcn_rcpf(1.0f + __expf(-v)); }
__device__ __forceinline__ float siluf_(float v) { return v * sigmoidf_(v); }
__device__ __forceinline__ f32x4 mfma16(bf16x8 a, bf16x8 b, f32x4 c) { return __builtin_amdgcn_mfma_f32_16x16x32_bf16(a, b, c, 0, 0, 0); }
__device__ __forceinline__ bf16x8 ldfrag(ldsp base, int off) { return *(const LAS bf16x8*)(base + off); }
__device__ __forceinline__ float shx(float v, int mask, int lane) { return __int_as_float(__builtin_amdgcn_ds_bpermute((lane ^ mask) << 2, __float_as_int(v))); }
__device__ __forceinline__ float wave_sum(float v, int lane) {
#pragma unroll
  for (int o = 32; o > 0; o >>= 1) v += shx(v, o, lane);
  return v;
}

#ifdef USE_NT
#define NTS(val, ptr) __builtin_nontemporal_store((val), (ptr))
#else
#define NTS(val, ptr) (*(ptr) = (val))
#endif
enum { MD_G1A = 0, MD_G1S, MD_G1B, MD_G2A, MD_G2B, MD_G3, MD_G4, MD_G5 };
struct EpiP {
  static constexpr bool PERM = true, AFTER_DRAIN = false;
  int mode, l, g;
  const Params* pp;
  template <int MODE, int ai, int m> __device__ __forceinline__ void rowf(const f32x4 (&acc)[2][2][4][2], const Unit& u, int wr, int wc, int fr, int fq) const {
    const Params& p = *pp;
    unsigned char* R0 = p.ws + OFF_R0; unsigned char* DO = (unsigned char*)p.out;
    float* small = (float*)(p.ws + OFF_SMALL);
    const float* mod = small + SM_MOD + (size_t)l * 8 * 6144;
      {
        const int row = u.pm * 256 + ai * 128 + wr * 64 + m * 16 + fr;
#pragma unroll
        for (int bj = 0; bj < 2; ++bj) {
          const int col = u.pn * 256 + bj * 128 + wc * 32 + 8 * fq;
          float v[8];
#pragma unroll
          for (int i = 0; i < 4; ++i) { v[i] = acc[ai][bj][m][0][i]; v[4 + i] = acc[ai][bj][m][1][i]; }
          if constexpr (MODE == MD_G1A) {
            const int sec = col >> 10, cs = col & 1023;
            if (sec == 0) {
              u32x4 o;
#pragma unroll
              for (int i = 0; i < 4; ++i) o[i] = pk2(siluf_(v[2 * i]), siluf_(v[2 * i + 1]));
              NTS(o, (u32x4*)(R0 + R_QH + ((size_t)row * 1024 + cs) * 2));
            } else if (sec == 1) {
              const float* lbp = small + SM_LB + l * 1024 + cs;
              const f32x4 l0 = *(const f32x4*)lbp, l1 = *(const f32x4*)(lbp + 4);
              float o[8];
              if (l == 0) {
#pragma unroll
                for (int i = 0; i < 8; ++i) { const float z = v[i]; o[i] = fminf(z, 0.f) - __logf(1.0f + __expf(-fabsf(z))); }
              } else {
#pragma unroll
                for (int i = 0; i < 8; ++i) {
                  const float lbv = i < 4 ? l0[i & 3] : l1[i & 3];
                  const float z = v[i], e = __expf(-fabsf(z)), r = __builtin_amdgcn_rcpf(1.0f + e);
                  const float sg = z >= 0.f ? r : e * r;
                  o[i] = __logf(lbv + (1.f - lbv) * sg);
                }
              }
              float* dst = (float*)(DO + D_LF) + (size_t)row * 1024 + cs;
              NTS(((f32x4){o[0], o[1], o[2], o[3]}), (f32x4*)dst); NTS(((f32x4){o[4], o[5], o[6], o[7]}), (f32x4*)(dst + 4));
            } else {
              const float posf = (float)p.pos[g * TG + row];
              const float sc = sec == 3 ? 0.0625f : 1.0f;
              const int p0 = (cs & 255) >> 1;
              u32x4 o;
#pragma unroll
              for (int i = 0; i < 4; ++i) {
                const float theta = __builtin_amdgcn_exp2f(-13.287712379549449f * (float)(p0 + i) * (1.0f / 127.0f));
                float rev = posf * theta * 0.15915494309189535f; rev -= floorf(rev);
                const float sn = __builtin_amdgcn_sinf(rev), cn = __builtin_amdgcn_cosf(rev);
                const float t1 = v[2 * i], t2 = v[2 * i + 1];
                o[i] = pk2((t1 * cn - t2 * sn) * sc, (t1 * sn + t2 * cn) * sc);
              }
              NTS(o, (u32x4*)(R0 + (sec == 2 ? R_QR : R_KR) + ((size_t)row * 1024 + cs) * 2));
            }
          } else if constexpr (MODE == MD_G1S) {
            const int sec = row >> 10;
            if (sec == 0) {
              u32x4 o;
#pragma unroll
              for (int i = 0; i < 4; ++i) o[i] = pk2(v[2 * i], v[2 * i + 1]);
              NTS(o, (u32x4*)(R0 + R_VIT + ((size_t)row * TG + col) * 2));
            } else {
              const int f = row - 1024, h = (u.pm * 256 - 1024) >> 9;
              const float lg2 = __log2f(1.0f - __builtin_amdgcn_exp2f(-5.0f - (float)h));
              float o[8];
#pragma unroll
              for (int i = 0; i < 8; ++i) o[i] = v[i] * __builtin_amdgcn_exp2f(lg2 * (float)(63 - ((col + i) & 63)));
              u32x4 ov;
#pragma unroll
              for (int i = 0; i < 4; ++i) ov[i] = pk2(o[2 * i], o[2 * i + 1]);
              NTS(ov, (u32x4*)(DO + D_VRT + ((size_t)f * TG + col) * 2));
            }
          } else if constexpr (MODE == MD_G1B) {
            const int sec = col >> 10, cs = col & 1023;
            if (sec == 0) {
              const float ss = (small + SM_STH)[(size_t)row * 8 + (cs >> 7)];
              const float rstd = rsqrtf(ss * (1.0f / 128.0f) + 1e-6f);
              u32x4* ptr = (u32x4*)(R0 + R_ORA + ((size_t)row * 1024 + cs) * 2);
              const u32x4 ov = *ptr; u32x4 o;
#pragma unroll
              for (int i = 0; i < 4; ++i) o[i] = pk2(bflo(ov[i]) * rstd * siluf_(v[2 * i]), bfhi(ov[i]) * rstd * siluf_(v[2 * i + 1]));
              NTS(o, ptr);
            } else if (sec < 3) {
              const int c2 = col - 1024;
              const float* st = small + SM_STR + ((size_t)row * 4 + (c2 >> 9)) * 2;
              const float mean = st[0] * (1.0f / 512.0f);
              const float var = fmaxf(st[1] * (1.0f / 512.0f) - mean * mean, 0.f);
              const float rstd = rsqrtf(var + 1e-6f);
              u32x4* ptr = (u32x4*)(R0 + R_ORB + ((size_t)row * 2048 + c2) * 2);
              const u32x4 ov = *ptr; u32x4 o;
#pragma unroll
              for (int i = 0; i < 4; ++i) o[i] = pk2((bflo(ov[i]) - mean) * rstd * siluf_(v[2 * i]), (bfhi(ov[i]) - mean) * rstd * siluf_(v[2 * i + 1]));
              NTS(o, ptr);
            } else {
              u32x4 o;
#pragma unroll
              for (int i = 0; i < 4; ++i) o[i] = pk2(sigmoidf_(v[2 * i]), sigmoidf_(v[2 * i + 1]));
              NTS(o, (u32x4*)(R0 + (sec == 3 ? R_SGA : R_SGB) + ((size_t)row * 1024 + cs) * 2));
            }
          } else if constexpr (MODE == MD_G2A) {
            const u32x4 gv = *(const u32x4*)(R0 + R_SGA + ((size_t)row * 1024 + col) * 2);
            float* dst = (float*)(R0 + R_M1) + (size_t)row * 1024 + col;
            NTS(((f32x4){bflo(gv[0]) * v[0], bfhi(gv[0]) * v[1], bflo(gv[1]) * v[2], bfhi(gv[1]) * v[3]}), (f32x4*)dst);
            NTS(((f32x4){bflo(gv[2]) * v[4], bfhi(gv[2]) * v[5], bflo(gv[3]) * v[6], bfhi(gv[3]) * v[7]}), (f32x4*)(dst + 4));
          } else if constexpr (MODE == MD_G2B) {
            const u32x4 gv = *(const u32x4*)(R0 + R_SGB + ((size_t)row * 1024 + col) * 2);
            const float* src = (const float*)(R0 + R_M1) + (size_t)row * 1024 + col;
            const f32x4 m0 = *(const f32x4*)src, m1 = *(const f32x4*)(src + 4);
            u32x4 o;
            o[0] = pk2(m0[0] + bflo(gv[0]) * v[0], m0[1] + bfhi(gv[0]) * v[1]);
            o[1] = pk2(m0[2] + bflo(gv[1]) * v[2], m0[3] + bfhi(gv[1]) * v[3]);
            o[2] = pk2(m1[0] + bflo(gv[2]) * v[4], m1[1] + bfhi(gv[2]) * v[5]);
            o[3] = pk2(m1[2] + bflo(gv[3]) * v[6], m1[3] + bfhi(gv[3]) * v[7]);
            NTS(o, (u32x4*)(R0 + R_MG + ((size_t)row * 1024 + col) * 2));
          } else if constexpr (MODE == MD_G3) {
            const int tg = g * TG + row, b = tg >> 12;
            const float* xin = (l == 0 ? p.x : (const float*)(p.ws + OFF_XB)) + (size_t)tg * 1024 + col;
            const float* gt = mod + (size_t)b * 6144 + 2 * 1024 + col;
            const f32x4 x0 = *(const f32x4*)xin, x1 = *(const f32x4*)(xin + 4), g0 = *(const f32x4*)gt, g1 = *(const f32x4*)(gt + 4);
            float* dst = (float*)(p.ws + OFF_XB) + (size_t)tg * 1024 + col;
            f32x4 o0, o1;
#pragma unroll
            for (int i = 0; i < 4; ++i) { o0[i] = ALPHA * x0[i] + (1.f + g0[i]) * v[i]; o1[i] = ALPHA * x1[i] + (1.f + g1[i]) * v[4 + i]; }
            NTS(o0, (f32x4*)dst); NTS(o1, (f32x4*)(dst + 4));
          } else if constexpr (MODE == MD_G4) {
            const float* bp = p.b_up + (size_t)l * 4096 + col;
            const f32x4 b0 = *(const f32x4*)bp, b1 = *(const f32x4*)(bp + 4);
            float o[8];
#pragma unroll
            for (int i = 0; i < 8; ++i) { const float hh = fmaxf(v[i] + (i < 4 ? b0[i & 3] : b1[i & 3]), 0.f); o[i] = hh * hh; }
            u32x4 ov;
#pragma unroll
            for (int i = 0; i < 4; ++i) ov[i] = pk2(o[2 * i], o[2 * i + 1]);
            NTS(ov, (u32x4*)(R0 + ((size_t)row * 4096 + col) * 2));
          } else if constexpr (MODE == MD_G5) {
            const int b = row >> 12;
            float* dst = (float*)(p.ws + OFF_XB) + (size_t)row * 1024 + col;
            const float* gt = mod + (size_t)b * 6144 + 5 * 1024 + col;
            const float* bp = p.b_down + (size_t)l * 1024 + col;
            const f32x4 x0 = *(const f32x4*)dst, x1 = *(const f32x4*)(dst + 4), g0 = *(const f32x4*)gt, g1 = *(const f32x4*)(gt + 4), b0 = *(const f32x4*)bp, b1 = *(const f32x4*)(bp + 4);
            f32x4 o0, o1;
#pragma unroll
            for (int i = 0; i < 4; ++i) { o0[i] = ALPHA * x0[i] + (1.f + g0[i]) * (v[i] + b0[i]); o1[i] = ALPHA * x1[i] + (1.f + g1[i]) * (v[4 + i] + b1[i]); }
            NTS(o0, (f32x4*)dst); NTS(o1, (f32x4*)(dst + 4));
          }
        }
      }
  }
  template <int MODE> __device__ __forceinline__ void run(const f32x4 (&acc)[2][2][4][2], const Unit& u, int wr, int wc, int fr, int fq) const {
    #define RW(a, b) rowf<MODE, a, b>(acc, u, wr, wc, fr, fq);
    RW(0, 0) RW(0, 1) RW(0, 2) RW(0, 3) RW(1, 0) RW(1, 1) RW(1, 2) RW(1, 3)
#undef RW
  }
  __device__ __forceinline__ void operator()(const f32x4 (&acc)[2][2][4][2], const Unit& u, int wr, int wc, int fr, int fq) const {
    switch (mode) {
      case MD_G1A: run<MD_G1A>(acc, u, wr, wc, fr, fq); break;
      case MD_G1S: run<MD_G1S>(acc, u, wr, wc, fr, fq); break;
      case MD_G1B: run<MD_G1B>(acc, u, wr, wc, fr, fq); break;
      case MD_G2A: run<MD_G2A>(acc, u, wr, wc, fr, fq); break;
      case MD_G2B: run<MD_G2B>(acc, u, wr, wc, fr, fq); break;
      case MD_G3: run<MD_G3>(acc, u, wr, wc, fr, fq); break;
      case MD_G4: run<MD_G4>(acc, u, wr, wc, fr, fq); break;
      default: run<MD_G5>(acc, u, wr, wc, fr, fq); break;
    }
  }
};
#define XB_TMO      128
#define XB_XCNT(j)  (256  + 64 * (j))
#define XB_XSUB(j)  (1280 + 64 * (j))
#define XB_XGEN(j)  (2304 + 64 * (j))
#define XB_TOP      3328
#define XB_TOPGEN   3392
#define XCD_BAR_WORDS 3456
#define XB_SPIN_CAP (1u << 18)

__device__ __forceinline__ unsigned xb_ld(unsigned* p)              { return __hip_atomic_load(p, __ATOMIC_RELAXED, __HIP_MEMORY_SCOPE_AGENT); }
__device__ __forceinline__ unsigned xb_add(unsigned* p, unsigned v) { return __hip_atomic_fetch_add(p, v, __ATOMIC_RELAXED, __HIP_MEMORY_SCOPE_AGENT); }
__device__ __forceinline__ unsigned xb_xcc_id() { return (unsigned)__builtin_amdgcn_s_getreg((3 << 11) | 20) & 0xFu; }
#define XB_SPIN(cond, bar) do { unsigned _sp = 0; while (cond) { __builtin_amdgcn_s_sleep(1); \
    if ((++_sp & 255u) == 0u) { if (xb_ld(&(bar)[XB_TMO])) break; if (_sp > XB_SPIN_CAP) { atomicAdd(&(bar)[XB_TMO], 1u); break; } } } } while (0)

struct XcdBarrier {
    unsigned* bar; unsigned x;
    volatile LAS unsigned* st;
};

__device__ __forceinline__ XcdBarrier xcd_barrier_post(unsigned* bar, volatile LAS unsigned* st) {
    XcdBarrier b; b.bar = bar; b.x = xb_xcc_id(); b.st = st;
    if (threadIdx.x == 0) (void)xb_add(&bar[XB_XCNT(b.x)], 1u);
    return b;
}
__device__ __forceinline__ void xcd_barrier_complete(unsigned* bar, unsigned x, unsigned& nloc, unsigned& nx) {
    const unsigned G = gridDim.x * gridDim.y * gridDim.z;
    unsigned sum, cnt, mine, sp = 0u;
    for (;;) {
        sum = 0u; cnt = 0u; mine = 0u;
#pragma unroll
        for (unsigned j = 0; j < 16; ++j) { const unsigned c = xb_ld(&bar[XB_XCNT(j)]); sum += c; cnt += (c > 0u) ? 1u : 0u; mine = (j == x) ? c : mine; }
        if (sum == G) break;
        __builtin_amdgcn_s_sleep(1);
        if ((++sp & 255u) == 0u) { if (xb_ld(&bar[XB_TMO])) break; if (sp > XB_SPIN_CAP) { atomicAdd(&bar[XB_TMO], 1u); break; } }
    }
    nloc = mine > 0u ? mine : 1u; nx = cnt > 0u ? cnt : 1u;
}

__device__ __forceinline__ void xcd_barrier(const XcdBarrier& b) {
    asm volatile("s_waitcnt vmcnt(0)" ::: "memory");
    __syncthreads();
    if (threadIdx.x == 0) {
        unsigned* bar = b.bar;
        __builtin_amdgcn_s_waitcnt(0);
        unsigned nloc = b.st[0], nx = b.st[1];
        if (nloc == 0u) { xcd_barrier_complete(bar, b.x, nloc, nx); b.st[0] = nloc; b.st[1] = nx; }
        const unsigned old = xb_add(&bar[XB_XSUB(b.x)], 1u);
        const unsigned gen = old / nloc;
        if (old + 1u == (gen + 1u) * nloc) {
            __builtin_amdgcn_fence(__ATOMIC_RELEASE, "agent");
            asm volatile("s_waitcnt vmcnt(0)" ::: "memory");
            const unsigned og = xb_add(&bar[XB_TOP], 1u);
            const unsigned tg = og / nx;
            if (og + 1u == (tg + 1u) * nx) xb_add(&bar[XB_TOPGEN], 1u);
            else XB_SPIN(xb_ld(&bar[XB_TOPGEN]) == tg, bar);
            __builtin_amdgcn_fence(__ATOMIC_ACQUIRE, "agent");
            xb_add(&bar[XB_XGEN(b.x)], 1u);
            asm volatile("s_waitcnt vmcnt(0)" ::: "memory");
        } else {
            XB_SPIN(xb_ld(&bar[XB_XGEN(b.x)]) == gen, bar);
            __builtin_amdgcn_fence(__ATOMIC_ACQUIRE, "agent");
            asm volatile("s_waitcnt vmcnt(0)" ::: "memory");
        }
    }
    __syncthreads();
}

__device__ __forceinline__ void gbar(unsigned* bar0, volatile LAS unsigned* st) {
    XcdBarrier b; b.bar = bar0; asm volatile("" : "+s"(b.bar)); b.x = (unsigned)__builtin_amdgcn_readfirstlane((int)xb_xcc_id()); asm volatile("" : "+s"(b.x)); b.st = st; xcd_barrier(b);
}
__device__ __forceinline__ void conv_job(ldsp lds, int wv, const float* src, int ld, int K, int c0, int ncols, bf16_t* dst) {
  LAS float* tile = (LAS float*)lds;
  const int tid = otid(wv), ntk = K >> 6, ntn = ncols >> 6, nt = ntk * ntn;
  for (int t = obid(); t < nt; t += gridDim.x) {
    const int tk = t / ntn, tn = t - tk * ntn, k0 = tk << 6, n0 = tn << 6;
    __syncthreads();
#pragma unroll
    for (int i = 0; i < 8; ++i) { const int r = i * 8 + (tid >> 6), cc = tid & 63; tile[r * 65 + cc] = src[(size_t)(k0 + r) * ld + c0 + n0 + cc]; }
    __syncthreads();
    const int kp = tid & 31, nn = tid >> 5;
#pragma unroll
    for (int i = 0; i < 4; ++i) { const int n = nn + 16 * i; *(unsigned*)(dst + (size_t)(n0 + n) * K + k0 + 2 * kp) = pk2(tile[(2 * kp) * 65 + n], tile[(2 * kp + 1) * 65 + n]); }
  }
  __syncthreads();
}
__device__ __forceinline__ void phase_conv(ldsp lds, const Params& p, int l) {
  bf16_t* WB = (bf16_t*)(p.ws + OFF_WB);
  const float* win = p.w_in + (size_t)l * 1024 * 12288;
  conv_job(lds, p.wv, win, 12288, 1024, 0, 1024, WB + W1A);
  conv_job(lds, p.wv, win, 12288, 1024, 1024, 1024, WB + W1A + 1024ull * 1024);
  conv_job(lds, p.wv, win, 12288, 1024, 4096, 2048, WB + W1A + 2048ull * 1024);
  conv_job(lds, p.wv, win, 12288, 1024, 2048, 1024, WB + W1S);
  conv_job(lds, p.wv, win, 12288, 1024, 6144, 2048, WB + W1S + 1024ull * 1024);
  conv_job(lds, p.wv, win, 12288, 1024, 3072, 1024, WB + W1B);
  conv_job(lds, p.wv, win, 12288, 1024, 8192, 4096, WB + W1B + 1024ull * 1024);
  conv_job(lds, p.wv, p.w_pa + (size_t)l * 1024 * 1024, 1024, 1024, 0, 1024, WB + WPA);
  conv_job(lds, p.wv, p.w_pb + (size_t)l * 2048 * 1024, 1024, 2048, 0, 1024, WB + WPB);
  conv_job(lds, p.wv, p.w_o + (size_t)l * 1024 * 1024, 1024, 1024, 0, 1024, WB + WO);
  conv_job(lds, p.wv, p.w_up + (size_t)l * 1024 * 4096, 4096, 1024, 0, 4096, WB + WUP);
  conv_job(lds, p.wv, p.w_down + (size_t)l * 4096 * 1024, 1024, 4096, 0, 1024, WB + WDN);
}
__device__ __forceinline__ void phase_mod(ldsp lds, const Params& p) {
  float* small = (float*)(p.ws + OFF_SMALL);
  const int tid = otid(p.wv);
  const int bid = obid();
  if (bid < 192) {
    LAS float* cond = (LAS float*)lds;
    LAS float* part = (LAS float*)(lds + 32768);
    for (int i = tid; i < 8192; i += 512) cond[i] = siluf_(p.c[i]);
    __syncthreads();
    const int o0 = bid * 64, l = o0 / 6144, n0 = o0 - l * 6144, nl = tid & 63, kq = tid >> 6;
    const float* w = p.w_ada + (size_t)l * 1024 * 6144 + n0 + nl + (size_t)(kq * 128) * 6144;
    float a[8];
#pragma unroll
    for (int b = 0; b < 8; ++b) a[b] = 0.f;
#pragma unroll 8
    for (int k = 0; k < 128; ++k) {
      const float wv = w[(size_t)k * 6144];
#pragma unroll
      for (int b = 0; b < 8; ++b) a[b] += cond[b * 1024 + kq * 128 + k] * wv;
    }
#pragma unroll
    for (int b = 0; b < 8; ++b) part[(kq * 8 + b) * 64 + nl] = a[b];
    __syncthreads();
    {
      const int b = tid >> 6; float s = 0.f;
#pragma unroll
      for (int q = 0; q < 8; ++q) s += part[(q * 8 + b) * 64 + nl];
      small[SM_MOD + (size_t)l * 8 * 6144 + b * 6144 + n0 + nl] = s + p.b_ada[l * 6144 + n0 + nl];
    }
    __syncthreads();
  } else if (bid == 192) {
    for (int i = tid; i < 1024; i += 512) {
      const float a = p.lb_logits[i], b = p.lb_logits[1024 + i], mx = fmaxf(a, b);
      const float ea = __expf(a - mx), eb = __expf(b - mx);
      small[SM_LB + i] = 0.f; small[SM_LB + 1024 + i] = eb / (ea + eb);
    }
  }
}
__device__ __forceinline__ void phase_u0(const Params& p) {
  const float* mod = (const float*)(p.ws + OFF_SMALL) + SM_MOD;
  bf16_t* U = (bf16_t*)(p.ws + OFF_U);
  const size_t n4 = (size_t)T_ALL * 1024 / 4;
  for (size_t i = (size_t)obid() * 512 + otid(p.wv); i < n4; i += (size_t)gridDim.x * 512) {
    const size_t e = i * 4; const int t = (int)(e >> 10), cc = (int)(e & 1023), b = t >> 12;
    const f32x4 xv = *(const f32x4*)(p.x + e), sh = *(const f32x4*)(mod + b * 6144 + cc), sc = *(const f32x4*)(mod + b * 6144 + 1024 + cc);
    u32x2 o; o[0] = pk2(xv[0] * (1.f + sc[0]) + sh[0], xv[1] * (1.f + sc[1]) + sh[1]); o[1] = pk2(xv[2] * (1.f + sc[2]) + sh[2], xv[3] * (1.f + sc[3]) + sh[3]);
    *(u32x2*)(U + e) = o;
  }
}
__device__ __forceinline__ void phase_ln(const Params& p, const float* gam, const float* bet, int lm, int s_shift, bool fin) {
  float* XB = (float*)(p.ws + OFF_XB);
  const float* mod = (const float*)(p.ws + OFF_SMALL) + SM_MOD + (size_t)lm * 8 * 6144;
  bf16_t* U = (bf16_t*)(p.ws + OFF_U);
  const int tid_ = otid(p.wv); const int lane = tid_ & 63, gw = obid() * 8 + (tid_ >> 6), nw = gridDim.x * 8;
  for (int row = gw; row < T_ALL; row += nw) {
    const float* src = XB + (size_t)row * 1024;
    f32x4 v[4]; float s = 0.f;
#pragma unroll
    for (int k = 0; k < 4; ++k) { v[k] = *(const f32x4*)(src + 256 * k + 4 * lane); s += v[k][0] + v[k][1] + v[k][2] + v[k][3]; }
    const float mu = wave_sum(s, lane) * (1.0f / 1024.0f);
    float q = 0.f;
#pragma unroll
    for (int k = 0; k < 4; ++k)
#pragma unroll
      for (int i = 0; i < 4; ++i) { const float d = v[k][i] - mu; q += d * d; }
    const float rstd = rsqrtf(wave_sum(q, lane) * (1.0f / 1024.0f) + 1e-5f);
    const int b = row >> 12;
#pragma unroll
    for (int k = 0; k < 4; ++k) {
      const int cc = 256 * k + 4 * lane;
      const f32x4 gg = *(const f32x4*)(gam + cc), bb = *(const f32x4*)(bet + cc);
      f32x4 y;
#pragma unroll
      for (int i = 0; i < 4; ++i) y[i] = (v[k][i] - mu) * rstd * gg[i] + bb[i];
      if (fin) { *(f32x4*)(p.out + (size_t)row * 1024 + cc) = y; }
      else {
        *(f32x4*)(XB + (size_t)row * 1024 + cc) = y;
        const f32x4 sh = *(const f32x4*)(mod + b * 6144 + s_shift * 1024 + cc), sc = *(const f32x4*)(mod + b * 6144 + (s_shift + 1) * 1024 + cc);
        u32x2 o; o[0] = pk2(y[0] * (1.f + sc[0]) + sh[0], y[1] * (1.f + sc[1]) + sh[1]); o[1] = pk2(y[2] * (1.f + sc[2]) + sh[2], y[3] * (1.f + sc[3]) + sh[3]);
        *(u32x2*)(U + (size_t)row * 1024 + cc) = o;
      }
    }
  }
}
typedef short s16x4 __attribute__((ext_vector_type(4)));
template <class T> __device__ __forceinline__ T* vaddr(T* q) { asm volatile("" : "+v"(q)); return q; }
__device__ __forceinline__ void ret_item(ldsp lds, const Params& p, int item, bool do_stats) {
  constexpr int KS = 0, VTS = 33792, STS = 43008, PS = 76800;
  const int es = item & 7, h = (item >> 3) & 3, bl = item >> 5;
  const int tid = otid(p.wv), w = tid >> 6, lane = tid & 63, fr = lane & 15, fq = lane >> 4;
  unsigned char* R0 = oaddr(p.ws) + OFF_R0; unsigned char* DO = (unsigned char*)oaddr(p.out);
  const bf16_t* Qr = (const bf16_t*)(R0 + R_QR); const bf16_t* Kr = (const bf16_t*)(R0 + R_KR);
  const bf16_t* VrT = (const bf16_t*)(DO + D_VRT); bf16_t* OrB = (bf16_t*)(R0 + R_ORB);
  float* stR = (float*)(p.ws + OFF_SMALL) + SM_STR;
  const float gam = 1.0f - __builtin_amdgcn_exp2f(-5.0f - (float)h), lg2 = __log2f(gam), g64 = __builtin_amdgcn_exp2f(lg2 * 64.0f);
  const int it = w >> 1, eh = w & 1;
  f32x4 st[2][4];
#pragma unroll
  for (int a = 0; a < 2; ++a)
#pragma unroll
    for (int b = 0; b < 4; ++b) st[a][b] = (f32x4){0.f, 0.f, 0.f, 0.f};
  const float rowscale = __builtin_amdgcn_exp2f(lg2 * (float)(16 * it + fr - 63));
  u32x4 kreg[4], vtreg; bf16x8 qn[8];
#define RET_LOADS(TOK) do { \
    const bf16_t* kbase = vaddr(Kr + (size_t)((TOK) + (tid >> 5)) * 1024 + h * 256 + (tid & 31) * 8); \
    const bf16_t* vtbase = vaddr(VrT + (size_t)(h * 512 + es * 64 + (tid >> 3)) * TG + (TOK) + (tid & 7) * 8); \
    const bf16_t* qbase = vaddr(Qr + (size_t)((TOK) + 16 * it + fr) * 1024 + h * 256 + fq * 8); \
    _Pragma("unroll") for (int i = 0; i < 4; ++i) kreg[i] = *(const u32x4*)(kbase + (size_t)i * 16 * 1024); \
    vtreg = *(const u32x4*)vtbase; \
    _Pragma("unroll") for (int ks = 0; ks < 8; ++ks) qn[ks] = *(const bf16x8*)(qbase + ks * 32); } while (0)
  RET_LOADS(bl * SEQ);
  for (int n = 0; n < 64; ++n) {
    const int tok0 = bl * SEQ + n * 64;
    bf16x8 qf[8];
    bf16_t* obase = vaddr(OrB + (size_t)(tok0 + 16 * it + fr) * 2048 + h * 512 + es * 64 + 32 * eh + 4 * fq);
    float* sbase = vaddr(stR + ((size_t)(tok0 + 16 * it + fr) * 4 + h) * 2);
#pragma unroll
    for (int ks = 0; ks < 8; ++ks) qf[ks] = qn[ks];
    __builtin_amdgcn_sched_barrier(0);
#pragma unroll
    for (int dt = 0; dt < 2; ++dt)
#pragma unroll
      for (int et = 0; et < 4; ++et) {
        u32x2 o; o[0] = pk2(st[dt][et][0], st[dt][et][1]); o[1] = pk2(st[dt][et][2], st[dt][et][3]);
        *(LAS u32x2*)(lds + STS + (16 * et + fr) * 528 + (32 * w + 16 * dt + 4 * fq) * 2) = o;
      }
#pragma unroll
    for (int i = 0; i < 4; ++i) { const int c = tid + 512 * i, r = c >> 5, ch = c & 31; *(LAS u32x4*)(lds + KS + r * 528 + ch * 16) = kreg[i]; }
    { const int r = tid >> 3, ch = tid & 7; *(LAS u32x4*)(lds + VTS + r * 144 + ch * 16) = vtreg; }
    __syncthreads();
    { const int tokn = bl * SEQ + (n < 63 ? n + 1 : 63) * 64; RET_LOADS(tokn); }
    __builtin_amdgcn_sched_barrier(0);
#pragma unroll
    for (int jj = 0; jj < 2; ++jj) {
      const int jt = 2 * eh + jj;
      f32x4 sc = (f32x4){0.f, 0.f, 0.f, 0.f};
#pragma unroll
      for (int ks = 0; ks < 8; ++ks) sc = mfma16(ldfrag(lds, KS + (16 * jt + fr) * 528 + (32 * ks + 8 * fq) * 2), qf[ks], sc);
      const int i_ = 16 * it + fr, j0 = 16 * jt + 4 * fq;
      u32x2 o; o[0] = pk2(j0 + 0 <= i_ ? sc[0] : 0.f, j0 + 1 <= i_ ? sc[1] : 0.f); o[1] = pk2(j0 + 2 <= i_ ? sc[2] : 0.f, j0 + 3 <= i_ ? sc[3] : 0.f);
      *(LAS u32x2*)(lds + PS + i_ * 144 + j0 * 2) = o;
    }
    __syncthreads();
    __builtin_amdgcn_sched_barrier(0);
    float s1 = 0.f, s2 = 0.f;
#pragma unroll
    for (int ee = 0; ee < 2; ++ee) {
      const int et = 2 * eh + ee;
      f32x4 o = (f32x4){0.f, 0.f, 0.f, 0.f};
#pragma unroll
      for (int k2 = 0; k2 < 2; ++k2) o = mfma16(ldfrag(lds, VTS + (16 * et + fr) * 144 + (32 * k2 + 8 * fq) * 2), ldfrag(lds, PS + (16 * it + fr) * 144 + (32 * k2 + 8 * fq) * 2), o);
#pragma unroll
      for (int ks = 0; ks < 8; ++ks) o = mfma16(ldfrag(lds, STS + (16 * et + fr) * 528 + (32 * ks + 8 * fq) * 2), qf[ks], o);
#pragma unroll
      for (int r = 0; r < 4; ++r) { o[r] *= rowscale; s1 += o[r]; s2 += o[r] * o[r]; }
      u32x2 ov; ov[0] = pk2(o[0], o[1]); ov[1] = pk2(o[2], o[3]);
      *(u32x2*)(obase + 16 * ee) = ov;
    }
    s1 += shx(s1, 16, lane); s1 += shx(s1, 32, lane); s2 += shx(s2, 16, lane); s2 += shx(s2, 32, lane);
    if (fq == 0 && do_stats) { unsafeAtomicAdd(sbase, s1); unsafeAtomicAdd(sbase + 1, s2); }
    __builtin_amdgcn_sched_barrier(0);
#pragma unroll
    for (int k2 = 0; k2 < 2; ++k2) {
      bf16x8 vf[4];
#pragma unroll
      for (int et = 0; et < 4; ++et) vf[et] = ldfrag(lds, VTS + (16 * et + fr) * 144 + (32 * k2 + 8 * fq) * 2);
#pragma unroll
      for (int dt = 0; dt < 2; ++dt) {
        bf16x8 kf;
        {
          const int a0 = KS + (32 * k2 + 8 * fq + (fr >> 2)) * 528 + (32 * w + 16 * dt + 4 * (fr & 3)) * 2;
          const s16x4 t0 = __builtin_amdgcn_ds_read_tr16_b64_v4i16((LAS s16x4*)(lds + a0));
          const s16x4 t1 = __builtin_amdgcn_ds_read_tr16_b64_v4i16((LAS s16x4*)(lds + a0 + 4 * 528));
          kf = (bf16x8){t0[0], t0[1], t0[2], t0[3], t1[0], t1[1], t1[2], t1[3]};
        }
#pragma unroll
        for (int et = 0; et < 4; ++et) st[dt][et] = mfma16(kf, vf[et], st[dt][et]);
      }
    }
#pragma unroll
    for (int dt = 0; dt < 2; ++dt)
#pragma unroll
      for (int et = 0; et < 4; ++et)
#pragma unroll
        for (int r = 0; r < 4; ++r) st[dt][et][r] *= g64;
    __syncthreads();
  }
}
__device__ __forceinline__ void hgrn_item(ldsp lds, const Params& p, int item, bool do_stats) {
  constexpr int QT = 0, KT = 17408, QB = 34816, KBT = 52224, VTS = 70656, STS = 75264, PS = 83968, TOT = 93184, DEC = 97280;
  const int es = item & 3, h = (item >> 2) & 7, bl = item >> 5;
  const int tid = otid(p.wv), w = tid >> 6, lane = tid & 63, fr = lane & 15, fq = lane >> 4;
  unsigned char* R0 = oaddr(p.ws) + OFF_R0; unsigned char* DO = (unsigned char*)oaddr(p.out);
  const bf16_t* Qh = (const bf16_t*)(R0 + R_QH); const float* LF = (const float*)(DO + D_LF); const bf16_t* ViT = (const bf16_t*)(R0 + R_VIT);
  bf16_t* OrA = (bf16_t*)(R0 + R_ORA);
  float* stH = (float*)(p.ws + OFF_SMALL) + SM_STH;
  LAS float* tot = (LAS float*)(lds + TOT); LAS float* dec = (LAS float*)(lds + DEC);
  const int it = w >> 1, eh = w & 1, d0 = 2 * lane;
  f32x4 st[2];
  st[0] = (f32x4){0.f, 0.f, 0.f, 0.f}; st[1] = (f32x4){0.f, 0.f, 0.f, 0.f};
  float lxn[8], lyn[8]; unsigned q2n[8]; u32x4 vtreg;
#define HG_LOADS(TOK) do { \
    const float* lfbase = vaddr(LF + (size_t)((TOK) + 8 * w) * 1024 + h * 128 + d0); \
    const bf16_t* qhbase = vaddr(Qh + (size_t)((TOK) + 8 * w) * 1024 + h * 128 + d0); \
    const bf16_t* vtbase = vaddr(ViT + (size_t)(h * 128 + es * 32 + ((tid & 255) >> 3)) * TG + (TOK) + (tid & 7) * 8); \
    _Pragma("unroll") for (int jj = 0; jj < 8; ++jj) { \
      const float2 t = *(const float2*)(lfbase + (size_t)jj * 1024); lxn[jj] = t.x; lyn[jj] = t.y; q2n[jj] = *(const unsigned*)(qhbase + (size_t)jj * 1024); } \
    vtreg = *(const u32x4*)vtbase; } while (0)
  HG_LOADS(bl * SEQ);
  for (int n = 0; n < 64; ++n) {
    const int tok0 = bl * SEQ + n * 64;
    float lx[8], ly[8]; unsigned q2[8];
    bf16_t* obase = vaddr(OrA + (size_t)(tok0 + 16 * it + fr) * 1024 + h * 128 + es * 32 + 16 * eh + 4 * fq);
    float* sbase = vaddr(stH + (size_t)(tok0 + 16 * it + fr) * 8 + h);
#pragma unroll
    for (int jj = 0; jj < 8; ++jj) { lx[jj] = lxn[jj]; ly[jj] = lyn[jj]; q2[jj] = q2n[jj]; }
    __builtin_amdgcn_sched_barrier(0);
    float px[8], py[8]; float cx = 0.f, cy = 0.f;
#pragma unroll
    for (int jj = 0; jj < 8; ++jj) { cx += lx[jj]; cy += ly[jj]; px[jj] = cx; py[jj] = cy; }
    tot[w * 128 + d0] = cx; tot[w * 128 + d0 + 1] = cy;
#pragma unroll
    for (int et = 0; et < 2; ++et) {
      u32x2 o; o[0] = pk2(st[et][0], st[et][1]); o[1] = pk2(st[et][2], st[et][3]);
      *(LAS u32x2*)(lds + STS + (16 * et + fr) * 272 + (16 * w + 4 * fq) * 2) = o;
    }
    if (tid < 256) { const int r = tid >> 3, ch = tid & 7; *(LAS u32x4*)(lds + VTS + r * 144 + ch * 16) = vtreg; }
    __syncthreads();
    { const int tokn = bl * SEQ + (n < 63 ? n + 1 : 63) * 64; HG_LOADS(tokn); }
    float offx = 0.f, offy = 0.f, rx = 0.f, ry = 0.f, bx = 0.f, by = 0.f;
#pragma unroll
    for (int q = 0; q < 8; ++q) {
      const float tx = tot[q * 128 + d0], ty = tot[q * 128 + d0 + 1];
      if (q < w) { offx += tx; offy += ty; }
      if (q < 4) { rx += tx; ry += ty; }
      bx += tx; by += ty;
    }
    if (w == 0) { dec[d0] = __expf(bx); dec[d0 + 1] = __expf(by); }
    unsigned kbx[4], kby[4];
#pragma unroll
    for (int jj = 0; jj < 8; ++jj) {
      const float Bx = offx + px[jj], By = offy + py[jj];
      const float qx = bflo(q2[jj]), qy = bfhi(q2[jj]);
      const float kx = 1.0f - __expf(lx[jj]), ky = 1.0f - __expf(ly[jj]);
      const float e1x = __expf(fminf(fmaxf(Bx - rx, -80.f), 80.f)), e1y = __expf(fminf(fmaxf(By - ry, -80.f), 80.f));
      const float e2x = __expf(fminf(fmaxf(rx - Bx, -80.f), 80.f)), e2y = __expf(fminf(fmaxf(ry - By, -80.f), 80.f));
      const int j = 8 * w + jj;
      *(LAS unsigned*)(lds + QT + j * 272 + d0 * 2) = pk2(qx * e1x, qy * e1y);
      *(LAS unsigned*)(lds + KT + j * 272 + d0 * 2) = pk2(kx * e2x, ky * e2y);
      *(LAS unsigned*)(lds + QB + j * 272 + d0 * 2) = pk2(qx * __expf(Bx), qy * __expf(By));
      const float kbvx = kx * __expf(bx - Bx), kbvy = ky * __expf(by - By);
      if (jj & 1) { kbx[jj >> 1] = pk2(__uint_as_float(kbx[jj >> 1]), kbvx); kby[jj >> 1] = pk2(__uint_as_float(kby[jj >> 1]), kbvy); }
      else { kbx[jj >> 1] = __float_as_uint(kbvx); kby[jj >> 1] = __float_as_uint(kbvy); }
    }
    *(LAS u32x4*)(lds + KBT + d0 * 144 + (8 * w) * 2) = (u32x4){kbx[0], kbx[1], kbx[2], kbx[3]};
    *(LAS u32x4*)(lds + KBT + (d0 + 1) * 144 + (8 * w) * 2) = (u32x4){kby[0], kby[1], kby[2], kby[3]};
    __syncthreads();
    __builtin_amdgcn_sched_barrier(0);
#pragma unroll
    for (int jj = 0; jj < 2; ++jj) {
      const int jt = 2 * eh + jj;
      f32x4 sc = (f32x4){0.f, 0.f, 0.f, 0.f};
#pragma unroll
      for (int ks = 0; ks < 4; ++ks) sc = mfma16(ldfrag(lds, KT + (16 * jt + fr) * 272 + (32 * ks + 8 * fq) * 2), ldfrag(lds, QT + (16 * it + fr) * 272 + (32 * ks + 8 * fq) * 2), sc);
      const int i_ = 16 * it + fr, j0 = 16 * jt + 4 * fq;
      u32x2 o; o[0] = pk2(j0 + 0 <= i_ ? sc[0] : 0.f, j0 + 1 <= i_ ? sc[1] : 0.f); o[1] = pk2(j0 + 2 <= i_ ? sc[2] : 0.f, j0 + 3 <= i_ ? sc[3] : 0.f);
      *(LAS u32x2*)(lds + PS + i_ * 144 + j0 * 2) = o;
    }
    __syncthreads();
    __builtin_amdgcn_sched_barrier(0);
    {
      f32x4 o = (f32x4){0.f, 0.f, 0.f, 0.f};
#pragma unroll
      for (int k2 = 0; k2 < 2; ++k2) o = mfma16(ldfrag(lds, VTS + (16 * eh + fr) * 144 + (32 * k2 + 8 * fq) * 2), ldfrag(lds, PS + (16 * it + fr) * 144 + (32 * k2 + 8 * fq) * 2), o);
#pragma unroll
      for (int ks = 0; ks < 4; ++ks) o = mfma16(ldfrag(lds, STS + (16 * eh + fr) * 272 + (32 * ks + 8 * fq) * 2), ldfrag(lds, QB + (16 * it + fr) * 272 + (32 * ks + 8 * fq) * 2), o);
      float s2 = o[0] * o[0] + o[1] * o[1] + o[2] * o[2] + o[3] * o[3];
      u32x2 ov; ov[0] = pk2(o[0], o[1]); ov[1] = pk2(o[2], o[3]);
      *(u32x2*)obase = ov;
      s2 += shx(s2, 16, lane); s2 += shx(s2, 32, lane);
      if (fq == 0 && do_stats) unsafeAtomicAdd(sbase, s2);
    }
    __builtin_amdgcn_sched_barrier(0);
    {
      const f32x4 dv = *(const LAS f32x4*)(dec + 16 * w + 4 * fq);
#pragma unroll
      for (int et = 0; et < 2; ++et)
#pragma unroll
        for (int r = 0; r < 4; ++r) st[et][r] *= dv[r];
#pragma unroll
      for (int k2 = 0; k2 < 2; ++k2) {
        const bf16x8 kf = ldfrag(lds, KBT + (16 * w + fr) * 144 + (32 * k2 + 8 * fq) * 2);
#pragma unroll
        for (int et = 0; et < 2; ++et) st[et] = mfma16(kf, ldfrag(lds, VTS + (16 * et + fr) * 144 + (32 * k2 + 8 * fq) * 2), st[et]);
      }
    }
    __syncthreads();
  }
}
#ifndef STAGGER_TICKS
#define STAGGER_TICKS 0
#endif
#ifndef REP_RET
#define REP_RET 1
#endif
#ifndef REP_HG
#define REP_HG 1
#endif
#ifndef REP_G1
#define REP_G1 1
#endif
#ifndef REP_G2
#define REP_G2 1
#endif
#ifndef REP_G4
#define REP_G4 1
#endif
#ifndef REP_SYNC
#define REP_SYNC 1
#endif
#ifndef REP_PRO
#define REP_PRO 1
#endif
#ifndef REP_S1
#define REP_S1 1
#endif
enum { ST_G1 = 0, ST_S1, ST_G1B, ST_G2, ST_G3, ST_L1, ST_G4, ST_G5, ST_L2 };
__global__ void __launch_bounds__(512, 2) mega(Params p0) {
  extern __shared__ __attribute__((aligned(16))) unsigned char shm[];
  ldsp lds = (ldsp)shm;
  cg::grid_group grid = cg::this_grid();
  Params p = p0; p.ws = oaddr(p0.ws); p.out = oaddr(p0.out); p.wv = __builtin_amdgcn_readfirstlane((int)(threadIdx.x >> 6));
  volatile LAS unsigned* xst = (volatile LAS unsigned*)(lds + 131072);
  if (threadIdx.x < 4) xst[threadIdx.x] = 0u;
  __syncthreads();
  (void)xcd_barrier_post((unsigned*)(p0.ws + OFF_SMALL + SM_BAR_BYTES), xst);
  for (int r = 0; r < REP_PRO; ++r) {
    p.ws = oaddr(p0.ws);
    phase_mod(lds, p);
    phase_conv(lds, p, 0);
    grid.sync();
  }
  phase_u0(p);
  gbar((unsigned*)(p0.ws + OFF_SMALL + SM_BAR_BYTES), xst);
  for (int pc = 0; pc < 28; ++pc) {
    p.ws = oaddr(p0.ws); p.out = oaddr(p0.out);
    const bf16_t* WB = (const bf16_t*)(p.ws + OFF_WB);
    const bf16_t* U = (const bf16_t*)(p.ws + OFF_U);
    unsigned char* R0 = p.ws + OFF_R0;
    const int l = pc / 14, k = pc - l * 14;
    int g = 0, stg;
    if (k < 10) { g = k / 5; stg = k - g * 5; } else stg = ST_L1 + (k - 10);
    int nj = 0, jmode0 = 0, jmode1 = 0; const bf16_t* jA0 = nullptr; const bf16_t* jA1 = nullptr; const bf16_t* jB0 = nullptr; const bf16_t* jB1 = nullptr;
    int jM0 = 0, jM1 = 0, jN0 = 0, jN1 = 0, jK0 = 0, jK1 = 0;
    if (stg == ST_G1) {
      float* stz = (float*)(p.ws + OFF_SMALL) + SM_STR;
      for (int i = obid() * 512 + otid(p.wv); i < TG * 16; i += gridDim.x * 512) stz[i] = 0.f;
      nj = 2;
      jmode0 = MD_G1A; jA0 = U + (size_t)g * TG * 1024; jB0 = WB + W1A; jM0 = TG; jN0 = 4096; jK0 = 1024;
      jmode1 = MD_G1S; jA1 = WB + W1S; jB1 = U + (size_t)g * TG * 1024; jM1 = 3072; jN1 = TG; jK1 = 1024;
    } else if (stg == ST_S1) {
      for (int rep = 0; rep < REP_S1; ++rep) {
        if (rep) { gbar((unsigned*)(p0.ws + OFF_SMALL + SM_BAR_BYTES), xst); float* stz = (float*)(p.ws + OFF_SMALL) + SM_STR; for (int i = obid() * 512 + otid(p.wv); i < TG * 16; i += gridDim.x * 512) stz[i] = 0.f; gbar((unsigned*)(p0.ws + OFF_SMALL + SM_BAR_BYTES), xst); }
        const int bid = obid();
        if (bid < 128) { for (int r2 = 0; r2 < REP_RET; ++r2) ret_item(lds, p, bid, r2 == REP_RET - 1); } else { for (int r2 = 0; r2 < REP_HG; ++r2) hgrn_item(lds, p, bid - 128, r2 == REP_HG - 1); }
      }
    } else if (stg == ST_G1B) {
      nj = 1; jmode0 = MD_G1B; jA0 = U + (size_t)g * TG * 1024; jB0 = WB + W1B; jM0 = TG; jN0 = 5120; jK0 = 1024;
    } else if (stg == ST_G2) {
      nj = 2;
      jmode0 = MD_G2A; jA0 = (const bf16_t*)(R0 + R_ORA); jB0 = WB + WPA; jM0 = TG; jN0 = 1024; jK0 = 1024;
      jmode1 = MD_G2B; jA1 = (const bf16_t*)(R0 + R_ORB); jB1 = WB + WPB; jM1 = TG; jN1 = 1024; jK1 = 2048;
    } else if (stg == ST_G3) {
      nj = 1; jmode0 = MD_G3; jA0 = (const bf16_t*)(R0 + R_MG); jB0 = WB + WO; jM0 = TG; jN0 = 1024; jK0 = 1024;
    } else if (stg == ST_L1) {
      phase_ln(p, p.ln1_g + l * 1024, p.ln1_b + l * 1024, l, 3, false);
    } else if (stg == ST_G4) {
      nj = 1; jmode0 = MD_G4; jA0 = U; jB0 = WB + WUP; jM0 = T_ALL; jN0 = 4096; jK0 = 1024;
    } else if (stg == ST_G5) {
      nj = 1; jmode0 = MD_G5; jA0 = (const bf16_t*)R0; jB0 = WB + WDN; jM0 = T_ALL; jN0 = 1024; jK0 = 4096;
    } else {
      phase_ln(p, p.ln2_g + l * 1024, p.ln2_b + l * 1024, l == 0 ? 1 : 0, 0, l == 1);
      if (l == 0) phase_conv(lds, p, 1);
    }
    for (int j = 0; j < nj * (stg == ST_G4 ? REP_G4 : 1) * (stg == ST_G1 ? REP_G1 : 1) * (stg == ST_G2 ? REP_G2 : 1); ++j) {
      pg8::Gemm gm; const bool j1 = (nj == 2 && (j & 1) == 1); gm.A = j1 ? jA1 : jA0; gm.Bt = j1 ? jB1 : jB0; gm.M = j1 ? jM1 : jM0; gm.N = j1 ? jN1 : jN0; gm.K = j1 ? jK1 : jK0;
      pg8::StaticOrder S; S.init(gm.M, gm.N, (int)gridDim.x, obid());
      EpiP E; E.mode = j1 ? jmode1 : jmode0; E.l = l; E.g = g; E.pp = &p;
#if STAGGER_TICKS > 0
      if (j == 0 && (gm.M >> 8) * (gm.N >> 8) >= 3 * (int)gridDim.x && ((obid() >> 3) & 1)) {
        const unsigned long long t0 = __builtin_amdgcn_s_memrealtime();
        while (__builtin_amdgcn_s_memrealtime() - t0 < (unsigned long long)STAGGER_TICKS) __builtin_amdgcn_s_sleep(32);
      }
#endif
      pg8::gemm_phase<EpiP, pg8::StaticOrder, false>((PG8_LAS unsigned char*)shm, gm, S, E, nullptr);
    }
    for (int r = 0; r < REP_SYNC; ++r) gbar((unsigned*)(p0.ws + OFF_SMALL + SM_BAR_BYTES), xst);
  }
}

extern "C" void kernel_launch(void* const* d_in, const int* in_sizes, int n_in, void* d_out, int out_size,
                              void* d_ws, size_t ws_size, hipStream_t stream) {
  constexpr size_t kDynLds = 131072 + 16;
  static int configured = 0;
  if (!configured) {
    (void)hipFuncSetAttribute((const void*)mega, hipFuncAttributeMaxDynamicSharedMemorySize, (int)kDynLds);
    configured = 1;
  }
  Params p{};
  p.x = (const float*)d_in[0]; p.c = (const float*)d_in[1]; p.pos = (const int*)d_in[2]; p.lb_logits = (const float*)d_in[3];
  p.w_ada = (const float*)d_in[4]; p.b_ada = (const float*)d_in[5]; p.w_in = (const float*)d_in[6]; p.w_pa = (const float*)d_in[7];
  p.w_pb = (const float*)d_in[8]; p.w_o = (const float*)d_in[9]; p.ln1_g = (const float*)d_in[10]; p.ln1_b = (const float*)d_in[11];
  p.w_up = (const float*)d_in[12]; p.b_up = (const float*)d_in[13]; p.w_down = (const float*)d_in[14]; p.b_down = (const float*)d_in[15];
  p.ln2_g = (const float*)d_in[16]; p.ln2_b = (const float*)d_in[17];
  p.out = (float*)d_out; p.ws = (unsigned char*)d_ws;
  if (ws_size < 512ull * 1024 * 1024) { fprintf(stderr, "workspace too small\n"); return; }
  (void)hipMemsetAsync((unsigned char*)d_ws + OFF_SMALL + SM_BAR_BYTES, 0, XCD_BAR_WORDS * 4, stream);
  void* args[] = {&p};
  hipError_t e = hipLaunchCooperativeKernel((void*)mega, dim3(256), dim3(512), args, kDynLds, stream);
  if (e != hipSuccess) fprintf(stderr, "cooperative launch failed: %s\n", hipGetErrorString(e));
}
```

```cpp
#include <hip/hip_runtime.h>
#include <hip/hip_cooperative_groups.h>
#include <cstdio>
namespace cg = cooperative_groups;
__device__ __forceinline__ int otid(int wv) { int t = (wv << 6) | (int)__builtin_amdgcn_mbcnt_hi(~0u, __builtin_amdgcn_mbcnt_lo(~0u, 0u)); asm volatile("" : "+v"(t)); return t; }
__device__ __forceinline__ int obid() { int t = blockIdx.x; asm volatile("" : "+s"(t)); return t; }
template <class T> __device__ __forceinline__ T* oaddr(T* q) { asm volatile("" : "+s"(q)); return q; }
namespace pg8 {
#define PG8_LAS __attribute__((address_space(3)))
typedef unsigned short bf16_t;
typedef short bf16x8 __attribute__((ext_vector_type(8)));
typedef float f32x4 __attribute__((ext_vector_type(4)));
typedef unsigned u32x4 __attribute__((ext_vector_type(4)));
constexpr int BM = 256, BK = 64, HALF = 128, HTB = HALF * BK * 2  , STAGE_BYTES = 8 * HTB, NXCD = 8, WGM = 8;

__host__ __device__ __forceinline__ int lds_byte(int r, int c) { const int st = (r >> 4) * 2 + (c >> 5), rr = r & 15, cc = c & 31, ob = rr * 64 + cc * 2; return st * 1024 + (ob ^ (((ob >> 9) & 1) << 5)); }
__host__ __device__ __forceinline__ void stage_rc(int b, int& R, int& C) { const int st = b / 1024, sb = b % 1024, swz = sb ^ (((sb >> 9) & 1) << 5); R = (st >> 1) * 16 + swz / 64; C = (st & 1) * 32 + (swz % 64) / 2; }
__host__ __device__ __forceinline__ int perm32(int rho) { const int n = rho >> 4, i = rho & 15; return 8 * (i >> 2) + 4 * n + (i & 3); }

struct Unit { int pm, pn; };
struct Gemm { const bf16_t* A; const bf16_t* Bt; int M, N, K; };

struct StaticOrder {
    int nM, nN, nwg, G, c;
    __host__ __device__ void init(int M, int N, int G_, int c_) { nM = M / BM; nN = N / BM; nwg = nM * nN; G = G_; c = c_; }
    __host__ __device__ bool next(int i, Unit& u) const {
        const long L = (long)i * G + c; if (L >= nwg) return false;
        int wgid = (int)L; { const int q = nwg / NXCD, r = nwg % NXCD, xcd = wgid % NXCD, off = wgid / NXCD; wgid = (xcd < r ? xcd * (q + 1) : r * (q + 1) + (xcd - r) * q) + off; }
        const int nig = WGM * nN, gid = wgid / nig, fm = gid * WGM, gsz = (nM - fm) < WGM ? (nM - fm) : WGM;
        u.pm = fm + ((wgid % nig) % gsz); u.pn = (wgid % nig) / gsz; return true;
    }
    __device__ __forceinline__ void a_ready(const Unit&) const {}
    __device__ __forceinline__ void done(const Unit&) const {}
};
__device__ __forceinline__ unsigned cvt_pk_bf16(float lo, float hi) { unsigned r; asm volatile("v_cvt_pk_bf16_f32 %0, %1, %2" : "=v"(r) : "v"(lo), "v"(hi)); return r; }

template <class Epi, class Sched, bool STAMP = false>
__device__ __forceinline__ void gemm_phase(PG8_LAS unsigned char* lds, const Gemm g, const Sched& S, const Epi& E, unsigned long long* stamps) {
    const int tid = otid(E.pp->wv), wid = __builtin_amdgcn_readfirstlane(tid >> 6), lane = tid & 63, wr = wid >> 2, wc = wid & 3, fr = lane & 15, fq = lane >> 4;
    const int K = g.K, nt = K / BK;
    int ts_lo = 0, ts_hi = 0, nts = 0; const unsigned long long rt_entry = STAMP ? (unsigned long long)wall_clock64() : 0ull;
#define PG8_STAMP() do { if (STAMP && wid == 0 && nts < 64) { const unsigned long long _c = (unsigned long long)clock64(); \
        ts_lo = (lane == nts) ? (int)(unsigned)_c : ts_lo; ts_hi = (lane == nts) ? (int)(unsigned)(_c >> 32) : ts_hi; ++nts; } } while (0)
    PG8_STAMP();
    unsigned voffA[2], voffB[2];
#pragma unroll
    for (int i = 0; i < 2; ++i) { int R, C; stage_rc(tid * 16 + i * 8192, R, C); const int Rb = Epi::PERM ? ((R & ~31) + perm32(R & 31)) : R;
        voffA[i] = (unsigned)(R * K + C) * 2u; voffB[i] = (unsigned)(Rb * K + C) * 2u; }
    const size_t kstep = (size_t)(BK * 2);
    const size_t hstep = (size_t)HALF * K * 2;
    const size_t tstep = 2 * hstep;
    const unsigned ldsw = (unsigned)wid * 1024u;
    const int aoff = lds_byte(wr * 64 + fr, fq * 8), boff = lds_byte(wc * 32 + fr, fq * 8);
#define PG8_SA(b, h) (((b) * 2 + (h)) * HTB)
#define PG8_SB(b, h) ((4 + (b) * 2 + (h)) * HTB)
#define PG8_STAGE(bufoff, gbase, voff) do { _Pragma("unroll") for (int _i = 0; _i < 2; ++_i) \
        __builtin_amdgcn_global_load_lds((const unsigned*)((const char*)(gbase) + (voff)[_i]), (PG8_LAS unsigned*)(lds + (bufoff) + ldsw + _i * 8192), 16, 0, 0); } while (0)
#define PG8_LDA(dst, b, h) do { _Pragma("unroll") for (int m = 0; m < 4; ++m) _Pragma("unroll") for (int k = 0; k < 2; ++k) dst[m][k] = *(const PG8_LAS bf16x8*)(lds + PG8_SA(b, h) + aoff + m * 2048 + k * 1024); } while (0)
#define PG8_LDB(dst, b, h) do { _Pragma("unroll") for (int n = 0; n < 2; ++n) _Pragma("unroll") for (int k = 0; k < 2; ++k) dst[n][k] = *(const PG8_LAS bf16x8*)(lds + PG8_SB(b, h) + boff + n * 2048 + k * 1024); } while (0)
#define PG8_MMA(ai, bj, At, Bt) do { __builtin_amdgcn_s_setprio(1); _Pragma("unroll") for (int m = 0; m < 4; ++m) _Pragma("unroll") for (int n = 0; n < 2; ++n) _Pragma("unroll") for (int k = 0; k < 2; ++k) \
        acc[ai][bj][m][n] = __builtin_amdgcn_mfma_f32_16x16x32_bf16(Bt[n][k], At[m][k], acc[ai][bj][m][n], 0, 0, 0); __builtin_amdgcn_s_setprio(0); } while (0)
#define PG8_WAIT_V(n) asm volatile("s_waitcnt vmcnt(" #n ")" ::: "memory")
#define PG8_WAIT_L(n) asm volatile("s_waitcnt lgkmcnt(" #n ")" ::: "memory")
#define PG8_BAR __builtin_amdgcn_s_barrier()
#define PG8_SCHED __builtin_amdgcn_sched_barrier(0)
    Unit cur, nxt; int ui = 0;
    if (!S.next(0, cur)) return;
    f32x4 acc[2][2][4][2];
#pragma unroll
    for (int a = 0; a < 2; ++a)
#pragma unroll
        for (int b = 0; b < 2; ++b)
#pragma unroll
            for (int m = 0; m < 4; ++m)
#pragma unroll
                for (int n = 0; n < 2; ++n) acc[a][b][m][n] = (f32x4){0.f, 0.f, 0.f, 0.f};
    bf16x8 At[4][2], B0[2][2], B1[2][2];
    const char* cA = (const char*)g.A + (size_t)cur.pm * tstep; const char* cB = (const char*)g.Bt + (size_t)cur.pn * tstep;
    S.a_ready(cur);
    PG8_STAGE(PG8_SB(0, 0), cB, voffB); PG8_STAGE(PG8_SA(0, 0), cA, voffA); PG8_STAGE(PG8_SB(0, 1), cB + hstep, voffB); PG8_STAGE(PG8_SA(0, 1), cA + hstep, voffA);
    if (wr == 1) PG8_BAR;
    PG8_WAIT_V(4); PG8_BAR;
    PG8_STAGE(PG8_SB(1, 0), cB + kstep, voffB); PG8_STAGE(PG8_SA(1, 0), cA + kstep, voffA); PG8_STAGE(PG8_SB(1, 1), cB + hstep + kstep, voffB);
    PG8_WAIT_V(6); PG8_BAR;
    PG8_STAMP();
    for (;;) {
        const bool has_next = S.next(ui + 1, nxt);
        const char* nA = has_next ? (const char*)g.A + (size_t)nxt.pm * tstep : cA; const char* nB = has_next ? (const char*)g.Bt + (size_t)nxt.pn * tstep : cB;
        for (int t = 0; t < nt; t += 2) {
            const bool last = (t == nt - 2);
            const char* a1 = cA + (size_t)(t + 1) * kstep;
            const char* a2 = last ? nA : cA + (size_t)(t + 2) * kstep; const char* b2 = last ? nB : cB + (size_t)(t + 2) * kstep;
            const char* a3 = a2 + kstep; const char* b3 = b2 + kstep;
            if (last && has_next) S.a_ready(nxt);
            PG8_LDB(B0, 0, 0); PG8_SCHED; PG8_LDA(At, 0, 0); PG8_STAGE(PG8_SA(1, 1), a1 + hstep, voffA);
            PG8_WAIT_L(8); PG8_BAR; PG8_WAIT_L(0); PG8_MMA(0, 0, At, B0); PG8_BAR; PG8_SCHED;
            PG8_LDB(B1, 0, 1); PG8_STAGE(PG8_SB(0, 0), b2, voffB);
            PG8_BAR; PG8_WAIT_L(0); PG8_MMA(0, 1, At, B1); PG8_BAR;
            PG8_LDA(At, 0, 1); PG8_STAGE(PG8_SA(0, 0), a2, voffA);
            PG8_BAR; PG8_WAIT_L(0); PG8_MMA(1, 0, At, B0); PG8_BAR; PG8_SCHED;
            PG8_STAGE(PG8_SB(0, 1), b2 + hstep, voffB);
            PG8_WAIT_V(6); PG8_BAR; PG8_MMA(1, 1, At, B1); PG8_BAR;
            PG8_LDB(B0, 1, 0); PG8_SCHED; PG8_LDA(At, 1, 0); PG8_STAGE(PG8_SA(0, 1), a2 + hstep, voffA);
            PG8_WAIT_L(8); PG8_BAR; PG8_WAIT_L(0); PG8_MMA(0, 0, At, B0); PG8_BAR; PG8_SCHED;
            PG8_LDB(B1, 1, 1); PG8_STAGE(PG8_SB(1, 0), b3, voffB);
            PG8_BAR; PG8_WAIT_L(0); PG8_MMA(0, 1, At, B1); PG8_BAR;
            PG8_LDA(At, 1, 1); PG8_STAGE(PG8_SA(1, 0), a3, voffA);
            PG8_BAR; PG8_WAIT_L(0); PG8_MMA(1, 0, At, B0); PG8_BAR; PG8_SCHED;
            PG8_STAGE(PG8_SB(1, 1), b3 + hstep, voffB);
            PG8_WAIT_V(6); PG8_BAR; PG8_MMA(1, 1, At, B1); PG8_BAR;
        }
        PG8_STAMP();
        if constexpr (!Epi::AFTER_DRAIN) { E(acc, cur, wr, wc, fr, fq); S.done(cur); }
        PG8_STAMP();
        if (!has_next) break;
#pragma unroll
        for (int a = 0; a < 2; ++a)
#pragma unroll
            for (int b = 0; b < 2; ++b)
#pragma unroll
                for (int m = 0; m < 4; ++m)
#pragma unroll
                    for (int n = 0; n < 2; ++n) acc[a][b][m][n] = (f32x4){0.f, 0.f, 0.f, 0.f};
        cur = nxt; cA = nA; cB = nB; ++ui;
    }
    PG8_WAIT_V(0);
    if (wr == 0) PG8_BAR;
    PG8_BAR;
    if constexpr (Epi::AFTER_DRAIN) { E.fused(acc, cur, wr, wc, fr, fq, lds, wid, lane); S.done(cur); }
    PG8_STAMP();
    if (STAMP && wid == 0) { stamps[lane] = lane < nts ? (((unsigned long long)(unsigned)ts_hi << 32) | (unsigned)ts_lo) : 0ull;
        if (lane == 62) stamps[62] = rt_entry; if (lane == 63) stamps[63] = (unsigned long long)wall_clock64(); }
#undef PG8_STAMP
#undef PG8_SA
#undef PG8_SB
#undef PG8_STAGE
#undef PG8_LDA
#undef PG8_LDB
#undef PG8_MMA
#undef PG8_WAIT_V
#undef PG8_WAIT_L
#undef PG8_BAR
#undef PG8_SCHED
}
}
using pg8::bf16_t; using pg8::bf16x8; using pg8::f32x4; using pg8::u32x4; using pg8::Unit;
typedef unsigned u32x2 __attribute__((ext_vector_type(2)));
#define LAS __attribute__((address_space(3)))
typedef LAS unsigned char* ldsp;

constexpr int T_ALL = 32768, TG = 16384, DM = 1024, SEQ = 4096;
constexpr float ALPHA = 1.4142135623730951f;
constexpr size_t MB = 1024ull * 1024ull;
constexpr size_t OFF_XB = 0, OFF_WB = 128 * MB, OFF_U = 184 * MB, OFF_SMALL = 248 * MB, OFF_R0 = 256 * MB;
constexpr size_t W1A = 0, W1S = W1A + 4096ull * 1024, W1B = W1S + 3072ull * 1024, WPA = W1B + 5120ull * 1024, WPB = WPA + 1024ull * 1024,
                 WO = WPB + 1024ull * 2048, WUP = WO + 1024ull * 1024, WDN = WUP + 4096ull * 1024, W_END = WDN + 4096ull * 1024;
static_assert(W_END * 2 <= 56 * MB, "weights");
constexpr size_t SM_MOD = 0  , SM_LB = 2 * 8 * 6144  , SM_STR = SM_LB + 2048  , SM_STH = SM_STR + (size_t)TG * 8  , SM_END = SM_STH + (size_t)TG * 8;
constexpr size_t SM_BAR_BYTES = 7 * MB;
static_assert(SM_END * 4 <= 7 * MB, "small");
constexpr size_t R_QH = 0, R_VIT = 32 * MB, R_QR = 64 * MB, R_KR = 96 * MB, R_KRT = 128 * MB, R_ORA = 160 * MB, R_ORB = 192 * MB;
constexpr size_t R_SGA = R_QH, R_SGB = R_VIT, R_M1 = R_QR, R_MG = R_KRT;
constexpr size_t D_LF = 0, D_VRT = 64 * MB;

struct Params {
  const float* x; const float* c; const int* pos; const float* lb_logits; const float* w_ada; const float* b_ada; const float* w_in; const float* w_pa; const float* w_pb;
  const float* w_o; const float* ln1_g; const float* ln1_b; const float* w_up; const float* b_up; const float* w_down; const float* b_down; const float* ln2_g; const float* ln2_b;
  float* out; unsigned char* ws; int wv; int pad;
};

__device__ __forceinline__ float bf2f(unsigned short b) { return __uint_as_float(((unsigned)b) << 16); }
__device__ __forceinline__ float bflo(unsigned u) { return __uint_as_float(u << 16); }
__device__ __forceinline__ float bfhi(unsigned u) { return __uint_as_float(u & 0xffff0000u); }
typedef float f32x2_ __attribute__((ext_vector_type(2)));
typedef __bf16 bf16x2_ __attribute__((ext_vector_type(2)));
__device__ __forceinline__ unsigned pk2(float lo, float hi) { const f32x2_ v = {lo, hi}; const bf16x2_ b = __builtin_convertvector(v, bf16x2_); return __builtin_bit_cast(unsigned, b); }
__device__ __forceinline__ float sigmoidf_(float v) { return __builtin_amdgcn_rcpf(1.0f + __expf(-v)); }
__device__ __forceinline__ float siluf_(float v) { return v * sigmoidf_(v); }
__device__ __forceinline__ f32x4 mfma16(bf16x8 a, bf16x8 b, f32x4 c) { return __builtin_amdgcn_mfma_f32_16x16x32_bf16(a, b, c, 0, 0, 0); }
__device__ __forceinline__ bf16x8 ldfrag(ldsp base, int off) { return *(const LAS bf16x8*)(base + off); }
__device__ __forceinline__ float shx(float v, int mask, int lane) { return __int_as_float(__builtin_amdgcn_ds_bpermute((lane ^ mask) << 2, __float_as_int(v))); }
__device__ __forceinline__ float wave_sum(float v, int lane) {
#pragma unroll
  for (int o = 32; o > 0; o >>= 1) v += shx(v, o, lane);
  return v;
}

#ifdef USE_NT
#define NTS(val, ptr) __builtin_nontemporal_store((val), (ptr))
#else
#define NTS(val, ptr) (*(ptr) = (val))
#endif
enum { MD_G1A = 0, MD_G1S, MD_G1B, MD_G2A, MD_G2B, MD_G3, MD_G4, MD_G5 };
struct RowBuf { u32x4 a[2]; f32x4 b0[2], b1[2]; f32x4 s[2]; int pi; };
struct UnitBuf { f32x4 c0[2], c1[2], d0[2], d1[2]; };
struct EpiP {
  static constexpr bool PERM = true, AFTER_DRAIN = false;
  int mode, l, g;
  const Params* pp;
  template <int MODE> __device__ __forceinline__ void unitload(UnitBuf& ub, const Unit& u, int wc, int fq) const {
    const Params& p = *pp;
    const float* small = (const float*)(p.ws + OFF_SMALL);
    const float* mod = small + SM_MOD + (size_t)l * 8 * 6144;
#pragma unroll
    for (int bj = 0; bj < 2; ++bj) {
      const int col = u.pn * 256 + bj * 128 + wc * 32 + 8 * fq;
      if constexpr (MODE == MD_G1A) {
        if ((col >> 10) == 1) { const float* lbp = small + SM_LB + l * 1024 + (col & 1023); ub.c0[bj] = *(const f32x4*)lbp; ub.c1[bj] = *(const f32x4*)(lbp + 4); }
      } else if constexpr (MODE == MD_G3) {
        const int b = (g * TG + u.pm * 256) >> 12; const float* gt = mod + (size_t)b * 6144 + 2 * 1024 + col;
        ub.c0[bj] = *(const f32x4*)gt; ub.c1[bj] = *(const f32x4*)(gt + 4);
      } else if constexpr (MODE == MD_G4) {
        const float* bp = p.b_up + (size_t)l * 4096 + col; ub.c0[bj] = *(const f32x4*)bp; ub.c1[bj] = *(const f32x4*)(bp + 4);
      } else if constexpr (MODE == MD_G5) {
        const int b = (u.pm * 256) >> 12; const float* gt = mod + (size_t)b * 6144 + 5 * 1024 + col; const float* bp = p.b_down + (size_t)l * 1024 + col;
        ub.c0[bj] = *(const f32x4*)gt; ub.c1[bj] = *(const f32x4*)(gt + 4); ub.d0[bj] = *(const f32x4*)bp; ub.d1[bj] = *(const f32x4*)(bp + 4);
      }
    }
  }
  template <int MODE, int ai, int m, int PH> __device__ __forceinline__ void rowf(const f32x4 (&acc)[2][2][4][2], RowBuf& rb, const UnitBuf& ub, const Unit& u, int wr, int wc, int fr, int fq) const {
    if constexpr (PH == 0 && MODE == MD_G1A) { if ((u.pn >> 2) >= 2) rb.pi = pp->pos[g * TG + u.pm * 256 + ai * 128 + wr * 64 + m * 16 + fr]; }
    cell<MODE, ai, m, PH, 0>(acc, rb, ub, u, wr, wc, fr, fq);
    cell<MODE, ai, m, PH, 1>(acc, rb, ub, u, wr, wc, fr, fq);
  }
  template <int MODE, int ai, int m, int PH, int bj> __device__ __forceinline__ void cell(const f32x4 (&acc)[2][2][4][2], RowBuf& rb, const UnitBuf& ub, const Unit& u, int wr, int wc, int fr, int fq) const {
    const Params& p = *pp;
    unsigned char* R0 = p.ws + OFF_R0; unsigned char* DO = (unsigned char*)p.out;
    float* small = (float*)(p.ws + OFF_SMALL);
    const int row = u.pm * 256 + ai * 128 + wr * 64 + m * 16 + fr;
    {
      const int col = u.pn * 256 + bj * 128 + wc * 32 + 8 * fq;
      float v[8];
#pragma unroll
      for (int i = 0; i < 4; ++i) { v[i] = acc[ai][bj][m][0][i]; v[4 + i] = acc[ai][bj][m][1][i]; }
      if constexpr (MODE == MD_G1A) {
        if constexpr (PH == 1) {
          const int sec = col >> 10, cs = col & 1023;
          if (sec == 0) {
            u32x4 o;
#pragma unroll
            for (int i = 0; i < 4; ++i) o[i] = pk2(siluf_(v[2 * i]), siluf_(v[2 * i + 1]));
            *(u32x4*)(R0 + R_QH + ((size_t)row * 1024 + cs) * 2) = o;
          } else if (sec == 1) {
            float o[8];
            if (l == 0) {
#pragma unroll
              for (int i = 0; i < 8; ++i) { const float z = v[i]; o[i] = fminf(z, 0.f) - __logf(1.0f + __expf(-fabsf(z))); }
            } else {
#pragma unroll
              for (int i = 0; i < 8; ++i) {
                const float lbv = i < 4 ? ub.c0[bj][i & 3] : ub.c1[bj][i & 3];
                const float z = v[i], e = __expf(-fabsf(z)), r = __builtin_amdgcn_rcpf(1.0f + e);
                const float sg = z >= 0.f ? r : e * r;
                o[i] = __logf(lbv + (1.f - lbv) * sg);
              }
            }
            float* dst = (float*)(DO + D_LF) + (size_t)row * 1024 + cs;
            *(f32x4*)dst = (f32x4){o[0], o[1], o[2], o[3]}; *(f32x4*)(dst + 4) = (f32x4){o[4], o[5], o[6], o[7]};
          } else {
            const float posf = (float)rb.pi;
            const float sc = sec == 3 ? 0.0625f : 1.0f;
            const int p0 = (cs & 255) >> 1;
            u32x4 o;
#pragma unroll
            for (int i = 0; i < 4; ++i) {
              const float theta = __builtin_amdgcn_exp2f(-13.287712379549449f * (float)(p0 + i) * (1.0f / 127.0f));
              float rev = posf * theta * 0.15915494309189535f; rev -= floorf(rev);
              const float sn = __builtin_amdgcn_sinf(rev), cn = __builtin_amdgcn_cosf(rev);
              const float t1 = v[2 * i], t2 = v[2 * i + 1];
              o[i] = pk2((t1 * cn - t2 * sn) * sc, (t1 * sn + t2 * cn) * sc);
            }
            *(u32x4*)(R0 + (sec == 2 ? R_QR : R_KR) + ((size_t)row * 1024 + cs) * 2) = o;
          }
        }
      } else if constexpr (MODE == MD_G1S) {
        if constexpr (PH == 1) {
          if ((row >> 10) == 0) {
            u32x4 o;
#pragma unroll
            for (int i = 0; i < 4; ++i) o[i] = pk2(v[2 * i], v[2 * i + 1]);
            *(u32x4*)(R0 + R_VIT + ((size_t)row * TG + col) * 2) = o;
          } else {
            const int f = row - 1024, h = (u.pm * 256 - 1024) >> 9;
            const float lg2 = __log2f(1.0f - __builtin_amdgcn_exp2f(-5.0f - (float)h));
            u32x4 ov;
#pragma unroll
            for (int i = 0; i < 4; ++i) ov[i] = pk2(v[2 * i] * __builtin_amdgcn_exp2f(lg2 * (float)(63 - ((col + 2 * i) & 63))), v[2 * i + 1] * __builtin_amdgcn_exp2f(lg2 * (float)(63 - ((col + 2 * i + 1) & 63))));
            *(u32x4*)(DO + D_VRT + ((size_t)f * TG + col) * 2) = ov;
          }
        }
      } else if constexpr (MODE == MD_G1B) {
        const int sec = col >> 10, cs = col & 1023;
        if (sec == 0) {
          u32x4* ptr = (u32x4*)(R0 + R_ORA + ((size_t)row * 1024 + cs) * 2);
          if constexpr (PH == 0) { rb.a[bj] = *ptr; rb.s[bj][0] = (small + SM_STH)[(size_t)row * 8 + (cs >> 7)]; }
          else {
            const float rstd = rsqrtf(rb.s[bj][0] * (1.0f / 128.0f) + 1e-6f);
            const u32x4 ov = rb.a[bj]; u32x4 o;
#pragma unroll
            for (int i = 0; i < 4; ++i) o[i] = pk2(bflo(ov[i]) * rstd * siluf_(v[2 * i]), bfhi(ov[i]) * rstd * siluf_(v[2 * i + 1]));
            *ptr = o;
          }
        } else if (sec < 3) {
          const int c2 = col - 1024;
          u32x4* ptr = (u32x4*)(R0 + R_ORB + ((size_t)row * 2048 + c2) * 2);
          if constexpr (PH == 0) { const float* st = small + SM_STR + ((size_t)row * 4 + (c2 >> 9)) * 2; rb.a[bj] = *ptr; rb.s[bj][0] = st[0]; rb.s[bj][1] = st[1]; }
          else {
            const float mean = rb.s[bj][0] * (1.0f / 512.0f);
            const float var = fmaxf(rb.s[bj][1] * (1.0f / 512.0f) - mean * mean, 0.f);
            const float rstd = rsqrtf(var + 1e-6f);
            const u32x4 ov = rb.a[bj]; u32x4 o;
#pragma unroll
            for (int i = 0; i < 4; ++i) o[i] = pk2((bflo(ov[i]) - mean) * rstd * siluf_(v[2 * i]), (bfhi(ov[i]) - mean) * rstd * siluf_(v[2 * i + 1]));
            *ptr = o;
          }
        } else {
          if constexpr (PH == 1) {
            u32x4 o;
#pragma unroll
            for (int i = 0; i < 4; ++i) o[i] = pk2(sigmoidf_(v[2 * i]), sigmoidf_(v[2 * i + 1]));
            *(u32x4*)(R0 + (sec == 3 ? R_SGA : R_SGB) + ((size_t)row * 1024 + cs) * 2) = o;
          }
        }
      } else if constexpr (MODE == MD_G2A) {
        if constexpr (PH == 0) rb.a[bj] = *(const u32x4*)(R0 + R_SGA + ((size_t)row * 1024 + col) * 2);
        else {
          const u32x4 gv = rb.a[bj];
          float* dst = (float*)(R0 + R_M1) + (size_t)row * 1024 + col;
          *(f32x4*)dst = (f32x4){bflo(gv[0]) * v[0], bfhi(gv[0]) * v[1], bflo(gv[1]) * v[2], bfhi(gv[1]) * v[3]};
          *(f32x4*)(dst + 4) = (f32x4){bflo(gv[2]) * v[4], bfhi(gv[2]) * v[5], bflo(gv[3]) * v[6], bfhi(gv[3]) * v[7]};
        }
      } else if constexpr (MODE == MD_G2B) {
        if constexpr (PH == 0) {
          rb.a[bj] = *(const u32x4*)(R0 + R_SGB + ((size_t)row * 1024 + col) * 2);
          const float* src = (const float*)(R0 + R_M1) + (size_t)row * 1024 + col;
          rb.b0[bj] = *(const f32x4*)src; rb.b1[bj] = *(const f32x4*)(src + 4);
        } else {
          const u32x4 gv = rb.a[bj]; const f32x4 m0 = rb.b0[bj], m1 = rb.b1[bj];
          u32x4 o;
          o[0] = pk2(m0[0] + bflo(gv[0]) * v[0], m0[1] + bfhi(gv[0]) * v[1]);
          o[1] = pk2(m0[2] + bflo(gv[1]) * v[2], m0[3] + bfhi(gv[1]) * v[3]);
          o[2] = pk2(m1[0] + bflo(gv[2]) * v[4], m1[1] + bfhi(gv[2]) * v[5]);
          o[3] = pk2(m1[2] + bflo(gv[3]) * v[6], m1[3] + bfhi(gv[3]) * v[7]);
          *(u32x4*)(R0 + R_MG + ((size_t)row * 1024 + col) * 2) = o;
        }
      } else if constexpr (MODE == MD_G3) {
        const int tg = g * TG + row;
        if constexpr (PH == 0) {
          const float* xin = (l == 0 ? p.x : (const float*)(p.ws + OFF_XB)) + (size_t)tg * 1024 + col;
          rb.b0[bj] = *(const f32x4*)xin; rb.b1[bj] = *(const f32x4*)(xin + 4);
        } else {
          float* dst = (float*)(p.ws + OFF_XB) + (size_t)tg * 1024 + col;
          f32x4 o0, o1;
#pragma unroll
          for (int i = 0; i < 4; ++i) { o0[i] = ALPHA * rb.b0[bj][i] + (1.f + ub.c0[bj][i]) * v[i]; o1[i] = ALPHA * rb.b1[bj][i] + (1.f + ub.c1[bj][i]) * v[4 + i]; }
          *(f32x4*)dst = o0; *(f32x4*)(dst + 4) = o1;
        }
      } else if constexpr (MODE == MD_G4) {
        if constexpr (PH == 1) {
          float o[8];
#pragma unroll
          for (int i = 0; i < 8; ++i) { const float hh = fmaxf(v[i] + (i < 4 ? ub.c0[bj][i & 3] : ub.c1[bj][i & 3]), 0.f); o[i] = hh * hh; }
          u32x4 ov;
#pragma unroll
          for (int i = 0; i < 4; ++i) ov[i] = pk2(o[2 * i], o[2 * i + 1]);
          *(u32x4*)(R0 + ((size_t)row * 4096 + col) * 2) = ov;
        }
      } else if constexpr (MODE == MD_G5) {
        float* dst = (float*)(p.ws + OFF_XB) + (size_t)row * 1024 + col;
        if constexpr (PH == 0) { rb.b0[bj] = *(const f32x4*)dst; rb.b1[bj] = *(const f32x4*)(dst + 4); }
        else {
          f32x4 o0, o1;
#pragma unroll
          for (int i = 0; i < 4; ++i) { o0[i] = ALPHA * rb.b0[bj][i] + (1.f + ub.c0[bj][i]) * (v[i] + ub.d0[bj][i]); o1[i] = ALPHA * rb.b1[bj][i] + (1.f + ub.c1[bj][i]) * (v[4 + i] + ub.d1[bj][i]); }
          *(f32x4*)dst = o0; *(f32x4*)(dst + 4) = o1;
        }
      }
    }
  }
  template <int MODE> __device__ __forceinline__ void run(const f32x4 (&acc)[2][2][4][2], const Unit& u, int wr, int wc, int fr, int fq) const {
    UnitBuf ub; unitload<MODE>(ub, u, wc, fq);
#define RB2(AI, M0, M1) { RowBuf r0, r1; \
      rowf<MODE, AI, M0, 0>(acc, r0, ub, u, wr, wc, fr, fq); rowf<MODE, AI, M1, 0>(acc, r1, ub, u, wr, wc, fr, fq); \
      rowf<MODE, AI, M0, 1>(acc, r0, ub, u, wr, wc, fr, fq); rowf<MODE, AI, M1, 1>(acc, r1, ub, u, wr, wc, fr, fq); }
    RB2(0, 0, 1) RB2(0, 2, 3) RB2(1, 0, 1) RB2(1, 2, 3)
#undef RB2
  }
  __device__ __forceinline__ void operator()(const f32x4 (&acc)[2][2][4][2], const Unit& u, int wr, int wc, int fr, int fq) const {
    asm volatile("" : "+v"(fr), "+v"(fq));
    switch (mode) {
      case MD_G1A: run<MD_G1A>(acc, u, wr, wc, fr, fq); break;
      case MD_G1S: run<MD_G1S>(acc, u, wr, wc, fr, fq); break;
      case MD_G1B: run<MD_G1B>(acc, u, wr, wc, fr, fq); break;
      case MD_G2A: run<MD_G2A>(acc, u, wr, wc, fr, fq); break;
      case MD_G2B: run<MD_G2B>(acc, u, wr, wc, fr, fq); break;
      case MD_G3: run<MD_G3>(acc, u, wr, wc, fr, fq); break;
      case MD_G4: run<MD_G4>(acc, u, wr, wc, fr, fq); break;
      default: run<MD_G5>(acc, u, wr, wc, fr, fq); break;
    }
  }
};
#define XB_TMO      128
#define XB_XCNT(j)  (256  + 64 * (j))
#define XB_XSUB(j)  (1280 + 64 * (j))
#define XB_XGEN(j)  (2304 + 64 * (j))
#define XB_TOP      3328
#define XB_TOPGEN   3392
#define XCD_BAR_WORDS 3456
#define XB_SPIN_CAP (1u << 18)

__device__ __forceinline__ unsigned xb_ld(unsigned* p)              { return __hip_atomic_load(p, __ATOMIC_RELAXED, __HIP_MEMORY_SCOPE_AGENT); }
__device__ __forceinline__ unsigned xb_add(unsigned* p, unsigned v) { return __hip_atomic_fetch_add(p, v, __ATOMIC_RELAXED, __HIP_MEMORY_SCOPE_AGENT); }
__device__ __forceinline__ unsigned xb_xcc_id() { return (unsigned)__builtin_amdgcn_s_getreg((3 << 11) | 20) & 0xFu; }
#define XB_SPIN(cond, bar) do { unsigned _sp = 0; while (cond) { __builtin_amdgcn_s_sleep(1); \
    if ((++_sp & 255u) == 0u) { if (xb_ld(&(bar)[XB_TMO])) break; if (_sp > XB_SPIN_CAP) { atomicAdd(&(bar)[XB_TMO], 1u); break; } } } } while (0)

struct XcdBarrier {
    unsigned* bar; unsigned x;
    volatile LAS unsigned* st;
};

__device__ __forceinline__ XcdBarrier xcd_barrier_post(unsigned* bar, volatile LAS unsigned* st) {
    XcdBarrier b; b.bar = bar; b.x = xb_xcc_id(); b.st = st;
    if (threadIdx.x == 0) (void)xb_add(&bar[XB_XCNT(b.x)], 1u);
    return b;
}
__device__ __forceinline__ void xcd_barrier_complete(unsigned* bar, unsigned x, unsigned& nloc, unsigned& nx) {
    const unsigned G = gridDim.x * gridDim.y * gridDim.z;
    unsigned sum, cnt, mine, sp = 0u;
    for (;;) {
        sum = 0u; cnt = 0u; mine = 0u;
#pragma unroll
        for (unsigned j = 0; j < 16; ++j) { const unsigned c = xb_ld(&bar[XB_XCNT(j)]); sum += c; cnt += (c > 0u) ? 1u : 0u; mine = (j == x) ? c : mine; }
        if (sum == G) break;
        __builtin_amdgcn_s_sleep(1);
        if ((++sp & 255u) == 0u) { if (xb_ld(&bar[XB_TMO])) break; if (sp > XB_SPIN_CAP) { atomicAdd(&bar[XB_TMO], 1u); break; } }
    }
    nloc = mine > 0u ? mine : 1u; nx = cnt > 0u ? cnt : 1u;
}

__device__ __forceinline__ void xcd_barrier(const XcdBarrier& b) {
    asm volatile("s_waitcnt vmcnt(0)" ::: "memory");
    __syncthreads();
    if (threadIdx.x == 0) {
        unsigned* bar = b.bar;
        __builtin_amdgcn_s_waitcnt(0);
        unsigned nloc = b.st[0], nx = b.st[1];
        if (nloc == 0u) { xcd_barrier_complete(bar, b.x, nloc, nx); b.st[0] = nloc; b.st[1] = nx; }
        const unsigned old = xb_add(&bar[XB_XSUB(b.x)], 1u);
        const unsigned gen = old / nloc;
        if (old + 1u == (gen + 1u) * nloc) {
            __builtin_amdgcn_fence(__ATOMIC_RELEASE, "agent");
            asm volatile("s_waitcnt vmcnt(0)" ::: "memory");
            const unsigned og = xb_add(&bar[XB_TOP], 1u);
            const unsigned tg = og / nx;
            if (og + 1u == (tg + 1u) * nx) xb_add(&bar[XB_TOPGEN], 1u);
            else XB_SPIN(xb_ld(&bar[XB_TOPGEN]) == tg, bar);
            __builtin_amdgcn_fence(__ATOMIC_ACQUIRE, "agent");
            xb_add(&bar[XB_XGEN(b.x)], 1u);
            asm volatile("s_waitcnt vmcnt(0)" ::: "memory");
        } else {
            XB_SPIN(xb_ld(&bar[XB_XGEN(b.x)]) == gen, bar);
            __builtin_amdgcn_fence(__ATOMIC_ACQUIRE, "agent");
            asm volatile("s_waitcnt vmcnt(0)" ::: "memory");
        }
    }
    __syncthreads();
}

__device__ __forceinline__ void gbar(unsigned* bar0, volatile LAS unsigned* st) {
    XcdBarrier b; b.bar = bar0; asm volatile("" : "+s"(b.bar)); b.x = (unsigned)__builtin_amdgcn_readfirstlane((int)xb_xcc_id()); asm volatile("" : "+s"(b.x)); b.st = st; xcd_barrier(b);
}
__device__ __forceinline__ void conv_job(ldsp lds, int wv, const float* src, int ld, int K, int c0, int ncols, bf16_t* dst) {
  LAS float* tile = (LAS float*)lds;
  const int tid = otid(wv), ntk = K >> 6, ntn = ncols >> 6, nt = ntk * ntn;
  for (int t = obid(); t < nt; t += gridDim.x) {
    const int tk = t / ntn, tn = t - tk * ntn, k0 = tk << 6, n0 = tn << 6;
    __syncthreads();
#pragma unroll
    for (int i = 0; i < 8; ++i) { const int r = i * 8 + (tid >> 6), cc = tid & 63; tile[r * 65 + cc] = src[(size_t)(k0 + r) * ld + c0 + n0 + cc]; }
    __syncthreads();
    const int kp = tid & 31, nn = tid >> 5;
#pragma unroll
    for (int i = 0; i < 4; ++i) { const int n = nn + 16 * i; *(unsigned*)(dst + (size_t)(n0 + n) * K + k0 + 2 * kp) = pk2(tile[(2 * kp) * 65 + n], tile[(2 * kp + 1) * 65 + n]); }
  }
  __syncthreads();
}
__device__ __forceinline__ void phase_conv(ldsp lds, const Params& p, int l) {
  bf16_t* WB = (bf16_t*)(p.ws + OFF_WB);
  const float* win = p.w_in + (size_t)l * 1024 * 12288;
  conv_job(lds, p.wv, win, 12288, 1024, 0, 1024, WB + W1A);
  conv_job(lds, p.wv, win, 12288, 1024, 1024, 1024, WB + W1A + 1024ull * 1024);
  conv_job(lds, p.wv, win, 12288, 1024, 4096, 2048, WB + W1A + 2048ull * 1024);
  conv_job(lds, p.wv, win, 12288, 1024, 2048, 1024, WB + W1S);
  conv_job(lds, p.wv, win, 12288, 1024, 6144, 2048, WB + W1S + 1024ull * 1024);
  conv_job(lds, p.wv, win, 12288, 1024, 3072, 1024, WB + W1B);
  conv_job(lds, p.wv, win, 12288, 1024, 8192, 4096, WB + W1B + 1024ull * 1024);
  conv_job(lds, p.wv, p.w_pa + (size_t)l * 1024 * 1024, 1024, 1024, 0, 1024, WB + WPA);
  conv_job(lds, p.wv, p.w_pb + (size_t)l * 2048 * 1024, 1024, 2048, 0, 1024, WB + WPB);
  conv_job(lds, p.wv, p.w_o + (size_t)l * 1024 * 1024, 1024, 1024, 0, 1024, WB + WO);
  conv_job(lds, p.wv, p.w_up + (size_t)l * 1024 * 4096, 4096, 1024, 0, 4096, WB + WUP);
  conv_job(lds, p.wv, p.w_down + (size_t)l * 4096 * 1024, 1024, 4096, 0, 1024, WB + WDN);
}
__device__ __forceinline__ void phase_mod(ldsp lds, const Params& p) {
  float* small = (float*)(p.ws + OFF_SMALL);
  const int tid = otid(p.wv);
  const int bid = obid();
  if (bid < 192) {
    LAS float* cond = (LAS float*)lds;
    LAS float* part = (LAS float*)(lds + 32768);
    for (int i = tid; i < 8192; i += 512) cond[i] = siluf_(p.c[i]);
    __syncthreads();
    const int o0 = bid * 64, l = o0 / 6144, n0 = o0 - l * 6144, nl = tid & 63, kq = tid >> 6;
    const float* w = p.w_ada + (size_t)l * 1024 * 6144 + n0 + nl + (size_t)(kq * 128) * 6144;
    float a[8];
#pragma unroll
    for (int b = 0; b < 8; ++b) a[b] = 0.f;
#pragma unroll 8
    for (int k = 0; k < 128; ++k) {
      const float wv = w[(size_t)k * 6144];
#pragma unroll
      for (int b = 0; b < 8; ++b) a[b] += cond[b * 1024 + kq * 128 + k] * wv;
    }
#pragma unroll
    for (int b = 0; b < 8; ++b) part[(kq * 8 + b) * 64 + nl] = a[b];
    __syncthreads();
    {
      const int b = tid >> 6; float s = 0.f;
#pragma unroll
      for (int q = 0; q < 8; ++q) s += part[(q * 8 + b) * 64 + nl];
      small[SM_MOD + (size_t)l * 8 * 6144 + b * 6144 + n0 + nl] = s + p.b_ada[l * 6144 + n0 + nl];
    }
    __syncthreads();
  } else if (bid == 192) {
    for (int i = tid; i < 1024; i += 512) {
      const float a = p.lb_logits[i], b = p.lb_logits[1024 + i], mx = fmaxf(a, b);
      const float ea = __expf(a - mx), eb = __expf(b - mx);
      small[SM_LB + i] = 0.f; small[SM_LB + 1024 + i] = eb / (ea + eb);
    }
  }
}
__device__ __forceinline__ void phase_u0(const Params& p) {
  const float* mod = (const float*)(p.ws + OFF_SMALL) + SM_MOD;
  bf16_t* U = (bf16_t*)(p.ws + OFF_U);
  const size_t n4 = (size_t)T_ALL * 1024 / 4;
  for (size_t i = (size_t)obid() * 512 + otid(p.wv); i < n4; i += (size_t)gridDim.x * 512) {
    const size_t e = i * 4; const int t = (int)(e >> 10), cc = (int)(e & 1023), b = t >> 12;
    const f32x4 xv = *(const f32x4*)(p.x + e), sh = *(const f32x4*)(mod + b * 6144 + cc), sc = *(const f32x4*)(mod + b * 6144 + 1024 + cc);
    u32x2 o; o[0] = pk2(xv[0] * (1.f + sc[0]) + sh[0], xv[1] * (1.f + sc[1]) + sh[1]); o[1] = pk2(xv[2] * (1.f + sc[2]) + sh[2], xv[3] * (1.f + sc[3]) + sh[3]);
    *(u32x2*)(U + e) = o;
  }
}
__device__ __forceinline__ void phase_ln(const Params& p, const float* gam, const float* bet, int lm, int s_shift, bool fin) {
  float* XB = (float*)(p.ws + OFF_XB);
  const float* mod = (const float*)(p.ws + OFF_SMALL) + SM_MOD + (size_t)lm * 8 * 6144;
  bf16_t* U = (bf16_t*)(p.ws + OFF_U);
  const int tid_ = otid(p.wv); const int lane = tid_ & 63, gw = obid() * 8 + (tid_ >> 6), nw = gridDim.x * 8;
  for (int row = gw; row < T_ALL; row += nw) {
    const float* src = XB + (size_t)row * 1024;
    f32x4 v[4]; float s = 0.f;
#pragma unroll
    for (int k = 0; k < 4; ++k) { v[k] = *(const f32x4*)(src + 256 * k + 4 * lane); s += v[k][0] + v[k][1] + v[k][2] + v[k][3]; }
    const float mu = wave_sum(s, lane) * (1.0f / 1024.0f);
    float q = 0.f;
#pragma unroll
    for (int k = 0; k < 4; ++k)
#pragma unroll
      for (int i = 0; i < 4; ++i) { const float d = v[k][i] - mu; q += d * d; }
    const float rstd = rsqrtf(wave_sum(q, lane) * (1.0f / 1024.0f) + 1e-5f);
    const int b = row >> 12;
#pragma unroll
    for (int k = 0; k < 4; ++k) {
      const int cc = 256 * k + 4 * lane;
      const f32x4 gg = *(const f32x4*)(gam + cc), bb = *(const f32x4*)(bet + cc);
      f32x4 y;
#pragma unroll
      for (int i = 0; i < 4; ++i) y[i] = (v[k][i] - mu) * rstd * gg[i] + bb[i];
      if (fin) { *(f32x4*)(p.out + (size_t)row * 1024 + cc) = y; }
      else {
        *(f32x4*)(XB + (size_t)row * 1024 + cc) = y;
        const f32x4 sh = *(const f32x4*)(mod + b * 6144 + s_shift * 1024 + cc), sc = *(const f32x4*)(mod + b * 6144 + (s_shift + 1) * 1024 + cc);
        u32x2 o; o[0] = pk2(y[0] * (1.f + sc[0]) + sh[0], y[1] * (1.f + sc[1]) + sh[1]); o[1] = pk2(y[2] * (1.f + sc[2]) + sh[2], y[3] * (1.f + sc[3]) + sh[3]);
        *(u32x2*)(U + (size_t)row * 1024 + cc) = o;
      }
    }
  }
}
typedef short s16x4 __attribute__((ext_vector_type(4)));
template <class T> __device__ __forceinline__ T* vaddr(T* q) { asm volatile("" : "+v"(q)); return q; }
__device__ __forceinline__ void ret_item(ldsp lds, const Params& p, int item, bool do_stats) {
  constexpr int KS = 0, VTS = 33792, STS = 43008, PS = 76800;
  const int es = item & 7, h = (item >> 3) & 3, bl = item >> 5;
  const int tid = otid(p.wv), w = tid >> 6, lane = tid & 63, fr = lane & 15, fq = lane >> 4;
  unsigned char* R0 = oaddr(p.ws) + OFF_R0; unsigned char* DO = (unsigned char*)oaddr(p.out);
  const bf16_t* Qr = (const bf16_t*)(R0 + R_QR); const bf16_t* Kr = (const bf16_t*)(R0 + R_KR);
  const bf16_t* VrT = (const bf16_t*)(DO + D_VRT); bf16_t* OrB = (bf16_t*)(R0 + R_ORB);
  float* stR = (float*)(p.ws + OFF_SMALL) + SM_STR;
  const float gam = 1.0f - __builtin_amdgcn_exp2f(-5.0f - (float)h), lg2 = __log2f(gam), g64 = __builtin_amdgcn_exp2f(lg2 * 64.0f);
  const int it = w >> 1, eh = w & 1;
  f32x4 st[2][4];
#pragma unroll
  for (int a = 0; a < 2; ++a)
#pragma unroll
    for (int b = 0; b < 4; ++b) st[a][b] = (f32x4){0.f, 0.f, 0.f, 0.f};
  const float rowscale = __builtin_amdgcn_exp2f(lg2 * (float)(16 * it + fr - 63));
  u32x4 kreg[4], vtreg; bf16x8 qn[8];
#define RET_LOADS(TOK) do { \
    const bf16_t* kbase = vaddr(Kr + (size_t)((TOK) + (tid >> 5)) * 1024 + h * 256 + (tid & 31) * 8); \
    const bf16_t* vtbase = vaddr(VrT + (size_t)(h * 512 + es * 64 + (tid >> 3)) * TG + (TOK) + (tid & 7) * 8); \
    const bf16_t* qbase = vaddr(Qr + (size_t)((TOK) + 16 * it + fr) * 1024 + h * 256 + fq * 8); \
    _Pragma("unroll") for (int i = 0; i < 4; ++i) kreg[i] = *(const u32x4*)(kbase + (size_t)i * 16 * 1024); \
    vtreg = *(const u32x4*)vtbase; \
    _Pragma("unroll") for (int ks = 0; ks < 8; ++ks) qn[ks] = *(const bf16x8*)(qbase + ks * 32); } while (0)
  RET_LOADS(bl * SEQ);
  for (int n = 0; n < 64; ++n) {
    const int tok0 = bl * SEQ + n * 64;
    bf16x8 qf[8];
    bf16_t* obase = vaddr(OrB + (size_t)(tok0 + 16 * it + fr) * 2048 + h * 512 + es * 64 + 32 * eh + 4 * fq);
    float* sbase = vaddr(stR + ((size_t)(tok0 + 16 * it + fr) * 4 + h) * 2);
#pragma unroll
    for (int ks = 0; ks < 8; ++ks) qf[ks] = qn[ks];
    __builtin_amdgcn_sched_barrier(0);
#pragma unroll
    for (int dt = 0; dt < 2; ++dt)
#pragma unroll
      for (int et = 0; et < 4; ++et) {
        u32x2 o; o[0] = pk2(st[dt][et][0], st[dt][et][1]); o[1] = pk2(st[dt][et][2], st[dt][et][3]);
        *(LAS u32x2*)(lds + STS + (16 * et + fr) * 528 + (32 * w + 16 * dt + 4 * fq) * 2) = o;
      }
#pragma unroll
    for (int i = 0; i < 4; ++i) { const int c = tid + 512 * i, r = c >> 5, ch = c & 31; *(LAS u32x4*)(lds + KS + r * 528 + ch * 16) = kreg[i]; }
    { const int r = tid >> 3, ch = tid & 7; *(LAS u32x4*)(lds + VTS + r * 144 + ch * 16) = vtreg; }
    __syncthreads();
    { const int tokn = bl * SEQ + (n < 63 ? n + 1 : 63) * 64; RET_LOADS(tokn); }
    f32x4 oacc[2];
#pragma unroll
    for (int jj = 0; jj < 2; ++jj) {
      const int jt = 2 * eh + jj;
      f32x4 sc = (f32x4){0.f, 0.f, 0.f, 0.f};
#pragma unroll
      for (int ks = 0; ks < 8; ++ks) sc = mfma16(ldfrag(lds, KS + (16 * jt + fr) * 528 + (32 * ks + 8 * fq) * 2), qf[ks], sc);
      const int i_ = 16 * it + fr, j0 = 16 * jt + 4 * fq;
      u32x2 o; o[0] = pk2(j0 + 0 <= i_ ? sc[0] : 0.f, j0 + 1 <= i_ ? sc[1] : 0.f); o[1] = pk2(j0 + 2 <= i_ ? sc[2] : 0.f, j0 + 3 <= i_ ? sc[3] : 0.f);
      *(LAS u32x2*)(lds + PS + i_ * 144 + j0 * 2) = o;
    }
#pragma unroll
    for (int ee = 0; ee < 2; ++ee) {
      const int et = 2 * eh + ee;
      f32x4 o = (f32x4){0.f, 0.f, 0.f, 0.f};
#pragma unroll
      for (int ks = 0; ks < 8; ++ks) o = mfma16(ldfrag(lds, STS + (16 * et + fr) * 528 + (32 * ks + 8 * fq) * 2), qf[ks], o);
      oacc[ee] = o;
    }
#pragma unroll
    for (int k2 = 0; k2 < 2; ++k2) {
      bf16x8 vf[4];
#pragma unroll
      for (int et = 0; et < 4; ++et) vf[et] = ldfrag(lds, VTS + (16 * et + fr) * 144 + (32 * k2 + 8 * fq) * 2);
#pragma unroll
      for (int dt = 0; dt < 2; ++dt) {
        bf16x8 kf;
        {
          const int a0 = KS + (32 * k2 + 8 * fq + (fr >> 2)) * 528 + (32 * w + 16 * dt + 4 * (fr & 3)) * 2;
          const s16x4 t0 = __builtin_amdgcn_ds_read_tr16_b64_v4i16((LAS s16x4*)(lds + a0));
          const s16x4 t1 = __builtin_amdgcn_ds_read_tr16_b64_v4i16((LAS s16x4*)(lds + a0 + 4 * 528));
          kf = (bf16x8){t0[0], t0[1], t0[2], t0[3], t1[0], t1[1], t1[2], t1[3]};
        }
#pragma unroll
        for (int et = 0; et < 4; ++et) st[dt][et] = mfma16(kf, vf[et], st[dt][et]);
      }
    }
#pragma unroll
    for (int dt = 0; dt < 2; ++dt)
#pragma unroll
      for (int et = 0; et < 4; ++et)
#pragma unroll
        for (int r = 0; r < 4; ++r) st[dt][et][r] *= g64;
    __syncthreads();
    float s1 = 0.f, s2 = 0.f;
#pragma unroll
    for (int ee = 0; ee < 2; ++ee) {
      const int et = 2 * eh + ee;
      f32x4 o = oacc[ee];
#pragma unroll
      for (int k2 = 0; k2 < 2; ++k2) o = mfma16(ldfrag(lds, VTS + (16 * et + fr) * 144 + (32 * k2 + 8 * fq) * 2), ldfrag(lds, PS + (16 * it + fr) * 144 + (32 * k2 + 8 * fq) * 2), o);
#pragma unroll
      for (int r = 0; r < 4; ++r) { o[r] *= rowscale; s1 += o[r]; s2 += o[r] * o[r]; }
      u32x2 ov; ov[0] = pk2(o[0], o[1]); ov[1] = pk2(o[2], o[3]);
      *(u32x2*)(obase + 16 * ee) = ov;
    }
    s1 += shx(s1, 16, lane); s1 += shx(s1, 32, lane); s2 += shx(s2, 16, lane); s2 += shx(s2, 32, lane);
    if (fq == 0 && do_stats) { unsafeAtomicAdd(sbase, s1); unsafeAtomicAdd(sbase + 1, s2); }
    __syncthreads();
  }
}
__device__ __forceinline__ void hgrn_item(ldsp lds, const Params& p, int item, bool do_stats) {
  constexpr int QT = 0, KT = 17408, QB = 34816, KBT = 52224, VTS = 70656, STS = 75264, PS = 83968, TOT = 93184, DEC = 97280;
  const int es = item & 3, h = (item >> 2) & 7, bl = item >> 5;
  const int tid = otid(p.wv), w = tid >> 6, lane = tid & 63, fr = lane & 15, fq = lane >> 4;
  unsigned char* R0 = oaddr(p.ws) + OFF_R0; unsigned char* DO = (unsigned char*)oaddr(p.out);
  const bf16_t* Qh = (const bf16_t*)(R0 + R_QH); const float* LF = (const float*)(DO + D_LF); const bf16_t* ViT = (const bf16_t*)(R0 + R_VIT);
  bf16_t* OrA = (bf16_t*)(R0 + R_ORA);
  float* stH = (float*)(p.ws + OFF_SMALL) + SM_STH;
  LAS float* tot = (LAS float*)(lds + TOT); LAS float* dec = (LAS float*)(lds + DEC);
  const int it = w >> 1, eh = w & 1, d0 = 2 * lane;
  f32x4 st[2];
  st[0] = (f32x4){0.f, 0.f, 0.f, 0.f}; st[1] = (f32x4){0.f, 0.f, 0.f, 0.f};
  float lxn[8], lyn[8]; unsigned q2n[8]; u32x4 vtreg;
#define HG_LOADS(TOK) do { \
    const float* lfbase = vaddr(LF + (size_t)((TOK) + 8 * w) * 1024 + h * 128 + d0); \
    const bf16_t* qhbase = vaddr(Qh + (size_t)((TOK) + 8 * w) * 1024 + h * 128 + d0); \
    const bf16_t* vtbase = vaddr(ViT + (size_t)(h * 128 + es * 32 + ((tid & 255) >> 3)) * TG + (TOK) + (tid & 7) * 8); \
    _Pragma("unroll") for (int jj = 0; jj < 8; ++jj) { \
      const float2 t = *(const float2*)(lfbase + (size_t)jj * 1024); lxn[jj] = t.x; lyn[jj] = t.y; q2n[jj] = *(const unsigned*)(qhbase + (size_t)jj * 1024); } \
    vtreg = *(const u32x4*)vtbase; } while (0)
  HG_LOADS(bl * SEQ);
  for (int n = 0; n < 64; ++n) {
    const int tok0 = bl * SEQ + n * 64;
    float lx[8], ly[8]; unsigned q2[8];
    bf16_t* obase = vaddr(OrA + (size_t)(tok0 + 16 * it + fr) * 1024 + h * 128 + es * 32 + 16 * eh + 4 * fq);
    float* sbase = vaddr(stH + (size_t)(tok0 + 16 * it + fr) * 8 + h);
#pragma unroll
    for (int jj = 0; jj < 8; ++jj) { lx[jj] = lxn[jj]; ly[jj] = lyn[jj]; q2[jj] = q2n[jj]; }
    __builtin_amdgcn_sched_barrier(0);
    float px[8], py[8]; float cx = 0.f, cy = 0.f;
#pragma unroll
    for (int jj = 0; jj < 8; ++jj) { cx += lx[jj]; cy += ly[jj]; px[jj] = cx; py[jj] = cy; }
    tot[w * 128 + d0] = cx; tot[w * 128 + d0 + 1] = cy;
#pragma unroll
    for (int et = 0; et < 2; ++et) {
      u32x2 o; o[0] = pk2(st[et][0], st[et][1]); o[1] = pk2(st[et][2], st[et][3]);
      *(LAS u32x2*)(lds + STS + (16 * et + fr) * 272 + (16 * w + 4 * fq) * 2) = o;
    }
    if (tid < 256) { const int r = tid >> 3, ch = tid & 7; *(LAS u32x4*)(lds + VTS + r * 144 + ch * 16) = vtreg; }
    __syncthreads();
    { const int tokn = bl * SEQ + (n < 63 ? n + 1 : 63) * 64; HG_LOADS(tokn); }
    float offx = 0.f, offy = 0.f, rx = 0.f, ry = 0.f, bx = 0.f, by = 0.f;
#pragma unroll
    for (int q = 0; q < 8; ++q) {
      const float tx = tot[q * 128 + d0], ty = tot[q * 128 + d0 + 1];
      if (q < w) { offx += tx; offy += ty; }
      if (q < 4) { rx += tx; ry += ty; }
      bx += tx; by += ty;
    }
    if (w == 0) { dec[d0] = __expf(bx); dec[d0 + 1] = __expf(by); }
    unsigned kbx[4], kby[4];
#pragma unroll
    for (int jj = 0; jj < 8; ++jj) {
      const float Bx = offx + px[jj], By = offy + py[jj];
      const float qx = bflo(q2[jj]), qy = bfhi(q2[jj]);
      const float kx = 1.0f - __expf(lx[jj]), ky = 1.0f - __expf(ly[jj]);
      const float e1x = __expf(fminf(fmaxf(Bx - rx, -80.f), 80.f)), e1y = __expf(fminf(fmaxf(By - ry, -80.f), 80.f));
      const float e2x = __expf(fminf(fmaxf(rx - Bx, -80.f), 80.f)), e2y = __expf(fminf(fmaxf(ry - By, -80.f), 80.f));
      const int j = 8 * w + jj;
      *(LAS unsigned*)(lds + QT + j * 272 + d0 * 2) = pk2(qx * e1x, qy * e1y);
      *(LAS unsigned*)(lds + KT + j * 272 + d0 * 2) = pk2(kx * e2x, ky * e2y);
      *(LAS unsigned*)(lds + QB + j * 272 + d0 * 2) = pk2(qx * __expf(Bx), qy * __expf(By));
      const float kbvx = kx * __expf(bx - Bx), kbvy = ky * __expf(by - By);
      if (jj & 1) { kbx[jj >> 1] = pk2(__uint_as_float(kbx[jj >> 1]), kbvx); kby[jj >> 1] = pk2(__uint_as_float(kby[jj >> 1]), kbvy); }
      else { kbx[jj >> 1] = __float_as_uint(kbvx); kby[jj >> 1] = __float_as_uint(kbvy); }
    }
    *(LAS u32x4*)(lds + KBT + d0 * 144 + (8 * w) * 2) = (u32x4){kbx[0], kbx[1], kbx[2], kbx[3]};
    *(LAS u32x4*)(lds + KBT + (d0 + 1) * 144 + (8 * w) * 2) = (u32x4){kby[0], kby[1], kby[2], kby[3]};
    __syncthreads();
    f32x4 oacc = (f32x4){0.f, 0.f, 0.f, 0.f};
#pragma unroll
    for (int jj = 0; jj < 2; ++jj) {
      const int jt = 2 * eh + jj;
      f32x4 sc = (f32x4){0.f, 0.f, 0.f, 0.f};
#pragma unroll
      for (int ks = 0; ks < 4; ++ks) sc = mfma16(ldfrag(lds, KT + (16 * jt + fr) * 272 + (32 * ks + 8 * fq) * 2), ldfrag(lds, QT + (16 * it + fr) * 272 + (32 * ks + 8 * fq) * 2), sc);
      const int i_ = 16 * it + fr, j0 = 16 * jt + 4 * fq;
      u32x2 o; o[0] = pk2(j0 + 0 <= i_ ? sc[0] : 0.f, j0 + 1 <= i_ ? sc[1] : 0.f); o[1] = pk2(j0 + 2 <= i_ ? sc[2] : 0.f, j0 + 3 <= i_ ? sc[3] : 0.f);
      *(LAS u32x2*)(lds + PS + i_ * 144 + j0 * 2) = o;
    }
#pragma unroll
    for (int ks = 0; ks < 4; ++ks) oacc = mfma16(ldfrag(lds, STS + (16 * eh + fr) * 272 + (32 * ks + 8 * fq) * 2), ldfrag(lds, QB + (16 * it + fr) * 272 + (32 * ks + 8 * fq) * 2), oacc);
    {
      const f32x4 dv = *(const LAS f32x4*)(dec + 16 * w + 4 * fq);
#pragma unroll
      for (int et = 0; et < 2; ++et)
#pragma unroll
        for (int r = 0; r < 4; ++r) st[et][r] *= dv[r];
#pragma unroll
      for (int k2 = 0; k2 < 2; ++k2) {
        const bf16x8 kf = ldfrag(lds, KBT + (16 * w + fr) * 144 + (32 * k2 + 8 * fq) * 2);
#pragma unroll
        for (int et = 0; et < 2; ++et) st[et] = mfma16(kf, ldfrag(lds, VTS + (16 * et + fr) * 144 + (32 * k2 + 8 * fq) * 2), st[et]);
      }
    }
    __syncthreads();
    {
      f32x4 o = oacc;
#pragma unroll
      for (int k2 = 0; k2 < 2; ++k2) o = mfma16(ldfrag(lds, VTS + (16 * eh + fr) * 144 + (32 * k2 + 8 * fq) * 2), ldfrag(lds, PS + (16 * it + fr) * 144 + (32 * k2 + 8 * fq) * 2), o);
      float s2 = o[0] * o[0] + o[1] * o[1] + o[2] * o[2] + o[3] * o[3];
      u32x2 ov; ov[0] = pk2(o[0], o[1]); ov[1] = pk2(o[2], o[3]);
      *(u32x2*)obase = ov;
      s2 += shx(s2, 16, lane); s2 += shx(s2, 32, lane);
      if (fq == 0 && do_stats) unsafeAtomicAdd(sbase, s2);
    }
    __syncthreads();
  }
}
#ifndef TSEL
#define TSEL -1
#endif
#ifndef STAGGER_TICKS
#define STAGGER_TICKS 0
#endif
#ifndef REP_RET
#define REP_RET 1
#endif
#ifndef REP_HG
#define REP_HG 1
#endif
#ifndef REP_G1
#define REP_G1 1
#endif
#ifndef REP_G2
#define REP_G2 1
#endif
#ifndef REP_G4
#define REP_G4 1
#endif
#ifndef REP_SYNC
#define REP_SYNC 1
#endif
#ifndef REP_PRO
#define REP_PRO 1
#endif
#ifndef REP_S1
#define REP_S1 1
#endif
enum { ST_G1 = 0, ST_S1, ST_G1B, ST_G2, ST_G3, ST_L1, ST_G4, ST_G5, ST_L2 };
__global__ void __launch_bounds__(512, 2) mega(Params p0) {
  extern __shared__ __attribute__((aligned(16))) unsigned char shm[];
  ldsp lds = (ldsp)shm;
  cg::grid_group grid = cg::this_grid();
  Params p = p0; p.ws = oaddr(p0.ws); p.out = oaddr(p0.out); p.wv = __builtin_amdgcn_readfirstlane((int)(threadIdx.x >> 6));
  volatile LAS unsigned* xst = (volatile LAS unsigned*)(lds + 131072);
  if (threadIdx.x < 4) xst[threadIdx.x] = 0u;
  __syncthreads();
  (void)xcd_barrier_post((unsigned*)(p0.ws + OFF_SMALL + SM_BAR_BYTES), xst);
  for (int r = 0; r < REP_PRO; ++r) {
    p.ws = oaddr(p0.ws);
    phase_mod(lds, p);
    phase_conv(lds, p, 0);
    grid.sync();
  }
  phase_u0(p);
  gbar((unsigned*)(p0.ws + OFF_SMALL + SM_BAR_BYTES), xst);
#if TSEL >= 0
  volatile LAS unsigned* tacc = (volatile LAS unsigned*)(lds + 131072 + 16);
  if (threadIdx.x == 0) tacc[0] = 0u;
#endif
  for (int pc = 0; pc < 28; ++pc) {
#if TSEL >= 0
    if (otid(p.wv) == 0) tacc[1] = (unsigned)__builtin_amdgcn_s_memrealtime();
#endif
    p.ws = oaddr(p0.ws); p.out = oaddr(p0.out);
    const bf16_t* WB = (const bf16_t*)(p.ws + OFF_WB);
    const bf16_t* U = (const bf16_t*)(p.ws + OFF_U);
    unsigned char* R0 = p.ws + OFF_R0;
    const int l = pc / 14, k = pc - l * 14;
    int g = 0, stg;
    if (k < 10) { g = k / 5; stg = k - g * 5; } else stg = ST_L1 + (k - 10);
    int nj = 0, jmode0 = 0, jmode1 = 0; const bf16_t* jA0 = nullptr; const bf16_t* jA1 = nullptr; const bf16_t* jB0 = nullptr; const bf16_t* jB1 = nullptr;
    int jM0 = 0, jM1 = 0, jN0 = 0, jN1 = 0, jK0 = 0, jK1 = 0;
    if (stg == ST_G1) {
      float* stz = (float*)(p.ws + OFF_SMALL) + SM_STR;
      for (int i = obid() * 512 + otid(p.wv); i < TG * 16; i += gridDim.x * 512) stz[i] = 0.f;
      nj = 2;
      jmode0 = MD_G1A; jA0 = U + (size_t)g * TG * 1024; jB0 = WB + W1A; jM0 = TG; jN0 = 4096; jK0 = 1024;
      jmode1 = MD_G1S; jA1 = WB + W1S; jB1 = U + (size_t)g * TG * 1024; jM1 = 3072; jN1 = TG; jK1 = 1024;
    } else if (stg == ST_S1) {
      for (int rep = 0; rep < REP_S1; ++rep) {
        if (rep) { gbar((unsigned*)(p0.ws + OFF_SMALL + SM_BAR_BYTES), xst); float* stz = (float*)(p.ws + OFF_SMALL) + SM_STR; for (int i = obid() * 512 + otid(p.wv); i < TG * 16; i += gridDim.x * 512) stz[i] = 0.f; gbar((unsigned*)(p0.ws + OFF_SMALL + SM_BAR_BYTES), xst); }
        const int bid = obid();
        if (bid < 128) { for (int r2 = 0; r2 < REP_RET; ++r2) ret_item(lds, p, bid, r2 == REP_RET - 1); } else { for (int r2 = 0; r2 < REP_HG; ++r2) hgrn_item(lds, p, bid - 128, r2 == REP_HG - 1); }
      }
    } else if (stg == ST_G1B) {
      nj = 1; jmode0 = MD_G1B; jA0 = U + (size_t)g * TG * 1024; jB0 = WB + W1B; jM0 = TG; jN0 = 5120; jK0 = 1024;
    } else if (stg == ST_G2) {
      nj = 2;
      jmode0 = MD_G2A; jA0 = (const bf16_t*)(R0 + R_ORA); jB0 = WB + WPA; jM0 = TG; jN0 = 1024; jK0 = 1024;
      jmode1 = MD_G2B; jA1 = (const bf16_t*)(R0 + R_ORB); jB1 = WB + WPB; jM1 = TG; jN1 = 1024; jK1 = 2048;
    } else if (stg == ST_G3) {
      nj = 1; jmode0 = MD_G3; jA0 = (const bf16_t*)(R0 + R_MG); jB0 = WB + WO; jM0 = TG; jN0 = 1024; jK0 = 1024;
    } else if (stg == ST_L1) {
      phase_ln(p, p.ln1_g + l * 1024, p.ln1_b + l * 1024, l, 3, false);
    } else if (stg == ST_G4) {
      nj = 1; jmode0 = MD_G4; jA0 = U; jB0 = WB + WUP; jM0 = T_ALL; jN0 = 4096; jK0 = 1024;
    } else if (stg == ST_G5) {
      nj = 1; jmode0 = MD_G5; jA0 = (const bf16_t*)R0; jB0 = WB + WDN; jM0 = T_ALL; jN0 = 1024; jK0 = 4096;
    } else {
      phase_ln(p, p.ln2_g + l * 1024, p.ln2_b + l * 1024, l == 0 ? 1 : 0, 0, l == 1);
      if (l == 0) phase_conv(lds, p, 1);
    }
    for (int j = 0; j < nj * (stg == ST_G4 ? REP_G4 : 1) * (stg == ST_G1 ? REP_G1 : 1) * (stg == ST_G2 ? REP_G2 : 1); ++j) {
      pg8::Gemm gm; const bool j1 = (nj == 2 && (j & 1) == 1); gm.A = j1 ? jA1 : jA0; gm.Bt = j1 ? jB1 : jB0; gm.M = j1 ? jM1 : jM0; gm.N = j1 ? jN1 : jN0; gm.K = j1 ? jK1 : jK0;
      pg8::StaticOrder S; S.init(gm.M, gm.N, (int)gridDim.x, obid());
      EpiP E; E.mode = j1 ? jmode1 : jmode0; E.l = l; E.g = g; E.pp = &p;
#if STAGGER_TICKS > 0
      if (j == 0 && (gm.M >> 8) * (gm.N >> 8) >= 3 * (int)gridDim.x && ((obid() >> 3) & 1)) {
        const unsigned long long t0 = __builtin_amdgcn_s_memrealtime();
        while (__builtin_amdgcn_s_memrealtime() - t0 < (unsigned long long)STAGGER_TICKS) __builtin_amdgcn_s_sleep(32);
      }
#endif
      pg8::gemm_phase<EpiP, pg8::StaticOrder, false>((PG8_LAS unsigned char*)shm, gm, S, E, nullptr);
    }
    for (int r = 0; r < REP_SYNC; ++r) gbar((unsigned*)(p0.ws + OFF_SMALL + SM_BAR_BYTES), xst);
#if TSEL >= 0
    const int k2_ = pc - (pc / 14) * 14, stg2_ = k2_ < 10 ? k2_ % 5 : ST_L1 + (k2_ - 10);
    if (otid(p.wv) == 0 && ((TSEL >> stg2_) & 1)) tacc[0] = tacc[0] + ((unsigned)__builtin_amdgcn_s_memrealtime() - tacc[1]);
#endif
  }
#if TSEL >= 0
  if (obid() == 0 && otid(p.wv) == 0) { const unsigned long long t0 = __builtin_amdgcn_s_memrealtime(); const unsigned long long w = 4ull * tacc[0]; while (__builtin_amdgcn_s_memrealtime() - t0 < w) __builtin_amdgcn_s_sleep(32); }
#endif
}

extern "C" void kernel_launch(void* const* d_in, const int* in_sizes, int n_in, void* d_out, int out_size,
                              void* d_ws, size_t ws_size, hipStream_t stream) {
  constexpr size_t kDynLds = 131072 + 16 + 16;
  static int configured = 0;
  if (!configured) {
    (void)hipFuncSetAttribute((const void*)mega, hipFuncAttributeMaxDynamicSharedMemorySize, (int)kDynLds);
    configured = 1;
  }
  Params p{};
  p.x = (const float*)d_in[0]; p.c = (const float*)d_in[1]; p.pos = (const int*)d_in[2]; p.lb_logits = (const float*)d_in[3];
  p.w_ada = (const float*)d_in[4]; p.b_ada = (const float*)d_in[5]; p.w_in = (const float*)d_in[6]; p.w_pa = (const float*)d_in[7];
  p.w_pb = (const float*)d_in[8]; p.w_o = (const float*)d_in[9]; p.ln1_g = (const float*)d_in[10]; p.ln1_b = (const float*)d_in[11];
  p.w_up = (const float*)d_in[12]; p.b_up = (const float*)d_in[13]; p.w_down = (const float*)d_in[14]; p.b_down = (const float*)d_in[15];
  p.ln2_g = (const float*)d_in[16]; p.ln2_b = (const float*)d_in[17];
  p.out = (float*)d_out; p.ws = (unsigned char*)d_ws;
  if (ws_size < 512ull * 1024 * 1024) { fprintf(stderr, "workspace too small\n"); return; }
  (void)hipMemsetAsync((unsigned char*)d_ws + OFF_SMALL + SM_BAR_BYTES, 0, XCD_BAR_WORDS * 4, stream);
  void* args[] = {&p};
  hipError_t e = hipLaunchCooperativeKernel((void*)mega, dim3(256), dim3(512), args, kDynLds, stream);
  if (e != hipSuccess) fprintf(stderr, "cooperative launch failed: %s\n", hipGetErrorString(e));
}
```

```cpp
#include <hip/hip_runtime.h>
#include <hip/hip_cooperative_groups.h>
#include <cstdio>
namespace cg = cooperative_groups;
__device__ __forceinline__ int otid(int wv) { int t = (wv << 6) | (int)__builtin_amdgcn_mbcnt_hi(~0u, __builtin_amdgcn_mbcnt_lo(~0u, 0u)); asm volatile("" : "+v"(t)); return t; }
__device__ __forceinline__ int obid() { int t = blockIdx.x; asm volatile("" : "+s"(t)); return t; }
template <class T> __device__ __forceinline__ T* oaddr(T* q) { asm volatile("" : "+s"(q)); return q; }
namespace pg8 {
#define PG8_LAS __attribute__((address_space(3)))
typedef unsigned short bf16_t;
typedef short bf16x8 __attribute__((ext_vector_type(8)));
typedef float f32x4 __attribute__((ext_vector_type(4)));
typedef unsigned u32x4 __attribute__((ext_vector_type(4)));
constexpr int BM = 256, BK = 64, HALF = 128, HTB = HALF * BK * 2  , STAGE_BYTES = 8 * HTB, NXCD = 8, WGM = 8;

__host__ __device__ __forceinline__ int lds_byte(int r, int c) { const int st = (r >> 4) * 2 + (c >> 5), rr = r & 15, cc = c & 31, ob = rr * 64 + cc * 2; return st * 1024 + (ob ^ (((ob >> 9) & 1) << 5)); }
__host__ __device__ __forceinline__ void stage_rc(int b, int& R, int& C) { const int st = b / 1024, sb = b % 1024, swz = sb ^ (((sb >> 9) & 1) << 5); R = (st >> 1) * 16 + swz / 64; C = (st & 1) * 32 + (swz % 64) / 2; }
__host__ __device__ __forceinline__ int perm32(int rho) { const int n = rho >> 4, i = rho & 15; return 8 * (i >> 2) + 4 * n + (i & 3); }

struct Unit { int pm, pn; };
struct Gemm { const bf16_t* A; const bf16_t* Bt; int M, N, K; };

struct StaticOrder {
    int nM, nN, nwg, G, c;
    __host__ __device__ void init(int M, int N, int G_, int c_) { nM = M / BM; nN = N / BM; nwg = nM * nN; G = G_; c = c_; }
    __host__ __device__ bool next(int i, Unit& u) const {
        const long L = (long)i * G + c; if (L >= nwg) return false;
        int wgid = (int)L; { const int q = nwg / NXCD, r = nwg % NXCD, xcd = wgid % NXCD, off = wgid / NXCD; wgid = (xcd < r ? xcd * (q + 1) : r * (q + 1) + (xcd - r) * q) + off; }
        const int nig = WGM * nN, gid = wgid / nig, fm = gid * WGM, gsz = (nM - fm) < WGM ? (nM - fm) : WGM;
        u.pm = fm + ((wgid % nig) % gsz); u.pn = (wgid % nig) / gsz; return true;
    }
    __device__ __forceinline__ void a_ready(const Unit&) const {}
    __device__ __forceinline__ void done(const Unit&) const {}
};
__device__ __forceinline__ unsigned cvt_pk_bf16(float lo, float hi) { unsigned r; asm volatile("v_cvt_pk_bf16_f32 %0, %1, %2" : "=v"(r) : "v"(lo), "v"(hi)); return r; }

template <class Epi, class Sched, bool STAMP = false>
__device__ __forceinline__ void gemm_phase(PG8_LAS unsigned char* lds, const Gemm g, const Sched& S, const Epi& E, unsigned long long* stamps) {
    const int tid = otid(E.pp->wv), wid = __builtin_amdgcn_readfirstlane(tid >> 6), lane = tid & 63, wr = wid >> 2, wc = wid & 3, fr = lane & 15, fq = lane >> 4;
    const int K = g.K, nt = K / BK;
    int ts_lo = 0, ts_hi = 0, nts = 0; const unsigned long long rt_entry = STAMP ? (unsigned long long)wall_clock64() : 0ull;
#define PG8_STAMP() do { if (STAMP && wid == 0 && nts < 64) { const unsigned long long _c = (unsigned long long)clock64(); \
        ts_lo = (lane == nts) ? (int)(unsigned)_c : ts_lo; ts_hi = (lane == nts) ? (int)(unsigned)(_c >> 32) : ts_hi; ++nts; } } while (0)
    PG8_STAMP();
    unsigned voffA[2], voffB[2];
#pragma unroll
    for (int i = 0; i < 2; ++i) { int R, C; stage_rc(tid * 16 + i * 8192, R, C); const int Rb = Epi::PERM ? ((R & ~31) + perm32(R & 31)) : R;
        voffA[i] = (unsigned)(R * K + C) * 2u; voffB[i] = (unsigned)(Rb * K + C) * 2u; }
    const size_t kstep = (size_t)(BK * 2);
    const size_t hstep = (size_t)HALF * K * 2;
    const size_t tstep = 2 * hstep;
    const unsigned ldsw = (unsigned)wid * 1024u;
    const int aoff = lds_byte(wr * 64 + fr, fq * 8), boff = lds_byte(wc * 32 + fr, fq * 8);
#define PG8_SA(b, h) (((b) * 2 + (h)) * HTB)
#define PG8_SB(b, h) ((4 + (b) * 2 + (h)) * HTB)
#define PG8_STAGE(bufoff, gbase, voff) do { _Pragma("unroll") for (int _i = 0; _i < 2; ++_i) \
        __builtin_amdgcn_global_load_lds((const unsigned*)((const char*)(gbase) + (voff)[_i]), (PG8_LAS unsigned*)(lds + (bufoff) + ldsw + _i * 8192), 16, 0, 0); } while (0)
#define PG8_LDA(dst, b, h) do { _Pragma("unroll") for (int m = 0; m < 4; ++m) _Pragma("unroll") for (int k = 0; k < 2; ++k) dst[m][k] = *(const PG8_LAS bf16x8*)(lds + PG8_SA(b, h) + aoff + m * 2048 + k * 1024); } while (0)
#define PG8_LDB(dst, b, h) do { _Pragma("unroll") for (int n = 0; n < 2; ++n) _Pragma("unroll") for (int k = 0; k < 2; ++k) dst[n][k] = *(const PG8_LAS bf16x8*)(lds + PG8_SB(b, h) + boff + n * 2048 + k * 1024); } while (0)
#define PG8_MMA(ai, bj, At, Bt) do { __builtin_amdgcn_s_setprio(1); _Pragma("unroll") for (int m = 0; m < 4; ++m) _Pragma("unroll") for (int n = 0; n < 2; ++n) _Pragma("unroll") for (int k = 0; k < 2; ++k) \
        acc[ai][bj][m][n] = __builtin_amdgcn_mfma_f32_16x16x32_bf16(Bt[n][k], At[m][k], acc[ai][bj][m][n], 0, 0, 0); __builtin_amdgcn_s_setprio(0); } while (0)
#define PG8_WAIT_V(n) asm volatile("s_waitcnt vmcnt(" #n ")" ::: "memory")
#define PG8_WAIT_L(n) asm volatile("s_waitcnt lgkmcnt(" #n ")" ::: "memory")
#define PG8_BAR __builtin_amdgcn_s_barrier()
#define PG8_SCHED __builtin_amdgcn_sched_barrier(0)
    Unit cur, nxt; int ui = 0;
    if (!S.next(0, cur)) return;
    f32x4 acc[2][2][4][2];
#pragma unroll
    for (int a = 0; a < 2; ++a)
#pragma unroll
        for (int b = 0; b < 2; ++b)
#pragma unroll
            for (int m = 0; m < 4; ++m)
#pragma unroll
                for (int n = 0; n < 2; ++n) acc[a][b][m][n] = (f32x4){0.f, 0.f, 0.f, 0.f};
    bf16x8 At[4][2], B0[2][2], B1[2][2];
    const char* cA = (const char*)g.A + (size_t)cur.pm * tstep; const char* cB = (const char*)g.Bt + (size_t)cur.pn * tstep;
    S.a_ready(cur);
    PG8_STAGE(PG8_SB(0, 0), cB, voffB); PG8_STAGE(PG8_SA(0, 0), cA, voffA); PG8_STAGE(PG8_SB(0, 1), cB + hstep, voffB); PG8_STAGE(PG8_SA(0, 1), cA + hstep, voffA);
    if (wr == 1) PG8_BAR;
    PG8_WAIT_V(4); PG8_BAR;
    PG8_STAGE(PG8_SB(1, 0), cB + kstep, voffB); PG8_STAGE(PG8_SA(1, 0), cA + kstep, voffA); PG8_STAGE(PG8_SB(1, 1), cB + hstep + kstep, voffB);
    PG8_WAIT_V(6); PG8_BAR;
    PG8_STAMP();
    for (;;) {
        const bool has_next = S.next(ui + 1, nxt);
        const char* nA = has_next ? (const char*)g.A + (size_t)nxt.pm * tstep : cA; const char* nB = has_next ? (const char*)g.Bt + (size_t)nxt.pn * tstep : cB;
        for (int t = 0; t < nt; t += 2) {
            const bool last = (t == nt - 2);
            const char* a1 = cA + (size_t)(t + 1) * kstep;
            const char* a2 = last ? nA : cA + (size_t)(t + 2) * kstep; const char* b2 = last ? nB : cB + (size_t)(t + 2) * kstep;
            const char* a3 = a2 + kstep; const char* b3 = b2 + kstep;
            if (last && has_next) S.a_ready(nxt);
            PG8_LDB(B0, 0, 0); PG8_SCHED; PG8_LDA(At, 0, 0); PG8_STAGE(PG8_SA(1, 1), a1 + hstep, voffA);
            PG8_WAIT_L(8); PG8_BAR; PG8_WAIT_L(0); PG8_MMA(0, 0, At, B0); PG8_BAR; PG8_SCHED;
            PG8_LDB(B1, 0, 1); PG8_STAGE(PG8_SB(0, 0), b2, voffB);
            PG8_BAR; PG8_WAIT_L(0); PG8_MMA(0, 1, At, B1); PG8_BAR;
            PG8_LDA(At, 0, 1); PG8_STAGE(PG8_SA(0, 0), a2, voffA);
            PG8_BAR; PG8_WAIT_L(0); PG8_MMA(1, 0, At, B0); PG8_BAR; PG8_SCHED;
            PG8_STAGE(PG8_SB(0, 1), b2 + hstep, voffB);
            PG8_WAIT_V(6); PG8_BAR; PG8_MMA(1, 1, At, B1); PG8_BAR;
            PG8_LDB(B0, 1, 0); PG8_SCHED; PG8_LDA(At, 1, 0); PG8_STAGE(PG8_SA(0, 1), a2 + hstep, voffA);
            PG8_WAIT_L(8); PG8_BAR; PG8_WAIT_L(0); PG8_MMA(0, 0, At, B0); PG8_BAR; PG8_SCHED;
            PG8_LDB(B1, 1, 1); PG8_STAGE(PG8_SB(1, 0), b3, voffB);
            PG8_BAR; PG8_WAIT_L(0); PG8_MMA(0, 1, At, B1); PG8_BAR;
            PG8_LDA(At, 1, 1); PG8_STAGE(PG8_SA(1, 0), a3, voffA);
            PG8_BAR; PG8_WAIT_L(0); PG8_MMA(1, 0, At, B0); PG8_BAR; PG8_SCHED;
            PG8_STAGE(PG8_SB(1, 1), b3 + hstep, voffB);
            PG8_WAIT_V(6); PG8_BAR; PG8_MMA(1, 1, At, B1); PG8_BAR;
        }
        PG8_STAMP();
        if constexpr (!Epi::AFTER_DRAIN) { E(acc, cur, wr, wc, fr, fq); S.done(cur); }
        PG8_STAMP();
        if (!has_next) break;
#pragma unroll
        for (int a = 0; a < 2; ++a)
#pragma unroll
            for (int b = 0; b < 2; ++b)
#pragma unroll
                for (int m = 0; m < 4; ++m)
#pragma unroll
                    for (int n = 0; n < 2; ++n) acc[a][b][m][n] = (f32x4){0.f, 0.f, 0.f, 0.f};
        cur = nxt; cA = nA; cB = nB; ++ui;
    }
    PG8_WAIT_V(0);
    if (wr == 0) PG8_BAR;
    PG8_BAR;
    if constexpr (Epi::AFTER_DRAIN) { E.fused(acc, cur, wr, wc, fr, fq, lds, wid, lane); S.done(cur); }
    PG8_STAMP();
    if (STAMP && wid == 0) { stamps[lane] = lane < nts ? (((unsigned long long)(unsigned)ts_hi << 32) | (unsigned)ts_lo) : 0ull;
        if (lane == 62) stamps[62] = rt_entry; if (lane == 63) stamps[63] = (unsigned long long)wall_clock64(); }
#undef PG8_STAMP
#undef PG8_SA
#undef PG8_SB
#undef PG8_STAGE
#undef PG8_LDA
#undef PG8_LDB
#undef PG8_MMA
#undef PG8_WAIT_V
#undef PG8_WAIT_L
#undef PG8_BAR
#undef PG8_SCHED
}
}
using pg8::bf16_t; using pg8::bf16x8; using pg8::f32x4; using pg8::u32x4; using pg8::Unit;
typedef unsigned u32x2 __attribute__((ext_vector_type(2)));
#define LAS __attribute__((address_space(3)))
typedef LAS unsigned char* ldsp;

constexpr int T_ALL = 32768, TG = 16384, DM = 1024, SEQ = 4096;
constexpr float ALPHA = 1.4142135623730951f;
constexpr size_t MB = 1024ull * 1024ull;
constexpr size_t OFF_XB = 0, OFF_WB = 128 * MB, OFF_U = 184 * MB, OFF_SMALL = 248 * MB, OFF_R0 = 256 * MB;
constexpr size_t W1A = 0, W1S = W1A + 4096ull * 1024, W1B = W1S + 3072ull * 1024, WPA = W1B + 5120ull * 1024, WPB = WPA + 1024ull * 1024,
                 WO = WPB + 1024ull * 2048, WUP = WO + 1024ull * 1024, WDN = WUP + 4096ull * 1024, W_END = WDN + 4096ull * 1024;
static_assert(W_END * 2 <= 56 * MB, "weights");
constexpr size_t SM_MOD = 0  , SM_LB = 2 * 8 * 6144  , SM_STR = SM_LB + 2048  , SM_STH = SM_STR + (size_t)TG * 8  , SM_END = SM_STH + (size_t)TG * 8;
constexpr size_t SM_BAR_BYTES = 7 * MB;
static_assert(SM_END * 4 <= 7 * MB, "small");
constexpr size_t R_QH = 0, R_VIT = 32 * MB, R_QR = 64 * MB, R_KR = 96 * MB, R_KRT = 128 * MB, R_ORA = 160 * MB, R_ORB = 192 * MB;
constexpr size_t R_SGA = R_QH, R_SGB = R_VIT, R_M1 = R_QR, R_MG = R_KRT;
constexpr size_t D_LF = 0, D_VRT = 64 * MB;

struct Params {
  const float* x; const float* c; const int* pos; const float* lb_logits; const float* w_ada; const float* b_ada; const float* w_in; const float* w_pa; const float* w_pb;
  const float* w_o; const float* ln1_g; const float* ln1_b; const float* w_up; const float* b_up; const float* w_down; const float* b_down; const float* ln2_g; const float* ln2_b;
  float* out; unsigned char* ws; int wv; int pad;
};

__device__ __forceinline__ float bf2f(unsigned short b) { return __uint_as_float(((unsigned)b) << 16); }
__device__ __forceinline__ float bflo(unsigned u) { return __uint_as_float(u << 16); }
__device__ __forceinline__ float bfhi(unsigned u) { return __uint_as_float(u & 0xffff0000u); }
typedef float f32x2_ __attribute__((ext_vector_type(2)));
typedef __bf16 bf16x2_ __attribute__((ext_vector_type(2)));
__device__ __forceinline__ unsigned pk2(float lo, float hi) { const f32x2_ v = {lo, hi}; const bf16x2_ b = __builtin_convertvector(v, bf16x2_); return __builtin_bit_cast(unsigned, b); }
__device__ __forceinline__ float sigmoidf_(float v) { return __builtin_amdgcn_rcpf(1.0f + __expf(-v)); }
__device__ __forceinline__ float siluf_(float v) { return v * sigmoidf_(v); }
__device__ __forceinline__ f32x4 mfma16(bf16x8 a, bf16x8 b, f32x4 c) { return __builtin_amdgcn_mfma_f32_16x16x32_bf16(a, b, c, 0, 0, 0); }
__device__ __forceinline__ bf16x8 ldfrag(ldsp base, int off) { return *(const LAS bf16x8*)(base + off); }
__device__ __forceinline__ float shx(float v, int mask, int lane) { return __int_as_float(__builtin_amdgcn_ds_bpermute((lane ^ mask) << 2, __float_as_int(v))); }
__device__ __forceinline__ float wave_sum(float v, int lane) {
#pragma unroll
  for (int o = 32; o > 0; o >>= 1) v += shx(v, o, lane);
  return v;
}

#ifdef USE_NT
#define NTS(val, ptr) __builtin_nontemporal_store((val), (ptr))
#else
#define NTS(val, ptr) (*(ptr) = (val))
#endif
enum { MD_G1A = 0, MD_G1S, MD_G1B, MD_G2A, MD_G2B, MD_G3, MD_G4, MD_G5 };
struct RowBuf { u32x4 a[2]; f32x4 b0[2], b1[2]; f32x4 s[2]; int pi; };
struct UnitBuf { f32x4 c0[2], c1[2], d0[2], d1[2]; };
struct EpiP {
  static constexpr bool PERM = true, AFTER_DRAIN = false;
  int mode, l, g;
  const Params* pp;
  template <int MODE> __device__ __forceinline__ void unitload(UnitBuf& ub, const Unit& u, int wc, int fq) const {
    const Params& p = *pp;
    const float* small = (const float*)(p.ws + OFF_SMALL);
    const float* mod = small + SM_MOD + (size_t)l * 8 * 6144;
#pragma unroll
    for (int bj = 0; bj < 2; ++bj) {
      const int col = u.pn * 256 + bj * 128 + wc * 32 + 8 * fq;
      if constexpr (MODE == MD_G1A) {
        if ((col >> 10) == 1) { const float* lbp = small + SM_LB + l * 1024 + (col & 1023); ub.c0[bj] = *(const f32x4*)lbp; ub.c1[bj] = *(const f32x4*)(lbp + 4); }
      } else if constexpr (MODE == MD_G3) {
        const int b = (g * TG + u.pm * 256) >> 12; const float* gt = mod + (size_t)b * 6144 + 2 * 1024 + col;
        ub.c0[bj] = *(const f32x4*)gt; ub.c1[bj] = *(const f32x4*)(gt + 4);
      } else if constexpr (MODE == MD_G4) {
        const float* bp = p.b_up + (size_t)l * 4096 + col; ub.c0[bj] = *(const f32x4*)bp; ub.c1[bj] = *(const f32x4*)(bp + 4);
      } else if constexpr (MODE == MD_G5) {
        const int b = (u.pm * 256) >> 12; const float* gt = mod + (size_t)b * 6144 + 5 * 1024 + col; const float* bp = p.b_down + (size_t)l * 1024 + col;
        ub.c0[bj] = *(const f32x4*)gt; ub.c1[bj] = *(const f32x4*)(gt + 4); ub.d0[bj] = *(const f32x4*)bp; ub.d1[bj] = *(const f32x4*)(bp + 4);
      }
    }
  }
  template <int MODE, int ai, int m, int PH> __device__ __forceinline__ void rowf(const f32x4 (&acc)[2][2][4][2], RowBuf& rb, const UnitBuf& ub, const Unit& u, int wr, int wc, int fr, int fq) const {
    if constexpr (PH == 0 && MODE == MD_G1A) { if ((u.pn >> 2) >= 2) rb.pi = pp->pos[g * TG + u.pm * 256 + ai * 128 + wr * 64 + m * 16 + fr]; }
    cell<MODE, ai, m, PH, 0>(acc, rb, ub, u, wr, wc, fr, fq);
    cell<MODE, ai, m, PH, 1>(acc, rb, ub, u, wr, wc, fr, fq);
  }
  template <int MODE, int ai, int m, int PH, int bj> __device__ __forceinline__ void cell(const f32x4 (&acc)[2][2][4][2], RowBuf& rb, const UnitBuf& ub, const Unit& u, int wr, int wc, int fr, int fq) const {
    const Params& p = *pp;
    unsigned char* R0 = p.ws + OFF_R0; unsigned char* DO = (unsigned char*)p.out;
    float* small = (float*)(p.ws + OFF_SMALL);
    const int row = u.pm * 256 + ai * 128 + wr * 64 + m * 16 + fr;
    {
      const int col = u.pn * 256 + bj * 128 + wc * 32 + 8 * fq;
      float v[8];
#pragma unroll
      for (int i = 0; i < 4; ++i) { v[i] = acc[ai][bj][m][0][i]; v[4 + i] = acc[ai][bj][m][1][i]; }
      if constexpr (MODE == MD_G1A) {
        if constexpr (PH == 1) {
          const int sec = col >> 10, cs = col & 1023;
          if (sec == 0) {
            u32x4 o;
#pragma unroll
            for (int i = 0; i < 4; ++i) o[i] = pk2(siluf_(v[2 * i]), siluf_(v[2 * i + 1]));
            *(u32x4*)(R0 + R_QH + ((size_t)row * 1024 + cs) * 2) = o;
          } else if (sec == 1) {
            float o[8];
            if (l == 0) {
#pragma unroll
              for (int i = 0; i < 8; ++i) { const float z = v[i]; o[i] = fminf(z, 0.f) - __logf(1.0f + __expf(-fabsf(z))); }
            } else {
#pragma unroll
              for (int i = 0; i < 8; ++i) {
                const float lbv = i < 4 ? ub.c0[bj][i & 3] : ub.c1[bj][i & 3];
                const float z = v[i], e = __expf(-fabsf(z)), r = __builtin_amdgcn_rcpf(1.0f + e);
                const float sg = z >= 0.f ? r : e * r;
                o[i] = __logf(lbv + (1.f - lbv) * sg);
              }
            }
            float* dst = (float*)(DO + D_LF) + (size_t)row * 1024 + cs;
            *(f32x4*)dst = (f32x4){o[0], o[1], o[2], o[3]}; *(f32x4*)(dst + 4) = (f32x4){o[4], o[5], o[6], o[7]};
          } else {
            const float posf = (float)rb.pi;
            const float sc = sec == 3 ? 0.0625f : 1.0f;
            const int p0 = (cs & 255) >> 1;
            u32x4 o;
#pragma unroll
            for (int i = 0; i < 4; ++i) {
              const float theta = __builtin_amdgcn_exp2f(-13.287712379549449f * (float)(p0 + i) * (1.0f / 127.0f));
              float rev = posf * theta * 0.15915494309189535f; rev -= floorf(rev);
              const float sn = __builtin_amdgcn_sinf(rev), cn = __builtin_amdgcn_cosf(rev);
              const float t1 = v[2 * i], t2 = v[2 * i + 1];
              o[i] = pk2((t1 * cn - t2 * sn) * sc, (t1 * sn + t2 * cn) * sc);
            }
            *(u32x4*)(R0 + (sec == 2 ? R_QR : R_KR) + ((size_t)row * 1024 + cs) * 2) = o;
          }
        }
      } else if constexpr (MODE == MD_G1S) {
        if constexpr (PH == 1) {
          if ((row >> 10) == 0) {
            u32x4 o;
#pragma unroll
            for (int i = 0; i < 4; ++i) o[i] = pk2(v[2 * i], v[2 * i + 1]);
            *(u32x4*)(R0 + R_VIT + ((size_t)row * TG + col) * 2) = o;
          } else {
            const int f = row - 1024, h = (u.pm * 256 - 1024) >> 9;
            const float lg2 = __log2f(1.0f - __builtin_amdgcn_exp2f(-5.0f - (float)h));
            u32x4 ov;
#pragma unroll
            for (int i = 0; i < 4; ++i) ov[i] = pk2(v[2 * i] * __builtin_amdgcn_exp2f(lg2 * (float)(63 - ((col + 2 * i) & 63))), v[2 * i + 1] * __builtin_amdgcn_exp2f(lg2 * (float)(63 - ((col + 2 * i + 1) & 63))));
            *(u32x4*)(DO + D_VRT + ((size_t)f * TG + col) * 2) = ov;
          }
        }
      } else if constexpr (MODE == MD_G1B) {
        const int sec = col >> 10, cs = col & 1023;
        if (sec == 0) {
          u32x4* ptr = (u32x4*)(R0 + R_ORA + ((size_t)row * 1024 + cs) * 2);
          if constexpr (PH == 0) { rb.a[bj] = *ptr; rb.s[bj][0] = (small + SM_STH)[(size_t)row * 8 + (cs >> 7)]; }
          else {
            const float rstd = rsqrtf(rb.s[bj][0] * (1.0f / 128.0f) + 1e-6f);
            const u32x4 ov = rb.a[bj]; u32x4 o;
#pragma unroll
            for (int i = 0; i < 4; ++i) o[i] = pk2(bflo(ov[i]) * rstd * siluf_(v[2 * i]), bfhi(ov[i]) * rstd * siluf_(v[2 * i + 1]));
            *ptr = o;
          }
        } else if (sec < 3) {
          const int c2 = col - 1024;
          u32x4* ptr = (u32x4*)(R0 + R_ORB + ((size_t)row * 2048 + c2) * 2);
          if constexpr (PH == 0) { const float* st = small + SM_STR + ((size_t)row * 4 + (c2 >> 9)) * 2; rb.a[bj] = *ptr; rb.s[bj][0] = st[0]; rb.s[bj][1] = st[1]; }
          else {
            const float mean = rb.s[bj][0] * (1.0f / 512.0f);
            const float var = fmaxf(rb.s[bj][1] * (1.0f / 512.0f) - mean * mean, 0.f);
            const float rstd = rsqrtf(var + 1e-6f);
            const u32x4 ov = rb.a[bj]; u32x4 o;
#pragma unroll
            for (int i = 0; i < 4; ++i) o[i] = pk2((bflo(ov[i]) - mean) * rstd * siluf_(v[2 * i]), (bfhi(ov[i]) - mean) * rstd * siluf_(v[2 * i + 1]));
            *ptr = o;
          }
        } else {
          if constexpr (PH == 1) {
            u32x4 o;
#pragma unroll
            for (int i = 0; i < 4; ++i) o[i] = pk2(sigmoidf_(v[2 * i]), sigmoidf_(v[2 * i + 1]));
            *(u32x4*)(R0 + (sec == 3 ? R_SGA : R_SGB) + ((size_t)row * 1024 + cs) * 2) = o;
          }
        }
      } else if constexpr (MODE == MD_G2A) {
        if constexpr (PH == 0) rb.a[bj] = *(const u32x4*)(R0 + R_SGA + ((size_t)row * 1024 + col) * 2);
        else {
          const u32x4 gv = rb.a[bj];
          float* dst = (float*)(R0 + R_M1) + (size_t)row * 1024 + col;
          *(f32x4*)dst = (f32x4){bflo(gv[0]) * v[0], bfhi(gv[0]) * v[1], bflo(gv[1]) * v[2], bfhi(gv[1]) * v[3]};
          *(f32x4*)(dst + 4) = (f32x4){bflo(gv[2]) * v[4], bfhi(gv[2]) * v[5], bflo(gv[3]) * v[6], bfhi(gv[3]) * v[7]};
        }
      } else if constexpr (MODE == MD_G2B) {
        if constexpr (PH == 0) {
          rb.a[bj] = *(const u32x4*)(R0 + R_SGB + ((size_t)row * 1024 + col) * 2);
          const float* src = (const float*)(R0 + R_M1) + (size_t)row * 1024 + col;
          rb.b0[bj] = *(const f32x4*)src; rb.b1[bj] = *(const f32x4*)(src + 4);
        } else {
          const u32x4 gv = rb.a[bj]; const f32x4 m0 = rb.b0[bj], m1 = rb.b1[bj];
          u32x4 o;
          o[0] = pk2(m0[0] + bflo(gv[0]) * v[0], m0[1] + bfhi(gv[0]) * v[1]);
          o[1] = pk2(m0[2] + bflo(gv[1]) * v[2], m0[3] + bfhi(gv[1]) * v[3]);
          o[2] = pk2(m1[0] + bflo(gv[2]) * v[4], m1[1] + bfhi(gv[2]) * v[5]);
          o[3] = pk2(m1[2] + bflo(gv[3]) * v[6], m1[3] + bfhi(gv[3]) * v[7]);
          *(u32x4*)(R0 + R_MG + ((size_t)row * 1024 + col) * 2) = o;
        }
      } else if constexpr (MODE == MD_G3) {
        const int tg = g * TG + row;
        if constexpr (PH == 0) {
          const float* xin = (l == 0 ? p.x : (const float*)(p.ws + OFF_XB)) + (size_t)tg * 1024 + col;
          rb.b0[bj] = *(const f32x4*)xin; rb.b1[bj] = *(const f32x4*)(xin + 4);
        } else {
          float* dst = (float*)(p.ws + OFF_XB) + (size_t)tg * 1024 + col;
          f32x4 o0, o1;
#pragma unroll
          for (int i = 0; i < 4; ++i) { o0[i] = ALPHA * rb.b0[bj][i] + (1.f + ub.c0[bj][i]) * v[i]; o1[i] = ALPHA * rb.b1[bj][i] + (1.f + ub.c1[bj][i]) * v[4 + i]; }
          *(f32x4*)dst = o0; *(f32x4*)(dst + 4) = o1;
        }
      } else if constexpr (MODE == MD_G4) {
        if constexpr (PH == 1) {
          float o[8];
#pragma unroll
          for (int i = 0; i < 8; ++i) { const float hh = fmaxf(v[i] + (i < 4 ? ub.c0[bj][i & 3] : ub.c1[bj][i & 3]), 0.f); o[i] = hh * hh; }
          u32x4 ov;
#pragma unroll
          for (int i = 0; i < 4; ++i) ov[i] = pk2(o[2 * i], o[2 * i + 1]);
          *(u32x4*)(R0 + ((size_t)row * 4096 + col) * 2) = ov;
        }
      } else if constexpr (MODE == MD_G5) {
        float* dst = (float*)(p.ws + OFF_XB) + (size_t)row * 1024 + col;
        if constexpr (PH == 0) { rb.b0[bj] = *(const f32x4*)dst; rb.b1[bj] = *(const f32x4*)(dst + 4); }
        else {
          f32x4 o0, o1;
#pragma unroll
          for (int i = 0; i < 4; ++i) { o0[i] = ALPHA * rb.b0[bj][i] + (1.f + ub.c0[bj][i]) * (v[i] + ub.d0[bj][i]); o1[i] = ALPHA * rb.b1[bj][i] + (1.f + ub.c1[bj][i]) * (v[4 + i] + ub.d1[bj][i]); }
          *(f32x4*)dst = o0; *(f32x4*)(dst + 4) = o1;
        }
      }
    }
  }
  template <int MODE> __device__ __forceinline__ void run(const f32x4 (&acc)[2][2][4][2], const Unit& u, int wr, int wc, int fr, int fq) const {
    UnitBuf ub; unitload<MODE>(ub, u, wc, fq);
#define RB2(AI, M0, M1) { RowBuf r0, r1; \
      rowf<MODE, AI, M0, 0>(acc, r0, ub, u, wr, wc, fr, fq); rowf<MODE, AI, M1, 0>(acc, r1, ub, u, wr, wc, fr, fq); \
      rowf<MODE, AI, M0, 1>(acc, r0, ub, u, wr, wc, fr, fq); rowf<MODE, AI, M1, 1>(acc, r1, ub, u, wr, wc, fr, fq); }
    RB2(0, 0, 1) RB2(0, 2, 3) RB2(1, 0, 1) RB2(1, 2, 3)
#undef RB2
  }
  __device__ __forceinline__ void operator()(const f32x4 (&acc)[2][2][4][2], const Unit& u, int wr, int wc, int fr, int fq) const {
    asm volatile("" : "+v"(fr), "+v"(fq));
    switch (mode) {
      case MD_G1A: run<MD_G1A>(acc, u, wr, wc, fr, fq); break;
      case MD_G1S: run<MD_G1S>(acc, u, wr, wc, fr, fq); break;
      case MD_G1B: run<MD_G1B>(acc, u, wr, wc, fr, fq); break;
      case MD_G2A: run<MD_G2A>(acc, u, wr, wc, fr, fq); break;
      case MD_G2B: run<MD_G2B>(acc, u, wr, wc, fr, fq); break;
      case MD_G3: run<MD_G3>(acc, u, wr, wc, fr, fq); break;
      case MD_G4: run<MD_G4>(acc, u, wr, wc, fr, fq); break;
      default: run<MD_G5>(acc, u, wr, wc, fr, fq); break;
    }
  }
};
#define XB_TMO      128
#define XB_XCNT(j)  (256  + 64 * (j))
#define XB_XSUB(j)  (1280 + 64 * (j))
#define XB_XGEN(j)  (2304 + 64 * (j))
#define XB_TOP      3328
#define XB_TOPGEN   3392
#define XCD_BAR_WORDS 3456
#define XB_SPIN_CAP (1u << 18)

__device__ __forceinline__ unsigned xb_ld(unsigned* p)              { return __hip_atomic_load(p, __ATOMIC_RELAXED, __HIP_MEMORY_SCOPE_AGENT); }
__device__ __forceinline__ unsigned xb_add(unsigned* p, unsigned v) { return __hip_atomic_fetch_add(p, v, __ATOMIC_RELAXED, __HIP_MEMORY_SCOPE_AGENT); }
__device__ __forceinline__ unsigned xb_xcc_id() { return (unsigned)__builtin_amdgcn_s_getreg((3 << 11) | 20) & 0xFu; }
#define XB_SPIN(cond, bar) do { unsigned _sp = 0; while (cond) { __builtin_amdgcn_s_sleep(1); \
    if ((++_sp & 255u) == 0u) { if (xb_ld(&(bar)[XB_TMO])) break; if (_sp > XB_SPIN_CAP) { atomicAdd(&(bar)[XB_TMO], 1u); break; } } } } while (0)

struct XcdBarrier {
    unsigned* bar; unsigned x;
    volatile LAS unsigned* st;
};

__device__ __forceinline__ XcdBarrier xcd_barrier_post(unsigned* bar, volatile LAS unsigned* st) {
    XcdBarrier b; b.bar = bar; b.x = xb_xcc_id(); b.st = st;
    if (threadIdx.x == 0) (void)xb_add(&bar[XB_XCNT(b.x)], 1u);
    return b;
}
__device__ __forceinline__ void xcd_barrier_complete(unsigned* bar, unsigned x, unsigned& nloc, unsigned& nx) {
    const unsigned G = gridDim.x * gridDim.y * gridDim.z;
    unsigned sum, cnt, mine, sp = 0u;
    for (;;) {
        sum = 0u; cnt = 0u; mine = 0u;
#pragma unroll
        for (unsigned j = 0; j < 16; ++j) { const unsigned c = xb_ld(&bar[XB_XCNT(j)]); sum += c; cnt += (c > 0u) ? 1u : 0u; mine = (j == x) ? c : mine; }
        if (sum == G) break;
        __builtin_amdgcn_s_sleep(1);
        if ((++sp & 255u) == 0u) { if (xb_ld(&bar[XB_TMO])) break; if (sp > XB_SPIN_CAP) { atomicAdd(&bar[XB_TMO], 1u); break; } }
    }
    nloc = mine > 0u ? mine : 1u; nx = cnt > 0u ? cnt : 1u;
}

__device__ __forceinline__ void xcd_barrier(const XcdBarrier& b) {
    asm volatile("s_waitcnt vmcnt(0)" ::: "memory");
    __syncthreads();
    if (threadIdx.x == 0) {
        unsigned* bar = b.bar;
        __builtin_amdgcn_s_waitcnt(0);
        unsigned nloc = b.st[0], nx = b.st[1];
        if (nloc == 0u) { xcd_barrier_complete(bar, b.x, nloc, nx); b.st[0] = nloc; b.st[1] = nx; }
        const unsigned old = xb_add(&bar[XB_XSUB(b.x)], 1u);
        const unsigned gen = old / nloc;
        if (old + 1u == (gen + 1u) * nloc) {
            __builtin_amdgcn_fence(__ATOMIC_RELEASE, "agent");
            asm volatile("s_waitcnt vmcnt(0)" ::: "memory");
            const unsigned og = xb_add(&bar[XB_TOP], 1u);
            const unsigned tg = og / nx;
            if (og + 1u == (tg + 1u) * nx) xb_add(&bar[XB_TOPGEN], 1u);
            else XB_SPIN(xb_ld(&bar[XB_TOPGEN]) == tg, bar);
            __builtin_amdgcn_fence(__ATOMIC_ACQUIRE, "agent");
            xb_add(&bar[XB_XGEN(b.x)], 1u);
            asm volatile("s_waitcnt vmcnt(0)" ::: "memory");
        } else {
            XB_SPIN(xb_ld(&bar[XB_XGEN(b.x)]) == gen, bar);
            __builtin_amdgcn_fence(__ATOMIC_ACQUIRE, "agent");
            asm volatile("s_waitcnt vmcnt(0)" ::: "memory");
        }
    }
    __syncthreads();
}

__device__ __forceinline__ void gbar(unsigned* bar0, volatile LAS unsigned* st) {
    XcdBarrier b; b.bar = bar0; asm volatile("" : "+s"(b.bar)); b.x = (unsigned)__builtin_amdgcn_readfirstlane((int)xb_xcc_id()); asm volatile("" : "+s"(b.x)); b.st = st; xcd_barrier(b);
}
__device__ __forceinline__ void conv_job(ldsp lds, int wv, const float* src, int ld, int K, int c0, int ncols, bf16_t* dst) {
  LAS float* tile = (LAS float*)lds;
  const int tid = otid(wv), ntk = K >> 6, ntn = ncols >> 6, nt = ntk * ntn;
  const int rr = tid >> 6, cc = tid & 63, kp = tid & 31, nn = tid >> 5;
  int t = obid();
  float reg[8];
  if (t < nt) { const int tk = t / ntn, tn = t - tk * ntn;
#pragma unroll
    for (int i = 0; i < 8; ++i) reg[i] = src[(size_t)((tk << 6) + i * 8 + rr) * ld + c0 + (tn << 6) + cc]; }
  for (; t < nt; t += gridDim.x) {
    const int tk = t / ntn, tn = t - tk * ntn, k0 = tk << 6, n0 = tn << 6;
    __syncthreads();
#pragma unroll
    for (int i = 0; i < 8; ++i) tile[(i * 8 + rr) * 65 + cc] = reg[i];
    __syncthreads();
    const int t2 = t + gridDim.x;
    if (t2 < nt) { const int tk2 = t2 / ntn, tn2 = t2 - tk2 * ntn;
#pragma unroll
      for (int i = 0; i < 8; ++i) reg[i] = src[(size_t)((tk2 << 6) + i * 8 + rr) * ld + c0 + (tn2 << 6) + cc]; }
#pragma unroll
    for (int i = 0; i < 4; ++i) { const int n = nn + 16 * i; *(unsigned*)(dst + (size_t)(n0 + n) * K + k0 + 2 * kp) = pk2(tile[(2 * kp) * 65 + n], tile[(2 * kp + 1) * 65 + n]); }
  }
  __syncthreads();
}
__device__ __forceinline__ void phase_conv(ldsp lds, const Params& p, int l) {
  bf16_t* WB = (bf16_t*)(p.ws + OFF_WB);
  const float* win = p.w_in + (size_t)l * 1024 * 12288;
  conv_job(lds, p.wv, win, 12288, 1024, 0, 1024, WB + W1A);
  conv_job(lds, p.wv, win, 12288, 1024, 1024, 1024, WB + W1A + 1024ull * 1024);
  conv_job(lds, p.wv, win, 12288, 1024, 4096, 2048, WB + W1A + 2048ull * 1024);
  conv_job(lds, p.wv, win, 12288, 1024, 2048, 1024, WB + W1S);
  conv_job(lds, p.wv, win, 12288, 1024, 6144, 2048, WB + W1S + 1024ull * 1024);
  conv_job(lds, p.wv, win, 12288, 1024, 3072, 1024, WB + W1B);
  conv_job(lds, p.wv, win, 12288, 1024, 8192, 4096, WB + W1B + 1024ull * 1024);
  conv_job(lds, p.wv, p.w_pa + (size_t)l * 1024 * 1024, 1024, 1024, 0, 1024, WB + WPA);
  conv_job(lds, p.wv, p.w_pb + (size_t)l * 2048 * 1024, 1024, 2048, 0, 1024, WB + WPB);
  conv_job(lds, p.wv, p.w_o + (size_t)l * 1024 * 1024, 1024, 1024, 0, 1024, WB + WO);
  conv_job(lds, p.wv, p.w_up + (size_t)l * 1024 * 4096, 4096, 1024, 0, 4096, WB + WUP);
  conv_job(lds, p.wv, p.w_down + (size_t)l * 4096 * 1024, 1024, 4096, 0, 1024, WB + WDN);
}
__device__ __forceinline__ void phase_mod(ldsp lds, const Params& p) {
  float* small = (float*)(p.ws + OFF_SMALL);
  const int tid = otid(p.wv);
  const int bid = obid();
  if (bid < 192) {
    LAS float* cond = (LAS float*)lds;
    LAS float* part = (LAS float*)(lds + 32768);
    for (int i = tid; i < 8192; i += 512) cond[i] = siluf_(p.c[i]);
    __syncthreads();
    const int o0 = bid * 64, l = o0 / 6144, n0 = o0 - l * 6144, nl = tid & 63, kq = tid >> 6;
    const float* w = p.w_ada + (size_t)l * 1024 * 6144 + n0 + nl + (size_t)(kq * 128) * 6144;
    float a[8];
#pragma unroll
    for (int b = 0; b < 8; ++b) a[b] = 0.f;
#pragma unroll 8
    for (int k = 0; k < 128; ++k) {
      const float wv = w[(size_t)k * 6144];
#pragma unroll
      for (int b = 0; b < 8; ++b) a[b] += cond[b * 1024 + kq * 128 + k] * wv;
    }
#pragma unroll
    for (int b = 0; b < 8; ++b) part[(kq * 8 + b) * 64 + nl] = a[b];
    __syncthreads();
    {
      const int b = tid >> 6; float s = 0.f;
#pragma unroll
      for (int q = 0; q < 8; ++q) s += part[(q * 8 + b) * 64 + nl];
      small[SM_MOD + (size_t)l * 8 * 6144 + b * 6144 + n0 + nl] = s + p.b_ada[l * 6144 + n0 + nl];
    }
    __syncthreads();
  } else if (bid == 192) {
    for (int i = tid; i < 1024; i += 512) {
      const float a = p.lb_logits[i], b = p.lb_logits[1024 + i], mx = fmaxf(a, b);
      const float ea = __expf(a - mx), eb = __expf(b - mx);
      small[SM_LB + i] = 0.f; small[SM_LB + 1024 + i] = eb / (ea + eb);
    }
  }
}
__device__ __forceinline__ void phase_u0(const Params& p) {
  const float* mod = (const float*)(p.ws + OFF_SMALL) + SM_MOD;
  bf16_t* U = (bf16_t*)(p.ws + OFF_U);
  const size_t n4 = (size_t)T_ALL * 1024 / 4;
  for (size_t i = (size_t)obid() * 512 + otid(p.wv); i < n4; i += (size_t)gridDim.x * 512) {
    const size_t e = i * 4; const int t = (int)(e >> 10), cc = (int)(e & 1023), b = t >> 12;
    const f32x4 xv = *(const f32x4*)(p.x + e), sh = *(const f32x4*)(mod + b * 6144 + cc), sc = *(const f32x4*)(mod + b * 6144 + 1024 + cc);
    u32x2 o; o[0] = pk2(xv[0] * (1.f + sc[0]) + sh[0], xv[1] * (1.f + sc[1]) + sh[1]); o[1] = pk2(xv[2] * (1.f + sc[2]) + sh[2], xv[3] * (1.f + sc[3]) + sh[3]);
    *(u32x2*)(U + e) = o;
  }
}
__device__ __forceinline__ void phase_ln(const Params& p, const float* gam, const float* bet, int lm, int s_shift, bool fin) {
  float* XB = (float*)(p.ws + OFF_XB);
  const float* mod = (const float*)(p.ws + OFF_SMALL) + SM_MOD + (size_t)lm * 8 * 6144;
  bf16_t* U = (bf16_t*)(p.ws + OFF_U);
  const int tid_ = otid(p.wv); const int lane = tid_ & 63, gw = obid() * 8 + (tid_ >> 6), nw = gridDim.x * 8;
  for (int row = gw; row < T_ALL; row += nw) {
    const float* src = XB + (size_t)row * 1024;
    f32x4 v[4]; float s = 0.f;
#pragma unroll
    for (int k = 0; k < 4; ++k) { v[k] = *(const f32x4*)(src + 256 * k + 4 * lane); s += v[k][0] + v[k][1] + v[k][2] + v[k][3]; }
    const float mu = wave_sum(s, lane) * (1.0f / 1024.0f);
    float q = 0.f;
#pragma unroll
    for (int k = 0; k < 4; ++k)
#pragma unroll
      for (int i = 0; i < 4; ++i) { const float d = v[k][i] - mu; q += d * d; }
    const float rstd = rsqrtf(wave_sum(q, lane) * (1.0f / 1024.0f) + 1e-5f);
    const int b = row >> 12;
#pragma unroll
    for (int k = 0; k < 4; ++k) {
      const int cc = 256 * k + 4 * lane;
      const f32x4 gg = *(const f32x4*)(gam + cc), bb = *(const f32x4*)(bet + cc);
      f32x4 y;
#pragma unroll
      for (int i = 0; i < 4; ++i) y[i] = (v[k][i] - mu) * rstd * gg[i] + bb[i];
      if (fin) { *(f32x4*)(p.out + (size_t)row * 1024 + cc) = y; }
      else {
        *(f32x4*)(XB + (size_t)row * 1024 + cc) = y;
        const f32x4 sh = *(const f32x4*)(mod + b * 6144 + s_shift * 1024 + cc), sc = *(const f32x4*)(mod + b * 6144 + (s_shift + 1) * 1024 + cc);
        u32x2 o; o[0] = pk2(y[0] * (1.f + sc[0]) + sh[0], y[1] * (1.f + sc[1]) + sh[1]); o[1] = pk2(y[2] * (1.f + sc[2]) + sh[2], y[3] * (1.f + sc[3]) + sh[3]);
        *(u32x2*)(U + (size_t)row * 1024 + cc) = o;
      }
    }
  }
}
typedef short s16x4 __attribute__((ext_vector_type(4)));
template <class T> __device__ __forceinline__ T* vaddr(T* q) { asm volatile("" : "+v"(q)); return q; }
__device__ __forceinline__ void ret_item(ldsp lds, const Params& p, int item, bool do_stats) {
  constexpr int KS = 0, VTS = 33792, STS = 43008, PS = 76800;
  const int es = item & 7, h = (item >> 3) & 3, bl = item >> 5;
  const int tid = otid(p.wv), w = tid >> 6, lane = tid & 63, fr = lane & 15, fq = lane >> 4;
  unsigned char* R0 = oaddr(p.ws) + OFF_R0; unsigned char* DO = (unsigned char*)oaddr(p.out);
  const bf16_t* Qr = (const bf16_t*)(R0 + R_QR); const bf16_t* Kr = (const bf16_t*)(R0 + R_KR);
  const bf16_t* VrT = (const bf16_t*)(DO + D_VRT); bf16_t* OrB = (bf16_t*)(R0 + R_ORB);
  float* stR = (float*)(p.ws + OFF_SMALL) + SM_STR;
  const float gam = 1.0f - __builtin_amdgcn_exp2f(-5.0f - (float)h), lg2 = __log2f(gam), g64 = __builtin_amdgcn_exp2f(lg2 * 64.0f);
  const int it = w >> 1, eh = w & 1;
  f32x4 st[2][4];
#pragma unroll
  for (int a = 0; a < 2; ++a)
#pragma unroll
    for (int b = 0; b < 4; ++b) st[a][b] = (f32x4){0.f, 0.f, 0.f, 0.f};
  const float rowscale = __builtin_amdgcn_exp2f(lg2 * (float)(16 * it + fr - 63));
  u32x4 kreg[4], vtreg; bf16x8 qn[8];
#define RET_LOADS(TOK) do { \
    const bf16_t* kbase = vaddr(Kr + (size_t)((TOK) + (tid >> 5)) * 1024 + h * 256 + (tid & 31) * 8); \
    const bf16_t* vtbase = vaddr(VrT + (size_t)(h * 512 + es * 64 + (tid >> 3)) * TG + (TOK) + (tid & 7) * 8); \
    const bf16_t* qbase = vaddr(Qr + (size_t)((TOK) + 16 * it + fr) * 1024 + h * 256 + fq * 8); \
    _Pragma("unroll") for (int i = 0; i < 4; ++i) kreg[i] = *(const u32x4*)(kbase + (size_t)i * 16 * 1024); \
    vtreg = *(const u32x4*)vtbase; \
    _Pragma("unroll") for (int ks = 0; ks < 8; ++ks) qn[ks] = *(const bf16x8*)(qbase + ks * 32); } while (0)
  RET_LOADS(bl * SEQ);
  for (int n = 0; n < 64; ++n) {
    const int tok0 = bl * SEQ + n * 64;
    bf16x8 qf[8];
    bf16_t* obase = vaddr(OrB + (size_t)(tok0 + 16 * it + fr) * 2048 + h * 512 + es * 64 + 32 * eh + 4 * fq);
    float* sbase = vaddr(stR + ((size_t)(tok0 + 16 * it + fr) * 4 + h) * 2);
#pragma unroll
    for (int ks = 0; ks < 8; ++ks) qf[ks] = qn[ks];
    __builtin_amdgcn_sched_barrier(0);
#pragma unroll
    for (int dt = 0; dt < 2; ++dt)
#pragma unroll
      for (int et = 0; et < 4; ++et) {
        u32x2 o; o[0] = pk2(st[dt][et][0], st[dt][et][1]); o[1] = pk2(st[dt][et][2], st[dt][et][3]);
        *(LAS u32x2*)(lds + STS + (16 * et + fr) * 528 + (32 * w + 16 * dt + 4 * fq) * 2) = o;
      }
#pragma unroll
    for (int i = 0; i < 4; ++i) { const int c = tid + 512 * i, r = c >> 5, ch = c & 31; *(LAS u32x4*)(lds + KS + r * 528 + ch * 16) = kreg[i]; }
    { const int r = tid >> 3, ch = tid & 7; *(LAS u32x4*)(lds + VTS + r * 144 + ch * 16) = vtreg; }
    __syncthreads();
    { const int tokn = bl * SEQ + (n < 63 ? n + 1 : 63) * 64; RET_LOADS(tokn); }
    f32x4 oacc[2];
#pragma unroll
    for (int jj = 0; jj < 2; ++jj) {
      const int jt = 2 * eh + jj;
      f32x4 sc = (f32x4){0.f, 0.f, 0.f, 0.f};
#pragma unroll
      for (int ks = 0; ks < 8; ++ks) sc = mfma16(ldfrag(lds, KS + (16 * jt + fr) * 528 + (32 * ks + 8 * fq) * 2), qf[ks], sc);
      const int i_ = 16 * it + fr, j0 = 16 * jt + 4 * fq;
      u32x2 o; o[0] = pk2(j0 + 0 <= i_ ? sc[0] : 0.f, j0 + 1 <= i_ ? sc[1] : 0.f); o[1] = pk2(j0 + 2 <= i_ ? sc[2] : 0.f, j0 + 3 <= i_ ? sc[3] : 0.f);
      *(LAS u32x2*)(lds + PS + i_ * 144 + j0 * 2) = o;
    }
#pragma unroll
    for (int ee = 0; ee < 2; ++ee) {
      const int et = 2 * eh + ee;
      f32x4 o = (f32x4){0.f, 0.f, 0.f, 0.f};
#pragma unroll
      for (int ks = 0; ks < 8; ++ks) o = mfma16(ldfrag(lds, STS + (16 * et + fr) * 528 + (32 * ks + 8 * fq) * 2), qf[ks], o);
      oacc[ee] = o;
    }
#pragma unroll
    for (int k2 = 0; k2 < 2; ++k2) {
      bf16x8 vf[4];
#pragma unroll
      for (int et = 0; et < 4; ++et) vf[et] = ldfrag(lds, VTS + (16 * et + fr) * 144 + (32 * k2 + 8 * fq) * 2);
#pragma unroll
      for (int dt = 0; dt < 2; ++dt) {
        bf16x8 kf;
        {
          const int a0 = KS + (32 * k2 + 8 * fq + (fr >> 2)) * 528 + (32 * w + 16 * dt + 4 * (fr & 3)) * 2;
          const s16x4 t0 = __builtin_amdgcn_ds_read_tr16_b64_v4i16((LAS s16x4*)(lds + a0));
          const s16x4 t1 = __builtin_amdgcn_ds_read_tr16_b64_v4i16((LAS s16x4*)(lds + a0 + 4 * 528));
          kf = (bf16x8){t0[0], t0[1], t0[2], t0[3], t1[0], t1[1], t1[2], t1[3]};
        }
#pragma unroll
        for (int et = 0; et < 4; ++et) st[dt][et] = mfma16(kf, vf[et], st[dt][et]);
      }
    }
#pragma unroll
    for (int dt = 0; dt < 2; ++dt)
#pragma unroll
      for (int et = 0; et < 4; ++et)
#pragma unroll
        for (int r = 0; r < 4; ++r) st[dt][et][r] *= g64;
    __syncthreads();
    float s1 = 0.f, s2 = 0.f;
#pragma unroll
    for (int ee = 0; ee < 2; ++ee) {
      const int et = 2 * eh + ee;
      f32x4 o = oacc[ee];
#pragma unroll
      for (int k2 = 0; k2 < 2; ++k2) o = mfma16(ldfrag(lds, VTS + (16 * et + fr) * 144 + (32 * k2 + 8 * fq) * 2), ldfrag(lds, PS + (16 * it + fr) * 144 + (32 * k2 + 8 * fq) * 2), o);
#pragma unroll
      for (int r = 0; r < 4; ++r) { o[r] *= rowscale; s1 += o[r]; s2 += o[r] * o[r]; }
      u32x2 ov; ov[0] = pk2(o[0], o[1]); ov[1] = pk2(o[2], o[3]);
      *(u32x2*)(obase + 16 * ee) = ov;
    }
    s1 += shx(s1, 16, lane); s1 += shx(s1, 32, lane); s2 += shx(s2, 16, lane); s2 += shx(s2, 32, lane);
    if (fq == 0 && do_stats) { unsafeAtomicAdd(sbase, s1); unsafeAtomicAdd(sbase + 1, s2); }
    __syncthreads();
  }
}
__device__ __forceinline__ void hgrn_item(ldsp lds, const Params& p, int item, bool do_stats) {
  constexpr int QT = 0, KT = 17408, QB = 34816, KBT = 52224, VTS = 70656, STS = 75264, PS = 83968, TOT = 93184, DEC = 97280;
  const int es = item & 3, h = (item >> 2) & 7, bl = item >> 5;
  const int tid = otid(p.wv), w = tid >> 6, lane = tid & 63, fr = lane & 15, fq = lane >> 4;
  unsigned char* R0 = oaddr(p.ws) + OFF_R0; unsigned char* DO = (unsigned char*)oaddr(p.out);
  const bf16_t* Qh = (const bf16_t*)(R0 + R_QH); const float* LF = (const float*)(DO + D_LF); const bf16_t* ViT = (const bf16_t*)(R0 + R_VIT);
  bf16_t* OrA = (bf16_t*)(R0 + R_ORA);
  float* stH = (float*)(p.ws + OFF_SMALL) + SM_STH;
  LAS float* tot = (LAS float*)(lds + TOT); LAS float* dec = (LAS float*)(lds + DEC);
  const int it = w >> 1, eh = w & 1, d0 = 2 * lane;
  f32x4 st[2];
  st[0] = (f32x4){0.f, 0.f, 0.f, 0.f}; st[1] = (f32x4){0.f, 0.f, 0.f, 0.f};
  float lxn[8], lyn[8]; unsigned q2n[8]; u32x4 vtreg;
#define HG_LOADS(TOK) do { \
    const float* lfbase = vaddr(LF + (size_t)((TOK) + 8 * w) * 1024 + h * 128 + d0); \
    const bf16_t* qhbase = vaddr(Qh + (size_t)((TOK) + 8 * w) * 1024 + h * 128 + d0); \
    const bf16_t* vtbase = vaddr(ViT + (size_t)(h * 128 + es * 32 + ((tid & 255) >> 3)) * TG + (TOK) + (tid & 7) * 8); \
    _Pragma("unroll") for (int jj = 0; jj < 8; ++jj) { \
      const float2 t = *(const float2*)(lfbase + (size_t)jj * 1024); lxn[jj] = t.x; lyn[jj] = t.y; q2n[jj] = *(const unsigned*)(qhbase + (size_t)jj * 1024); } \
    vtreg = *(const u32x4*)vtbase; } while (0)
  HG_LOADS(bl * SEQ);
  for (int n = 0; n < 64; ++n) {
    const int tok0 = bl * SEQ + n * 64;
    float lx[8], ly[8]; unsigned q2[8];
    bf16_t* obase = vaddr(OrA + (size_t)(tok0 + 16 * it + fr) * 1024 + h * 128 + es * 32 + 16 * eh + 4 * fq);
    float* sbase = vaddr(stH + (size_t)(tok0 + 16 * it + fr) * 8 + h);
#pragma unroll
    for (int jj = 0; jj < 8; ++jj) { lx[jj] = lxn[jj]; ly[jj] = lyn[jj]; q2[jj] = q2n[jj]; }
    __builtin_amdgcn_sched_barrier(0);
    float px[8], py[8]; float cx = 0.f, cy = 0.f;
#pragma unroll
    for (int jj = 0; jj < 8; ++jj) { cx += lx[jj]; cy += ly[jj]; px[jj] = cx; py[jj] = cy; }
    tot[w * 128 + d0] = cx; tot[w * 128 + d0 + 1] = cy;
#pragma unroll
    for (int et = 0; et < 2; ++et) {
      u32x2 o; o[0] = pk2(st[et][0], st[et][1]); o[1] = pk2(st[et][2], st[et][3]);
      *(LAS u32x2*)(lds + STS + (16 * et + fr) * 272 + (16 * w + 4 * fq) * 2) = o;
    }
    if (tid < 256) { const int r = tid >> 3, ch = tid & 7; *(LAS u32x4*)(lds + VTS + r * 144 + ch * 16) = vtreg; }
    __syncthreads();
    { const int tokn = bl * SEQ + (n < 63 ? n + 1 : 63) * 64; HG_LOADS(tokn); }
    float offx = 0.f, offy = 0.f, rx = 0.f, ry = 0.f, bx = 0.f, by = 0.f;
#pragma unroll
    for (int q = 0; q < 8; ++q) {
      const float tx = tot[q * 128 + d0], ty = tot[q * 128 + d0 + 1];
      if (q < w) { offx += tx; offy += ty; }
      if (q < 4) { rx += tx; ry += ty; }
      bx += tx; by += ty;
    }
    if (w == 0) { dec[d0] = __expf(bx); dec[d0 + 1] = __expf(by); }
    unsigned kbx[4], kby[4];
#pragma unroll
    for (int jj = 0; jj < 8; ++jj) {
      const float Bx = offx + px[jj], By = offy + py[jj];
      const float qx = bflo(q2[jj]), qy = bfhi(q2[jj]);
      const float kx = 1.0f - __expf(lx[jj]), ky = 1.0f - __expf(ly[jj]);
      const float e1x = __expf(fminf(fmaxf(Bx - rx, -80.f), 80.f)), e1y = __expf(fminf(fmaxf(By - ry, -80.f), 80.f));
      const float e2x = __expf(fminf(fmaxf(rx - Bx, -80.f), 80.f)), e2y = __expf(fminf(fmaxf(ry - By, -80.f), 80.f));
      const int j = 8 * w + jj;
      *(LAS unsigned*)(lds + QT + j * 272 + d0 * 2) = pk2(qx * e1x, qy * e1y);
      *(LAS unsigned*)(lds + KT + j * 272 + d0 * 2) = pk2(kx * e2x, ky * e2y);
      *(LAS unsigned*)(lds + QB + j * 272 + d0 * 2) = pk2(qx * __expf(Bx), qy * __expf(By));
      const float kbvx = kx * __expf(bx - Bx), kbvy = ky * __expf(by - By);
      if (jj & 1) { kbx[jj >> 1] = pk2(__uint_as_float(kbx[jj >> 1]), kbvx); kby[jj >> 1] = pk2(__uint_as_float(kby[jj >> 1]), kbvy); }
      else { kbx[jj >> 1] = __float_as_uint(kbvx); kby[jj >> 1] = __float_as_uint(kbvy); }
    }
    *(LAS u32x4*)(lds + KBT + d0 * 144 + (8 * w) * 2) = (u32x4){kbx[0], kbx[1], kbx[2], kbx[3]};
    *(LAS u32x4*)(lds + KBT + (d0 + 1) * 144 + (8 * w) * 2) = (u32x4){kby[0], kby[1], kby[2], kby[3]};
    __syncthreads();
    f32x4 oacc = (f32x4){0.f, 0.f, 0.f, 0.f};
#pragma unroll
    for (int jj = 0; jj < 2; ++jj) {
      const int jt = 2 * eh + jj;
      f32x4 sc = (f32x4){0.f, 0.f, 0.f, 0.f};
#pragma unroll
      for (int ks = 0; ks < 4; ++ks) sc = mfma16(ldfrag(lds, KT + (16 * jt + fr) * 272 + (32 * ks + 8 * fq) * 2), ldfrag(lds, QT + (16 * it + fr) * 272 + (32 * ks + 8 * fq) * 2), sc);
      const int i_ = 16 * it + fr, j0 = 16 * jt + 4 * fq;
      u32x2 o; o[0] = pk2(j0 + 0 <= i_ ? sc[0] : 0.f, j0 + 1 <= i_ ? sc[1] : 0.f); o[1] = pk2(j0 + 2 <= i_ ? sc[2] : 0.f, j0 + 3 <= i_ ? sc[3] : 0.f);
      *(LAS u32x2*)(lds + PS + i_ * 144 + j0 * 2) = o;
    }
#pragma unroll
    for (int ks = 0; ks < 4; ++ks) oacc = mfma16(ldfrag(lds, STS + (16 * eh + fr) * 272 + (32 * ks + 8 * fq) * 2), ldfrag(lds, QB + (16 * it + fr) * 272 + (32 * ks + 8 * fq) * 2), oacc);
    {
      const f32x4 dv = *(const LAS f32x4*)(dec + 16 * w + 4 * fq);
#pragma unroll
      for (int et = 0; et < 2; ++et)
#pragma unroll
        for (int r = 0; r < 4; ++r) st[et][r] *= dv[r];
#pragma unroll
      for (int k2 = 0; k2 < 2; ++k2) {
        const bf16x8 kf = ldfrag(lds, KBT + (16 * w + fr) * 144 + (32 * k2 + 8 * fq) * 2);
#pragma unroll
        for (int et = 0; et < 2; ++et) st[et] = mfma16(kf, ldfrag(lds, VTS + (16 * et + fr) * 144 + (32 * k2 + 8 * fq) * 2), st[et]);
      }
    }
    __syncthreads();
    {
      f32x4 o = oacc;
#pragma unroll
      for (int k2 = 0; k2 < 2; ++k2) o = mfma16(ldfrag(lds, VTS + (16 * eh + fr) * 144 + (32 * k2 + 8 * fq) * 2), ldfrag(lds, PS + (16 * it + fr) * 144 + (32 * k2 + 8 * fq) * 2), o);
      float s2 = o[0] * o[0] + o[1] * o[1] + o[2] * o[2] + o[3] * o[3];
      u32x2 ov; ov[0] = pk2(o[0], o[1]); ov[1] = pk2(o[2], o[3]);
      *(u32x2*)obase = ov;
      s2 += shx(s2, 16, lane); s2 += shx(s2, 32, lane);
      if (fq == 0 && do_stats) unsafeAtomicAdd(sbase, s2);
    }
    __syncthreads();
  }
}
#ifndef TSEL
#define TSEL -1
#endif
#ifndef STAGGER_TICKS
#define STAGGER_TICKS 0
#endif
#ifndef REP_RET
#define REP_RET 1
#endif
#ifndef REP_HG
#define REP_HG 1
#endif
#ifndef REP_G1
#define REP_G1 1
#endif
#ifndef REP_G2
#define REP_G2 1
#endif
#ifndef REP_G4
#define REP_G4 1
#endif
#ifndef REP_SYNC
#define REP_SYNC 1
#endif
#ifndef REP_PRO
#define REP_PRO 1
#endif
#ifndef REP_S1
#define REP_S1 1
#endif
enum { ST_G1 = 0, ST_S1, ST_G1B, ST_G2, ST_G3, ST_L1, ST_G4, ST_G5, ST_L2 };
__global__ void __launch_bounds__(512, 2) mega(Params p0) {
  extern __shared__ __attribute__((aligned(16))) unsigned char shm[];
  ldsp lds = (ldsp)shm;
  cg::grid_group grid = cg::this_grid();
  Params p = p0; p.ws = oaddr(p0.ws); p.out = oaddr(p0.out); p.wv = __builtin_amdgcn_readfirstlane((int)(threadIdx.x >> 6));
  volatile LAS unsigned* xst = (volatile LAS unsigned*)(lds + 131072);
  if (threadIdx.x < 4) xst[threadIdx.x] = 0u;
  __syncthreads();
  (void)xcd_barrier_post((unsigned*)(p0.ws + OFF_SMALL + SM_BAR_BYTES), xst);
  for (int r = 0; r < REP_PRO; ++r) {
    p.ws = oaddr(p0.ws);
    phase_mod(lds, p);
    phase_conv(lds, p, 0);
    grid.sync();
  }
  phase_u0(p);
  gbar((unsigned*)(p0.ws + OFF_SMALL + SM_BAR_BYTES), xst);
#if TSEL >= 0
  volatile LAS unsigned* tacc = (volatile LAS unsigned*)(lds + 131072 + 16);
  if (threadIdx.x == 0) tacc[0] = 0u;
#endif
  for (int pc = 0; pc < 28; ++pc) {
#if TSEL >= 0
    if (otid(p.wv) == 0) tacc[1] = (unsigned)__builtin_amdgcn_s_memrealtime();
#endif
    p.ws = oaddr(p0.ws); p.out = oaddr(p0.out);
    const bf16_t* WB = (const bf16_t*)(p.ws + OFF_WB);
    const bf16_t* U = (const bf16_t*)(p.ws + OFF_U);
    unsigned char* R0 = p.ws + OFF_R0;
    const int l = pc / 14, k = pc - l * 14;
    int g = 0, stg;
    if (k < 10) { g = k / 5; stg = k - g * 5; } else stg = ST_L1 + (k - 10);
    int nj = 0, jmode0 = 0, jmode1 = 0; const bf16_t* jA0 = nullptr; const bf16_t* jA1 = nullptr; const bf16_t* jB0 = nullptr; const bf16_t* jB1 = nullptr;
    int jM0 = 0, jM1 = 0, jN0 = 0, jN1 = 0, jK0 = 0, jK1 = 0;
    if (stg == ST_G1) {
      float* stz = (float*)(p.ws + OFF_SMALL) + SM_STR;
      for (int i = obid() * 512 + otid(p.wv); i < TG * 16; i += gridDim.x * 512) stz[i] = 0.f;
      nj = 2;
      jmode0 = MD_G1A; jA0 = U + (size_t)g * TG * 1024; jB0 = WB + W1A; jM0 = TG; jN0 = 4096; jK0 = 1024;
      jmode1 = MD_G1S; jA1 = WB + W1S; jB1 = U + (size_t)g * TG * 1024; jM1 = 3072; jN1 = TG; jK1 = 1024;
    } else if (stg == ST_S1) {
      for (int rep = 0; rep < REP_S1; ++rep) {
        if (rep) { gbar((unsigned*)(p0.ws + OFF_SMALL + SM_BAR_BYTES), xst); float* stz = (float*)(p.ws + OFF_SMALL) + SM_STR; for (int i = obid() * 512 + otid(p.wv); i < TG * 16; i += gridDim.x * 512) stz[i] = 0.f; gbar((unsigned*)(p0.ws + OFF_SMALL + SM_BAR_BYTES), xst); }
        const int bid = obid();
        if (bid < 128) { for (int r2 = 0; r2 < REP_RET; ++r2) ret_item(lds, p, bid, r2 == REP_RET - 1); } else { for (int r2 = 0; r2 < REP_HG; ++r2) hgrn_item(lds, p, bid - 128, r2 == REP_HG - 1); }
      }
    } else if (stg == ST_G1B) {
      nj = 1; jmode0 = MD_G1B; jA0 = U + (size_t)g * TG * 1024; jB0 = WB + W1B; jM0 = TG; jN0 = 5120; jK0 = 1024;
    } else if (stg == ST_G2) {
      nj = 2;
      jmode0 = MD_G2A; jA0 = (const bf16_t*)(R0 + R_ORA); jB0 = WB + WPA; jM0 = TG; jN0 = 1024; jK0 = 1024;
      jmode1 = MD_G2B; jA1 = (const bf16_t*)(R0 + R_ORB); jB1 = WB + WPB; jM1 = TG; jN1 = 1024; jK1 = 2048;
    } else if (stg == ST_G3) {
      nj = 1; jmode0 = MD_G3; jA0 = (const bf16_t*)(R0 + R_MG); jB0 = WB + WO; jM0 = TG; jN0 = 1024; jK0 = 1024;
    } else if (stg == ST_L1) {
      phase_ln(p, p.ln1_g + l * 1024, p.ln1_b + l * 1024, l, 3, false);
    } else if (stg == ST_G4) {
      nj = 1; jmode0 = MD_G4; jA0 = U; jB0 = WB + WUP; jM0 = T_ALL; jN0 = 4096; jK0 = 1024;
    } else if (stg == ST_G5) {
      nj = 1; jmode0 = MD_G5; jA0 = (const bf16_t*)R0; jB0 = WB + WDN; jM0 = T_ALL; jN0 = 1024; jK0 = 4096;
    } else {
      phase_ln(p, p.ln2_g + l * 1024, p.ln2_b + l * 1024, l == 0 ? 1 : 0, 0, l == 1);
      if (l == 0) phase_conv(lds, p, 1);
    }
    for (int j = 0; j < nj * (stg == ST_G4 ? REP_G4 : 1) * (stg == ST_G1 ? REP_G1 : 1) * (stg == ST_G2 ? REP_G2 : 1); ++j) {
      pg8::Gemm gm; const bool j1 = (nj == 2 && (j & 1) == 1); gm.A = j1 ? jA1 : jA0; gm.Bt = j1 ? jB1 : jB0; gm.M = j1 ? jM1 : jM0; gm.N = j1 ? jN1 : jN0; gm.K = j1 ? jK1 : jK0;
      pg8::StaticOrder S; S.init(gm.M, gm.N, (int)gridDim.x, obid());
      EpiP E; E.mode = j1 ? jmode1 : jmode0; E.l = l; E.g = g; E.pp = &p;
#if STAGGER_TICKS > 0
      if (j == 0 && (gm.M >> 8) * (gm.N >> 8) >= 3 * (int)gridDim.x && ((obid() >> 3) & 1)) {
        const unsigned long long t0 = __builtin_amdgcn_s_memrealtime();
        while (__builtin_amdgcn_s_memrealtime() - t0 < (unsigned long long)STAGGER_TICKS) __builtin_amdgcn_s_sleep(32);
      }
#endif
      pg8::gemm_phase<EpiP, pg8::StaticOrder, false>((PG8_LAS unsigned char*)shm, gm, S, E, nullptr);
    }
    for (int r = 0; r < REP_SYNC; ++r) gbar((unsigned*)(p0.ws + OFF_SMALL + SM_BAR_BYTES), xst);
#if TSEL >= 0
    const int k2_ = pc - (pc / 14) * 14, stg2_ = k2_ < 10 ? k2_ % 5 : ST_L1 + (k2_ - 10);
    if (otid(p.wv) == 0 && ((TSEL >> stg2_) & 1)) tacc[0] = tacc[0] + ((unsigned)__builtin_amdgcn_s_memrealtime() - tacc[1]);
#endif
  }
#if TSEL >= 0
  if (obid() == 0 && otid(p.wv) == 0) { const unsigned long long t0 = __builtin_amdgcn_s_memrealtime(); const unsigned long long w = 4ull * tacc[0]; while (__builtin_amdgcn_s_memrealtime() - t0 < w) __builtin_amdgcn_s_sleep(32); }
#endif
}

extern "C" void kernel_launch(void* const* d_in, const int* in_sizes, int n_in, void* d_out, int out_size,
                              void* d_ws, size_t ws_size, hipStream_t stream) {
  constexpr size_t kDynLds = 131072 + 16 + 16;
  static int configured = 0;
  if (!configured) {
    (void)hipFuncSetAttribute((const void*)mega, hipFuncAttributeMaxDynamicSharedMemorySize, (int)kDynLds);
    configured = 1;
  }
  Params p{};
  p.x = (const float*)d_in[0]; p.c = (const float*)d_in[1]; p.pos = (const int*)d_in[2]; p.lb_logits = (const float*)d_in[3];
  p.w_ada = (const float*)d_in[4]; p.b_ada = (const float*)d_in[5]; p.w_in = (const float*)d_in[6]; p.w_pa = (const float*)d_in[7];
  p.w_pb = (const float*)d_in[8]; p.w_o = (const float*)d_in[9]; p.ln1_g = (const float*)d_in[10]; p.ln1_b = (const float*)d_in[11];
  p.w_up = (const float*)d_in[12]; p.b_up = (const float*)d_in[13]; p.w_down = (const float*)d_in[14]; p.b_down = (const float*)d_in[15];
  p.ln2_g = (const float*)d_in[16]; p.ln2_b = (const float*)d_in[17];
  p.out = (float*)d_out; p.ws = (unsigned char*)d_ws;
  if (ws_size < 512ull * 1024 * 1024) { fprintf(stderr, "workspace too small\n"); return; }
  (void)hipMemsetAsync((unsigned char*)d_ws + OFF_SMALL + SM_BAR_BYTES, 0, XCD_BAR_WORDS * 4, stream);
  void* args[] = {&p};
  hipError_t e = hipLaunchCooperativeKernel((void*)mega, dim3(256), dim3(512), args, kDynLds, stream);
  if (e != hipSuccess) fprintf(stderr, "cooperative launch failed: %s\n", hipGetErrorString(e));
}
```

```cpp
#include <hip/hip_runtime.h>
#include <hip/hip_cooperative_groups.h>
#include <cstdio>
namespace cg = cooperative_groups;
__device__ __forceinline__ int otid(int wv) { int t = (wv << 6) | (int)__builtin_amdgcn_mbcnt_hi(~0u, __builtin_amdgcn_mbcnt_lo(~0u, 0u)); asm volatile("" : "+v"(t)); return t; }
__device__ __forceinline__ int obid() { int t = blockIdx.x; asm volatile("" : "+s"(t)); return t; }
template <class T> __device__ __forceinline__ T* oaddr(T* q) { asm volatile("" : "+s"(q)); return q; }
namespace pg8 {
#define PG8_LAS __attribute__((address_space(3)))
typedef unsigned short bf16_t;
typedef short bf16x8 __attribute__((ext_vector_type(8)));
typedef float f32x4 __attribute__((ext_vector_type(4)));
typedef unsigned u32x4 __attribute__((ext_vector_type(4)));
constexpr int BM = 256, BK = 64, HALF = 128, HTB = HALF * BK * 2  , STAGE_BYTES = 8 * HTB, NXCD = 8, WGM = 8;

__host__ __device__ __forceinline__ int lds_byte(int r, int c) { const int st = (r >> 4) * 2 + (c >> 5), rr = r & 15, cc = c & 31, ob = rr * 64 + cc * 2; return st * 1024 + (ob ^ (((ob >> 9) & 1) << 5)); }
__host__ __device__ __forceinline__ void stage_rc(int b, int& R, int& C) { const int st = b / 1024, sb = b % 1024, swz = sb ^ (((sb >> 9) & 1) << 5); R = (st >> 1) * 16 + swz / 64; C = (st & 1) * 32 + (swz % 64) / 2; }
__host__ __device__ __forceinline__ int perm32(int rho) { const int n = rho >> 4, i = rho & 15; return 8 * (i >> 2) + 4 * n + (i & 3); }

struct Unit { int pm, pn; };
struct Gemm { const bf16_t* A; const bf16_t* Bt; int M, N, K; };

struct StaticOrder {
    int nM, nN, nwg, G, c;
    __host__ __device__ void init(int M, int N, int G_, int c_) { nM = M / BM; nN = N / BM; nwg = nM * nN; G = G_; c = c_; }
    __host__ __device__ bool next(int i, Unit& u) const {
        const long L = (long)i * G + c; if (L >= nwg) return false;
        int wgid = (int)L; { const int q = nwg / NXCD, r = nwg % NXCD, xcd = wgid % NXCD, off = wgid / NXCD; wgid = (xcd < r ? xcd * (q + 1) : r * (q + 1) + (xcd - r) * q) + off; }
        const int nig = WGM * nN, gid = wgid / nig, fm = gid * WGM, gsz = (nM - fm) < WGM ? (nM - fm) : WGM;
        u.pm = fm + ((wgid % nig) % gsz); u.pn = (wgid % nig) / gsz; return true;
    }
    __device__ __forceinline__ void a_ready(const Unit&) const {}
    __device__ __forceinline__ void done(const Unit&) const {}
};
__device__ __forceinline__ unsigned cvt_pk_bf16(float lo, float hi) { unsigned r; asm volatile("v_cvt_pk_bf16_f32 %0, %1, %2" : "=v"(r) : "v"(lo), "v"(hi)); return r; }

template <class Epi, class Sched, bool STAMP = false>
__device__ __forceinline__ void gemm_phase(PG8_LAS unsigned char* lds, const Gemm g, const Sched& S, const Epi& E, unsigned long long* stamps) {
    const int tid = otid(E.pp->wv), wid = __builtin_amdgcn_readfirstlane(tid >> 6), lane = tid & 63, wr = wid >> 2, wc = wid & 3, fr = lane & 15, fq = lane >> 4;
    const int K = g.K, nt = K / BK;
    int ts_lo = 0, ts_hi = 0, nts = 0; const unsigned long long rt_entry = STAMP ? (unsigned long long)wall_clock64() : 0ull;
#define PG8_STAMP() do { if (STAMP && wid == 0 && nts < 64) { const unsigned long long _c = (unsigned long long)clock64(); \
        ts_lo = (lane == nts) ? (int)(unsigned)_c : ts_lo; ts_hi = (lane == nts) ? (int)(unsigned)(_c >> 32) : ts_hi; ++nts; } } while (0)
    PG8_STAMP();
    unsigned voffA[2], voffB[2];
#pragma unroll
    for (int i = 0; i < 2; ++i) { int R, C; stage_rc(tid * 16 + i * 8192, R, C); const int Rb = Epi::PERM ? ((R & ~31) + perm32(R & 31)) : R;
        voffA[i] = (unsigned)(R * K + C) * 2u; voffB[i] = (unsigned)(Rb * K + C) * 2u; }
    const size_t kstep = (size_t)(BK * 2);
    const size_t hstep = (size_t)HALF * K * 2;
    const size_t tstep = 2 * hstep;
    const unsigned ldsw = (unsigned)wid * 1024u;
    const int aoff = lds_byte(wr * 64 + fr, fq * 8), boff = lds_byte(wc * 32 + fr, fq * 8);
#define PG8_SA(b, h) (((b) * 2 + (h)) * HTB)
#define PG8_SB(b, h) ((4 + (b) * 2 + (h)) * HTB)
#define PG8_STAGE(bufoff, gbase, voff) do { _Pragma("unroll") for (int _i = 0; _i < 2; ++_i) \
        __builtin_amdgcn_global_load_lds((const unsigned*)((const char*)(gbase) + (voff)[_i]), (PG8_LAS unsigned*)(lds + (bufoff) + ldsw + _i * 8192), 16, 0, 0); } while (0)
#define PG8_LDA(dst, b, h) do { _Pragma("unroll") for (int m = 0; m < 4; ++m) _Pragma("unroll") for (int k = 0; k < 2; ++k) dst[m][k] = *(const PG8_LAS bf16x8*)(lds + PG8_SA(b, h) + aoff + m * 2048 + k * 1024); } while (0)
#define PG8_LDB(dst, b, h) do { _Pragma("unroll") for (int n = 0; n < 2; ++n) _Pragma("unroll") for (int k = 0; k < 2; ++k) dst[n][k] = *(const PG8_LAS bf16x8*)(lds + PG8_SB(b, h) + boff + n * 2048 + k * 1024); } while (0)
#define PG8_MMA(ai, bj, At, Bt) do { __builtin_amdgcn_s_setprio(1); _Pragma("unroll") for (int m = 0; m < 4; ++m) _Pragma("unroll") for (int n = 0; n < 2; ++n) _Pragma("unroll") for (int k = 0; k < 2; ++k) \
        acc[ai][bj][m][n] = __builtin_amdgcn_mfma_f32_16x16x32_bf16(Bt[n][k], At[m][k], acc[ai][bj][m][n], 0, 0, 0); __builtin_amdgcn_s_setprio(0); } while (0)
#define PG8_WAIT_V(n) asm volatile("s_waitcnt vmcnt(" #n ")" ::: "memory")
#define PG8_WAIT_L(n) asm volatile("s_waitcnt lgkmcnt(" #n ")" ::: "memory")
#define PG8_BAR __builtin_amdgcn_s_barrier()
#define PG8_SCHED __builtin_amdgcn_sched_barrier(0)
    Unit cur, nxt; int ui = 0;
    if (!S.next(0, cur)) return;
    f32x4 acc[2][2][4][2];
#pragma unroll
    for (int a = 0; a < 2; ++a)
#pragma unroll
        for (int b = 0; b < 2; ++b)
#pragma unroll
            for (int m = 0; m < 4; ++m)
#pragma unroll
                for (int n = 0; n < 2; ++n) acc[a][b][m][n] = (f32x4){0.f, 0.f, 0.f, 0.f};
    bf16x8 At[4][2], B0[2][2], B1[2][2];
    const char* cA = (const char*)g.A + (size_t)cur.pm * tstep; const char* cB = (const char*)g.Bt + (size_t)cur.pn * tstep;
    S.a_ready(cur);
    PG8_STAGE(PG8_SB(0, 0), cB, voffB); PG8_STAGE(PG8_SA(0, 0), cA, voffA); PG8_STAGE(PG8_SB(0, 1), cB + hstep, voffB); PG8_STAGE(PG8_SA(0, 1), cA + hstep, voffA);
    if (wr == 1) PG8_BAR;
    PG8_WAIT_V(4); PG8_BAR;
    PG8_STAGE(PG8_SB(1, 0), cB + kstep, voffB); PG8_STAGE(PG8_SA(1, 0), cA + kstep, voffA); PG8_STAGE(PG8_SB(1, 1), cB + hstep + kstep, voffB);
    PG8_WAIT_V(6); PG8_BAR;
    PG8_STAMP();
    for (;;) {
        const bool has_next = S.next(ui + 1, nxt);
        const char* nA = has_next ? (const char*)g.A + (size_t)nxt.pm * tstep : cA; const char* nB = has_next ? (const char*)g.Bt + (size_t)nxt.pn * tstep : cB;
        for (int t = 0; t < nt; t += 2) {
            const bool last = (t == nt - 2);
            const char* a1 = cA + (size_t)(t + 1) * kstep;
            const char* a2 = last ? nA : cA + (size_t)(t + 2) * kstep; const char* b2 = last ? nB : cB + (size_t)(t + 2) * kstep;
            const char* a3 = a2 + kstep; const char* b3 = b2 + kstep;
            if (last && has_next) S.a_ready(nxt);
            PG8_LDB(B0, 0, 0); PG8_SCHED; PG8_LDA(At, 0, 0); PG8_STAGE(PG8_SA(1, 1), a1 + hstep, voffA);
            PG8_WAIT_L(8); PG8_BAR; PG8_WAIT_L(0); PG8_MMA(0, 0, At, B0); PG8_BAR; PG8_SCHED;
            PG8_LDB(B1, 0, 1); PG8_STAGE(PG8_SB(0, 0), b2, voffB);
            PG8_BAR; PG8_WAIT_L(0); PG8_MMA(0, 1, At, B1); PG8_BAR;
            PG8_LDA(At, 0, 1); PG8_STAGE(PG8_SA(0, 0), a2, voffA);
            PG8_BAR; PG8_WAIT_L(0); PG8_MMA(1, 0, At, B0); PG8_BAR; PG8_SCHED;
            PG8_STAGE(PG8_SB(0, 1), b2 + hstep, voffB);
            PG8_WAIT_V(6); PG8_BAR; PG8_MMA(1, 1, At, B1); PG8_BAR;
            PG8_LDB(B0, 1, 0); PG8_SCHED; PG8_LDA(At, 1, 0); PG8_STAGE(PG8_SA(0, 1), a2 + hstep, voffA);
            PG8_WAIT_L(8); PG8_BAR; PG8_WAIT_L(0); PG8_MMA(0, 0, At, B0); PG8_BAR; PG8_SCHED;
            PG8_LDB(B1, 1, 1); PG8_STAGE(PG8_SB(1, 0), b3, voffB);
            PG8_BAR; PG8_WAIT_L(0); PG8_MMA(0, 1, At, B1); PG8_BAR;
            PG8_LDA(At, 1, 1); PG8_STAGE(PG8_SA(1, 0), a3, voffA);
            PG8_BAR; PG8_WAIT_L(0); PG8_MMA(1, 0, At, B0); PG8_BAR; PG8_SCHED;
            PG8_STAGE(PG8_SB(1, 1), b3 + hstep, voffB);
            PG8_WAIT_V(6); PG8_BAR; PG8_MMA(1, 1, At, B1); PG8_BAR;
        }
        PG8_STAMP();
        if constexpr (!Epi::AFTER_DRAIN) { E(acc, cur, wr, wc, fr, fq); S.done(cur); }
        PG8_STAMP();
        if (!has_next) break;
#pragma unroll
        for (int a = 0; a < 2; ++a)
#pragma unroll
            for (int b = 0; b < 2; ++b)
#pragma unroll
                for (int m = 0; m < 4; ++m)
#pragma unroll
                    for (int n = 0; n < 2; ++n) acc[a][b][m][n] = (f32x4){0.f, 0.f, 0.f, 0.f};
        cur = nxt; cA = nA; cB = nB; ++ui;
    }
    PG8_WAIT_V(0);
    if (wr == 0) PG8_BAR;
    PG8_BAR;
    if constexpr (Epi::AFTER_DRAIN) { E.fused(acc, cur, wr, wc, fr, fq, lds, wid, lane); S.done(cur); }
    PG8_STAMP();
    if (STAMP && wid == 0) { stamps[lane] = lane < nts ? (((unsigned long long)(unsigned)ts_hi << 32) | (unsigned)ts_lo) : 0ull;
        if (lane == 62) stamps[62] = rt_entry; if (lane == 63) stamps[63] = (unsigned long long)wall_clock64(); }
#undef PG8_STAMP
#undef PG8_SA
#undef PG8_SB
#undef PG8_STAGE
#undef PG8_LDA
#undef PG8_LDB
#undef PG8_MMA
#undef PG8_WAIT_V
#undef PG8_WAIT_L
#undef PG8_BAR
#undef PG8_SCHED
}
}
using pg8::bf16_t; using pg8::bf16x8; using pg8::f32x4; using pg8::u32x4; using pg8::Unit;
typedef unsigned u32x2 __attribute__((ext_vector_type(2)));
#define LAS __attribute__((address_space(3)))
#define GAS __attribute__((address_space(1)))
typedef LAS unsigned char* ldsp;

constexpr int T_ALL = 32768, TG = 16384, DM = 1024, SEQ = 4096;
constexpr float ALPHA = 1.4142135623730951f;
constexpr size_t MB = 1024ull * 1024ull;
constexpr size_t OFF_XB = 0, OFF_WB = 128 * MB, OFF_U = 184 * MB, OFF_SMALL = 248 * MB, OFF_R0 = 256 * MB;
constexpr size_t W1A = 0, W1S = W1A + 4096ull * 1024, W1B = W1S + 3072ull * 1024, WPA = W1B + 5120ull * 1024, WPB = WPA + 1024ull * 1024,
                 WO = WPB + 1024ull * 2048, WUP = WO + 1024ull * 1024, WDN = WUP + 4096ull * 1024, W_END = WDN + 4096ull * 1024;
static_assert(W_END * 2 <= 56 * MB, "weights");
constexpr size_t SM_MOD = 0  , SM_LB = 2 * 8 * 6144  , SM_STR = SM_LB + 2048  , SM_STH = SM_STR + (size_t)TG * 8  , SM_END = SM_STH + (size_t)TG * 8;
constexpr size_t SM_BAR_BYTES = 7 * MB;
static_assert(SM_END * 4 <= 7 * MB, "small");
constexpr size_t R_QH = 0, R_VIT = 32 * MB, R_QR = 64 * MB, R_KR = 96 * MB, R_KRT = 128 * MB, R_ORA = 160 * MB, R_ORB = 192 * MB;
constexpr size_t R_SGA = R_QH, R_SGB = R_VIT, R_M1 = R_QR, R_MG = R_KRT;
constexpr size_t D_LF = 0, D_VRT = 64 * MB;

struct Params {
  const float* x; const float* c; const int* pos; const float* lb_logits; const float* w_ada; const float* b_ada; const float* w_in; const float* w_pa; const float* w_pb;
  const float* w_o; const float* ln1_g; const float* ln1_b; const float* w_up; const float* b_up; const float* w_down; const float* b_down; const float* ln2_g; const float* ln2_b;
  float* out; unsigned char* ws; int wv; int pad;
};

__device__ __forceinline__ float bf2f(unsigned short b) { return __uint_as_float(((unsigned)b) << 16); }
__device__ __forceinline__ float bflo(unsigned u) { return __uint_as_float(u << 16); }
__device__ __forceinline__ float bfhi(unsigned u) { return __uint_as_float(u & 0xffff0000u); }
typedef float f32x2_ __attribute__((ext_vector_type(2)));
typedef __bf16 bf16x2_ __attribute__((ext_vector_type(2)));
__device__ __forceinline__ unsigned pk2(float lo, float hi) { const f32x2_ v = {lo, hi}; const bf16x2_ b = __builtin_convertvector(v, bf16x2_); return __builtin_bit_cast(unsigned, b); }
__device__ __forceinline__ float sigmoidf_(float v) { return __builtin_amdgcn_rcpf(1.0f + __expf(-v)); }
__device__ __forceinline__ float siluf_(float v) { return v * sigmoidf_(v); }
__device__ __forceinline__ f32x4 mfma16(bf16x8 a, bf16x8 b, f32x4 c) { return __builtin_amdgcn_mfma_f32_16x16x32_bf16(a, b, c, 0, 0, 0); }
__device__ __forceinline__ bf16x8 ldfrag(ldsp base, int off) { return *(const LAS bf16x8*)(base + off); }
__device__ __forceinline__ float shx(float v, int mask, int lane) { return __int_as_float(__builtin_amdgcn_ds_bpermute((lane ^ mask) << 2, __float_as_int(v))); }
__device__ __forceinline__ float wave_sum(float v, int lane) {
#pragma unroll
  for (int o = 32; o > 0; o >>= 1) v += shx(v, o, lane);
  return v;
}

#ifdef USE_NT
#define NTS(val, ptr) __builtin_nontemporal_store((val), (ptr))
#else
#define NTS(val, ptr) (*(ptr) = (val))
#endif
enum { MD_G1A = 0, MD_G1S, MD_G1B, MD_G2A, MD_G2B, MD_G3, MD_G4, MD_G5 };
struct RowBuf { u32x4 a[2]; f32x4 b0[2], b1[2]; f32x4 s[2]; int pi; };
struct UnitBuf { f32x4 c0[2], c1[2], d0[2], d1[2]; };
struct EpiP {
  static constexpr bool PERM = true, AFTER_DRAIN = false;
  int mode, l, g;
  const Params* pp;
  template <int MODE> __device__ __forceinline__ void unitload(UnitBuf& ub, const Unit& u, int wc, int fq) const {
    const Params& p = *pp;
    const GAS float* small = (const GAS float*)(p.ws + OFF_SMALL);
    const GAS float* mod = small + SM_MOD + (size_t)l * 8 * 6144;
#pragma unroll
    for (int bj = 0; bj < 2; ++bj) {
      const int col = u.pn * 256 + bj * 128 + wc * 32 + 8 * fq;
      if constexpr (MODE == MD_G1A) {
        if ((col >> 10) == 1) { const GAS float* lbp = small + SM_LB + l * 1024 + (col & 1023); ub.c0[bj] = *(const GAS f32x4*)lbp; ub.c1[bj] = *(const GAS f32x4*)(lbp + 4); }
      } else if constexpr (MODE == MD_G3) {
        const int b = (g * TG + u.pm * 256) >> 12; const GAS float* gt = mod + (size_t)b * 6144 + 2 * 1024 + col;
        ub.c0[bj] = *(const GAS f32x4*)gt; ub.c1[bj] = *(const GAS f32x4*)(gt + 4);
      } else if constexpr (MODE == MD_G4) {
        const GAS float* bp = (const GAS float*)p.b_up + (size_t)l * 4096 + col; ub.c0[bj] = *(const GAS f32x4*)bp; ub.c1[bj] = *(const GAS f32x4*)(bp + 4);
      } else if constexpr (MODE == MD_G5) {
        const int b = (u.pm * 256) >> 12; const GAS float* gt = mod + (size_t)b * 6144 + 5 * 1024 + col; const GAS float* bp = (const GAS float*)p.b_down + (size_t)l * 1024 + col;
        ub.c0[bj] = *(const GAS f32x4*)gt; ub.c1[bj] = *(const GAS f32x4*)(gt + 4); ub.d0[bj] = *(const GAS f32x4*)bp; ub.d1[bj] = *(const GAS f32x4*)(bp + 4);
      }
    }
  }
  template <int MODE, int ai, int m, int PH> __device__ __forceinline__ void rowf(const f32x4 (&acc)[2][2][4][2], RowBuf& rb, const UnitBuf& ub, const Unit& u, int wr, int wc, int fr, int fq) const {
    if constexpr (PH == 0 && MODE == MD_G1A) { if ((u.pn >> 2) >= 2) rb.pi = ((const GAS int*)pp->pos)[g * TG + u.pm * 256 + ai * 128 + wr * 64 + m * 16 + fr]; }
    cell<MODE, ai, m, PH, 0>(acc, rb, ub, u, wr, wc, fr, fq);
    cell<MODE, ai, m, PH, 1>(acc, rb, ub, u, wr, wc, fr, fq);
  }
  template <int MODE, int ai, int m, int PH, int bj> __device__ __forceinline__ void cell(const f32x4 (&acc)[2][2][4][2], RowBuf& rb, const UnitBuf& ub, const Unit& u, int wr, int wc, int fr, int fq) const {
    const Params& p = *pp;
    GAS unsigned char* R0 = (GAS unsigned char*)(p.ws + OFF_R0); GAS unsigned char* DO = (GAS unsigned char*)p.out;
    GAS float* small = (GAS float*)(p.ws + OFF_SMALL);
    const int row = u.pm * 256 + ai * 128 + wr * 64 + m * 16 + fr;
    {
      const int col = u.pn * 256 + bj * 128 + wc * 32 + 8 * fq;
      float v[8];
#pragma unroll
      for (int i = 0; i < 4; ++i) { v[i] = acc[ai][bj][m][0][i]; v[4 + i] = acc[ai][bj][m][1][i]; }
      if constexpr (MODE == MD_G1A) {
        if constexpr (PH == 1) {
          const int sec = col >> 10, cs = col & 1023;
          if (sec == 0) {
            u32x4 o;
#pragma unroll
            for (int i = 0; i < 4; ++i) o[i] = pk2(siluf_(v[2 * i]), siluf_(v[2 * i + 1]));
            *(GAS u32x4*)(R0 + R_QH + ((size_t)row * 1024 + cs) * 2) = o;
          } else if (sec == 1) {
            float o[8];
            if (l == 0) {
#pragma unroll
              for (int i = 0; i < 8; ++i) { const float z = v[i]; o[i] = fminf(z, 0.f) - __logf(1.0f + __expf(-fabsf(z))); }
            } else {
#pragma unroll
              for (int i = 0; i < 8; ++i) {
                const float lbv = i < 4 ? ub.c0[bj][i & 3] : ub.c1[bj][i & 3];
                const float z = v[i], e = __expf(-fabsf(z)), r = __builtin_amdgcn_rcpf(1.0f + e);
                const float sg = z >= 0.f ? r : e * r;
                o[i] = __logf(lbv + (1.f - lbv) * sg);
              }
            }
            GAS float* dst = (GAS float*)(DO + D_LF) + (size_t)row * 1024 + cs;
            *(GAS f32x4*)dst = (f32x4){o[0], o[1], o[2], o[3]}; *(GAS f32x4*)(dst + 4) = (f32x4){o[4], o[5], o[6], o[7]};
          } else {
            const float posf = (float)rb.pi;
            const float sc = sec == 3 ? 0.0625f : 1.0f;
            const int p0 = (cs & 255) >> 1;
            u32x4 o;
#pragma unroll
            for (int i = 0; i < 4; ++i) {
              const float theta = __builtin_amdgcn_exp2f(-13.287712379549449f * (float)(p0 + i) * (1.0f / 127.0f));
              float rev = posf * theta * 0.15915494309189535f; rev -= floorf(rev);
              const float sn = __builtin_amdgcn_sinf(rev), cn = __builtin_amdgcn_cosf(rev);
              const float t1 = v[2 * i], t2 = v[2 * i + 1];
              o[i] = pk2((t1 * cn - t2 * sn) * sc, (t1 * sn + t2 * cn) * sc);
            }
            *(GAS u32x4*)(R0 + (sec == 2 ? R_QR : R_KR) + ((size_t)row * 1024 + cs) * 2) = o;
          }
        }
      } else if constexpr (MODE == MD_G1S) {
        if constexpr (PH == 1) {
          if ((row >> 10) == 0) {
            u32x4 o;
#pragma unroll
            for (int i = 0; i < 4; ++i) o[i] = pk2(v[2 * i], v[2 * i + 1]);
            *(GAS u32x4*)(R0 + R_VIT + ((size_t)row * TG + col) * 2) = o;
          } else {
            const int f = row - 1024, h = (u.pm * 256 - 1024) >> 9;
            const float lg2 = __log2f(1.0f - __builtin_amdgcn_exp2f(-5.0f - (float)h));
            u32x4 ov;
#pragma unroll
            for (int i = 0; i < 4; ++i) ov[i] = pk2(v[2 * i] * __builtin_amdgcn_exp2f(lg2 * (float)(63 - ((col + 2 * i) & 63))), v[2 * i + 1] * __builtin_amdgcn_exp2f(lg2 * (float)(63 - ((col + 2 * i + 1) & 63))));
            *(GAS u32x4*)(DO + D_VRT + ((size_t)f * TG + col) * 2) = ov;
          }
        }
      } else if constexpr (MODE == MD_G1B) {
        const int sec = col >> 10, cs = col & 1023;
        if (sec == 0) {
          GAS u32x4* ptr = (GAS u32x4*)(R0 + R_ORA + ((size_t)row * 1024 + cs) * 2);
          if constexpr (PH == 0) { rb.a[bj] = *ptr; rb.s[bj][0] = (small + SM_STH)[(size_t)row * 8 + (cs >> 7)]; }
          else {
            const float rstd = rsqrtf(rb.s[bj][0] * (1.0f / 128.0f) + 1e-6f);
            const u32x4 ov = rb.a[bj]; u32x4 o;
#pragma unroll
            for (int i = 0; i < 4; ++i) o[i] = pk2(bflo(ov[i]) * rstd * siluf_(v[2 * i]), bfhi(ov[i]) * rstd * siluf_(v[2 * i + 1]));
            *ptr = o;
          }
        } else if (sec < 3) {
          const int c2 = col - 1024;
          GAS u32x4* ptr = (GAS u32x4*)(R0 + R_ORB + ((size_t)row * 2048 + c2) * 2);
          if constexpr (PH == 0) { const GAS float* st = small + SM_STR + ((size_t)row * 4 + (c2 >> 9)) * 2; rb.a[bj] = *ptr; rb.s[bj][0] = st[0]; rb.s[bj][1] = st[1]; }
          else {
            const float mean = rb.s[bj][0] * (1.0f / 512.0f);
            const float var = fmaxf(rb.s[bj][1] * (1.0f / 512.0f) - mean * mean, 0.f);
            const float rstd = rsqrtf(var + 1e-6f);
            const u32x4 ov = rb.a[bj]; u32x4 o;
#pragma unroll
            for (int i = 0; i < 4; ++i) o[i] = pk2((bflo(ov[i]) - mean) * rstd * siluf_(v[2 * i]), (bfhi(ov[i]) - mean) * rstd * siluf_(v[2 * i + 1]));
            *ptr = o;
          }
        } else {
          if constexpr (PH == 1) {
            u32x4 o;
#pragma unroll
            for (int i = 0; i < 4; ++i) o[i] = pk2(sigmoidf_(v[2 * i]), sigmoidf_(v[2 * i + 1]));
            *(GAS u32x4*)(R0 + (sec == 3 ? R_SGA : R_SGB) + ((size_t)row * 1024 + cs) * 2) = o;
          }
        }
      } else if constexpr (MODE == MD_G2A) {
        if constexpr (PH == 0) rb.a[bj] = *(const GAS u32x4*)(R0 + R_SGA + ((size_t)row * 1024 + col) * 2);
        else {
          const u32x4 gv = rb.a[bj];
          GAS float* dst = (GAS float*)(R0 + R_M1) + (size_t)row * 1024 + col;
          *(GAS f32x4*)dst = (f32x4){bflo(gv[0]) * v[0], bfhi(gv[0]) * v[1], bflo(gv[1]) * v[2], bfhi(gv[1]) * v[3]};
          *(GAS f32x4*)(dst + 4) = (f32x4){bflo(gv[2]) * v[4], bfhi(gv[2]) * v[5], bflo(gv[3]) * v[6], bfhi(gv[3]) * v[7]};
        }
      } else if constexpr (MODE == MD_G2B) {
        if constexpr (PH == 0) {
          rb.a[bj] = *(const GAS u32x4*)(R0 + R_SGB + ((size_t)row * 1024 + col) * 2);
          const GAS float* src = (const GAS float*)(R0 + R_M1) + (size_t)row * 1024 + col;
          rb.b0[bj] = *(const GAS f32x4*)src; rb.b1[bj] = *(const GAS f32x4*)(src + 4);
        } else {
          const u32x4 gv = rb.a[bj]; const f32x4 m0 = rb.b0[bj], m1 = rb.b1[bj];
          u32x4 o;
          o[0] = pk2(m0[0] + bflo(gv[0]) * v[0], m0[1] + bfhi(gv[0]) * v[1]);
          o[1] = pk2(m0[2] + bflo(gv[1]) * v[2], m0[3] + bfhi(gv[1]) * v[3]);
          o[2] = pk2(m1[0] + bflo(gv[2]) * v[4], m1[1] + bfhi(gv[2]) * v[5]);
          o[3] = pk2(m1[2] + bflo(gv[3]) * v[6], m1[3] + bfhi(gv[3]) * v[7]);
          *(GAS u32x4*)(R0 + R_MG + ((size_t)row * 1024 + col) * 2) = o;
        }
      } else if constexpr (MODE == MD_G3) {
        const int tg = g * TG + row;
        if constexpr (PH == 0) {
          const GAS float* xin = (l == 0 ? (const GAS float*)p.x : (const GAS float*)(p.ws + OFF_XB)) + (size_t)tg * 1024 + col;
          rb.b0[bj] = *(const GAS f32x4*)xin; rb.b1[bj] = *(const GAS f32x4*)(xin + 4);
        } else {
          GAS float* dst = (GAS float*)(p.ws + OFF_XB) + (size_t)tg * 1024 + col;
          f32x4 o0, o1;
#pragma unroll
          for (int i = 0; i < 4; ++i) { o0[i] = ALPHA * rb.b0[bj][i] + (1.f + ub.c0[bj][i]) * v[i]; o1[i] = ALPHA * rb.b1[bj][i] + (1.f + ub.c1[bj][i]) * v[4 + i]; }
          *(GAS f32x4*)dst = o0; *(GAS f32x4*)(dst + 4) = o1;
        }
      } else if constexpr (MODE == MD_G4) {
        if constexpr (PH == 1) {
          float o[8];
#pragma unroll
          for (int i = 0; i < 8; ++i) { const float hh = fmaxf(v[i] + (i < 4 ? ub.c0[bj][i & 3] : ub.c1[bj][i & 3]), 0.f); o[i] = hh * hh; }
          u32x4 ov;
#pragma unroll
          for (int i = 0; i < 4; ++i) ov[i] = pk2(o[2 * i], o[2 * i + 1]);
          *(GAS u32x4*)(R0 + ((size_t)row * 4096 + col) * 2) = ov;
        }
      } else if constexpr (MODE == MD_G5) {
        GAS float* dst = (GAS float*)(p.ws + OFF_XB) + (size_t)row * 1024 + col;
        if constexpr (PH == 0) { rb.b0[bj] = *(const GAS f32x4*)dst; rb.b1[bj] = *(const GAS f32x4*)(dst + 4); }
        else {
          f32x4 o0, o1;
#pragma unroll
          for (int i = 0; i < 4; ++i) { o0[i] = ALPHA * rb.b0[bj][i] + (1.f + ub.c0[bj][i]) * (v[i] + ub.d0[bj][i]); o1[i] = ALPHA * rb.b1[bj][i] + (1.f + ub.c1[bj][i]) * (v[4 + i] + ub.d1[bj][i]); }
          *(GAS f32x4*)dst = o0; *(GAS f32x4*)(dst + 4) = o1;
        }
      }
    }
  }
  template <int MODE> __device__ __forceinline__ void run(const f32x4 (&acc)[2][2][4][2], const Unit& u, int wr, int wc, int fr, int fq) const {
    UnitBuf ub; unitload<MODE>(ub, u, wc, fq);
#define RB2(AI, M0, M1) { RowBuf r0, r1; \
      rowf<MODE, AI, M0, 0>(acc, r0, ub, u, wr, wc, fr, fq); rowf<MODE, AI, M1, 0>(acc, r1, ub, u, wr, wc, fr, fq); \
      rowf<MODE, AI, M0, 1>(acc, r0, ub, u, wr, wc, fr, fq); rowf<MODE, AI, M1, 1>(acc, r1, ub, u, wr, wc, fr, fq); }
    RB2(0, 0, 1) RB2(0, 2, 3) RB2(1, 0, 1) RB2(1, 2, 3)
#undef RB2
  }
  __device__ __forceinline__ void operator()(const f32x4 (&acc)[2][2][4][2], const Unit& u, int wr, int wc, int fr, int fq) const {
    asm volatile("" : "+v"(fr), "+v"(fq));
    switch (mode) {
      case MD_G1A: run<MD_G1A>(acc, u, wr, wc, fr, fq); break;
      case MD_G1S: run<MD_G1S>(acc, u, wr, wc, fr, fq); break;
      case MD_G1B: run<MD_G1B>(acc, u, wr, wc, fr, fq); break;
      case MD_G2A: run<MD_G2A>(acc, u, wr, wc, fr, fq); break;
      case MD_G2B: run<MD_G2B>(acc, u, wr, wc, fr, fq); break;
      case MD_G3: run<MD_G3>(acc, u, wr, wc, fr, fq); break;
      case MD_G4: run<MD_G4>(acc, u, wr, wc, fr, fq); break;
      default: run<MD_G5>(acc, u, wr, wc, fr, fq); break;
    }
  }
};
#define XB_TMO      128
#define XB_XCNT(j)  (256  + 64 * (j))
#define XB_XSUB(j)  (1280 + 64 * (j))
#define XB_XGEN(j)  (2304 + 64 * (j))
#define XB_TOP      3328
#define XB_TOPGEN   3392
#define XCD_BAR_WORDS 3456
#define XB_SPIN_CAP (1u << 18)

__device__ __forceinline__ unsigned xb_ld(unsigned* p)              { return __hip_atomic_load(p, __ATOMIC_RELAXED, __HIP_MEMORY_SCOPE_AGENT); }
__device__ __forceinline__ unsigned xb_add(unsigned* p, unsigned v) { return __hip_atomic_fetch_add(p, v, __ATOMIC_RELAXED, __HIP_MEMORY_SCOPE_AGENT); }
__device__ __forceinline__ unsigned xb_xcc_id() { return (unsigned)__builtin_amdgcn_s_getreg((3 << 11) | 20) & 0xFu; }
#define XB_SPIN(cond, bar) do { unsigned _sp = 0; while (cond) { __builtin_amdgcn_s_sleep(1); \
    if ((++_sp & 255u) == 0u) { if (xb_ld(&(bar)[XB_TMO])) break; if (_sp > XB_SPIN_CAP) { atomicAdd(&(bar)[XB_TMO], 1u); break; } } } } while (0)

struct XcdBarrier {
    unsigned* bar; unsigned x;
    volatile LAS unsigned* st;
};

__device__ __forceinline__ XcdBarrier xcd_barrier_post(unsigned* bar, volatile LAS unsigned* st) {
    XcdBarrier b; b.bar = bar; b.x = xb_xcc_id(); b.st = st;
    if (threadIdx.x == 0) (void)xb_add(&bar[XB_XCNT(b.x)], 1u);
    return b;
}
__device__ __forceinline__ void xcd_barrier_complete(unsigned* bar, unsigned x, unsigned& nloc, unsigned& nx) {
    const unsigned G = gridDim.x * gridDim.y * gridDim.z;
    unsigned sum, cnt, mine, sp = 0u;
    for (;;) {
        sum = 0u; cnt = 0u; mine = 0u;
#pragma unroll
        for (unsigned j = 0; j < 16; ++j) { const unsigned c = xb_ld(&bar[XB_XCNT(j)]); sum += c; cnt += (c > 0u) ? 1u : 0u; mine = (j == x) ? c : mine; }
        if (sum == G) break;
        __builtin_amdgcn_s_sleep(1);
        if ((++sp & 255u) == 0u) { if (xb_ld(&bar[XB_TMO])) break; if (sp > XB_SPIN_CAP) { atomicAdd(&bar[XB_TMO], 1u); break; } }
    }
    nloc = mine > 0u ? mine : 1u; nx = cnt > 0u ? cnt : 1u;
}

__device__ __forceinline__ void xcd_barrier(const XcdBarrier& b) {
    asm volatile("s_waitcnt vmcnt(0)" ::: "memory");
    __syncthreads();
    if (threadIdx.x == 0) {
        unsigned* bar = b.bar;
        __builtin_amdgcn_s_waitcnt(0);
        unsigned nloc = b.st[0], nx = b.st[1];
        if (nloc == 0u) { xcd_barrier_complete(bar, b.x, nloc, nx); b.st[0] = nloc; b.st[1] = nx; }
        const unsigned old = xb_add(&bar[XB_XSUB(b.x)], 1u);
        const unsigned gen = old / nloc;
        if (old + 1u == (gen + 1u) * nloc) {
            __builtin_amdgcn_fence(__ATOMIC_RELEASE, "agent");
            asm volatile("s_waitcnt vmcnt(0)" ::: "memory");
            const unsigned og = xb_add(&bar[XB_TOP], 1u);
            const unsigned tg = og / nx;
            if (og + 1u == (tg + 1u) * nx) xb_add(&bar[XB_TOPGEN], 1u);
            else XB_SPIN(xb_ld(&bar[XB_TOPGEN]) == tg, bar);
            __builtin_amdgcn_fence(__ATOMIC_ACQUIRE, "agent");
            xb_add(&bar[XB_XGEN(b.x)], 1u);
            asm volatile("s_waitcnt vmcnt(0)" ::: "memory");
        } else {
            XB_SPIN(xb_ld(&bar[XB_XGEN(b.x)]) == gen, bar);
            __builtin_amdgcn_fence(__ATOMIC_ACQUIRE, "agent");
            asm volatile("s_waitcnt vmcnt(0)" ::: "memory");
        }
    }
    __syncthreads();
}

__device__ __forceinline__ void gbar(unsigned* bar0, volatile LAS unsigned* st) {
    XcdBarrier b; b.bar = bar0; asm volatile("" : "+s"(b.bar)); b.x = (unsigned)__builtin_amdgcn_readfirstlane((int)xb_xcc_id()); asm volatile("" : "+s"(b.x)); b.st = st; xcd_barrier(b);
}
__device__ __forceinline__ void conv_job(ldsp lds, int wv, const float* src, int ld, int K, int c0, int ncols, bf16_t* dst) {
  LAS float* tile = (LAS float*)lds;
  const int tid = otid(wv), ntk = K >> 6, ntn = ncols >> 6, nt = ntk * ntn;
  const int rr = tid >> 6, cc = tid & 63, kp = tid & 31, nn = tid >> 5;
  int t = obid();
  float reg[8];
  if (t < nt) { const int tk = t / ntn, tn = t - tk * ntn;
#pragma unroll
    for (int i = 0; i < 8; ++i) reg[i] = src[(size_t)((tk << 6) + i * 8 + rr) * ld + c0 + (tn << 6) + cc]; }
  for (; t < nt; t += gridDim.x) {
    const int tk = t / ntn, tn = t - tk * ntn, k0 = tk << 6, n0 = tn << 6;
    __syncthreads();
#pragma unroll
    for (int i = 0; i < 8; ++i) tile[(i * 8 + rr) * 65 + cc] = reg[i];
    __syncthreads();
    const int t2 = t + gridDim.x;
    if (t2 < nt) { const int tk2 = t2 / ntn, tn2 = t2 - tk2 * ntn;
#pragma unroll
      for (int i = 0; i < 8; ++i) reg[i] = src[(size_t)((tk2 << 6) + i * 8 + rr) * ld + c0 + (tn2 << 6) + cc]; }
#pragma unroll
    for (int i = 0; i < 4; ++i) { const int n = nn + 16 * i; *(unsigned*)(dst + (size_t)(n0 + n) * K + k0 + 2 * kp) = pk2(tile[(2 * kp) * 65 + n], tile[(2 * kp + 1) * 65 + n]); }
  }
  __syncthreads();
}
__device__ __forceinline__ void phase_conv(ldsp lds, const Params& p, int l) {
  bf16_t* WB = (bf16_t*)(p.ws + OFF_WB);
  const float* win = p.w_in + (size_t)l * 1024 * 12288;
  conv_job(lds, p.wv, win, 12288, 1024, 0, 1024, WB + W1A);
  conv_job(lds, p.wv, win, 12288, 1024, 1024, 1024, WB + W1A + 1024ull * 1024);
  conv_job(lds, p.wv, win, 12288, 1024, 4096, 2048, WB + W1A + 2048ull * 1024);
  conv_job(lds, p.wv, win, 12288, 1024, 2048, 1024, WB + W1S);
  conv_job(lds, p.wv, win, 12288, 1024, 6144, 2048, WB + W1S + 1024ull * 1024);
  conv_job(lds, p.wv, win, 12288, 1024, 3072, 1024, WB + W1B);
  conv_job(lds, p.wv, win, 12288, 1024, 8192, 4096, WB + W1B + 1024ull * 1024);
  conv_job(lds, p.wv, p.w_pa + (size_t)l * 1024 * 1024, 1024, 1024, 0, 1024, WB + WPA);
  conv_job(lds, p.wv, p.w_pb + (size_t)l * 2048 * 1024, 1024, 2048, 0, 1024, WB + WPB);
  conv_job(lds, p.wv, p.w_o + (size_t)l * 1024 * 1024, 1024, 1024, 0, 1024, WB + WO);
  conv_job(lds, p.wv, p.w_up + (size_t)l * 1024 * 4096, 4096, 1024, 0, 4096, WB + WUP);
  conv_job(lds, p.wv, p.w_down + (size_t)l * 4096 * 1024, 1024, 4096, 0, 1024, WB + WDN);
}
__device__ __forceinline__ void phase_mod(ldsp lds, const Params& p) {
  float* small = (float*)(p.ws + OFF_SMALL);
  const int tid = otid(p.wv);
  const int bid = obid();
  if (bid < 192) {
    LAS float* cond = (LAS float*)lds;
    LAS float* part = (LAS float*)(lds + 32768);
    for (int i = tid; i < 8192; i += 512) cond[i] = siluf_(p.c[i]);
    __syncthreads();
    const int o0 = bid * 64, l = o0 / 6144, n0 = o0 - l * 6144, nl = tid & 63, kq = tid >> 6;
    const float* w = p.w_ada + (size_t)l * 1024 * 6144 + n0 + nl + (size_t)(kq * 128) * 6144;
    float a[8];
#pragma unroll
    for (int b = 0; b < 8; ++b) a[b] = 0.f;
#pragma unroll 8
    for (int k = 0; k < 128; ++k) {
      const float wv = w[(size_t)k * 6144];
#pragma unroll
      for (int b = 0; b < 8; ++b) a[b] += cond[b * 1024 + kq * 128 + k] * wv;
    }
#pragma unroll
    for (int b = 0; b < 8; ++b) part[(kq * 8 + b) * 64 + nl] = a[b];
    __syncthreads();
    {
      const int b = tid >> 6; float s = 0.f;
#pragma unroll
      for (int q = 0; q < 8; ++q) s += part[(q * 8 + b) * 64 + nl];
      small[SM_MOD + (size_t)l * 8 * 6144 + b * 6144 + n0 + nl] = s + p.b_ada[l * 6144 + n0 + nl];
    }
    __syncthreads();
  } else if (bid == 192) {
    for (int i = tid; i < 1024; i += 512) {
      const float a = p.lb_logits[i], b = p.lb_logits[1024 + i], mx = fmaxf(a, b);
      const float ea = __expf(a - mx), eb = __expf(b - mx);
      small[SM_LB + i] = 0.f; small[SM_LB + 1024 + i] = eb / (ea + eb);
    }
  }
}
__device__ __forceinline__ void phase_u0(const Params& p) {
  const float* mod = (const float*)(p.ws + OFF_SMALL) + SM_MOD;
  bf16_t* U = (bf16_t*)(p.ws + OFF_U);
  const size_t n4 = (size_t)T_ALL * 1024 / 4;
  for (size_t i = (size_t)obid() * 512 + otid(p.wv); i < n4; i += (size_t)gridDim.x * 512) {
    const size_t e = i * 4; const int t = (int)(e >> 10), cc = (int)(e & 1023), b = t >> 12;
    const f32x4 xv = *(const f32x4*)(p.x + e), sh = *(const f32x4*)(mod + b * 6144 + cc), sc = *(const f32x4*)(mod + b * 6144 + 1024 + cc);
    u32x2 o; o[0] = pk2(xv[0] * (1.f + sc[0]) + sh[0], xv[1] * (1.f + sc[1]) + sh[1]); o[1] = pk2(xv[2] * (1.f + sc[2]) + sh[2], xv[3] * (1.f + sc[3]) + sh[3]);
    *(u32x2*)(U + e) = o;
  }
}
__device__ __forceinline__ void phase_ln(const Params& p, const float* gam, const float* bet, int lm, int s_shift, bool fin) {
  float* XB = (float*)(p.ws + OFF_XB);
  const float* mod = (const float*)(p.ws + OFF_SMALL) + SM_MOD + (size_t)lm * 8 * 6144;
  bf16_t* U = (bf16_t*)(p.ws + OFF_U);
  const int tid_ = otid(p.wv); const int lane = tid_ & 63, gw = obid() * 8 + (tid_ >> 6), nw = gridDim.x * 8;
  for (int row = gw; row < T_ALL; row += nw) {
    const float* src = XB + (size_t)row * 1024;
    f32x4 v[4]; float s = 0.f;
#pragma unroll
    for (int k = 0; k < 4; ++k) { v[k] = *(const f32x4*)(src + 256 * k + 4 * lane); s += v[k][0] + v[k][1] + v[k][2] + v[k][3]; }
    const float mu = wave_sum(s, lane) * (1.0f / 1024.0f);
    float q = 0.f;
#pragma unroll
    for (int k = 0; k < 4; ++k)
#pragma unroll
      for (int i = 0; i < 4; ++i) { const float d = v[k][i] - mu; q += d * d; }
    const float rstd = rsqrtf(wave_sum(q, lane) * (1.0f / 1024.0f) + 1e-5f);
    const int b = row >> 12;
#pragma unroll
    for (int k = 0; k < 4; ++k) {
      const int cc = 256 * k + 4 * lane;
      const f32x4 gg = *(const f32x4*)(gam + cc), bb = *(const f32x4*)(bet + cc);
      f32x4 y;
#pragma unroll
      for (int i = 0; i < 4; ++i) y[i] = (v[k][i] - mu) * rstd * gg[i] + bb[i];
      if (fin) { *(f32x4*)(p.out + (size_t)row * 1024 + cc) = y; }
      else {
        *(f32x4*)(XB + (size_t)row * 1024 + cc) = y;
        const f32x4 sh = *(const f32x4*)(mod + b * 6144 + s_shift * 1024 + cc), sc = *(const f32x4*)(mod + b * 6144 + (s_shift + 1) * 1024 + cc);
        u32x2 o; o[0] = pk2(y[0] * (1.f + sc[0]) + sh[0], y[1] * (1.f + sc[1]) + sh[1]); o[1] = pk2(y[2] * (1.f + sc[2]) + sh[2], y[3] * (1.f + sc[3]) + sh[3]);
        *(u32x2*)(U + (size_t)row * 1024 + cc) = o;
      }
    }
  }
}
typedef short s16x4 __attribute__((ext_vector_type(4)));
template <class V, class T> __device__ __forceinline__ V gld(const T* q) { return *(const GAS V*)q; }
template <class V, class T> __device__ __forceinline__ void gst(T* q, V v) { *(GAS V*)q = v; }
template <class T> __device__ __forceinline__ T* vaddr(T* q) { asm volatile("" : "+v"(q)); return q; }
__device__ __forceinline__ void stat_add2(float* addr, float a, float b) {
  unsigned long long sv;
  asm volatile("s_mov_b64 %0, exec\n\ts_mov_b64 exec, 0xffff\n\tglobal_atomic_add_f32 %1, %2, off\n\tglobal_atomic_add_f32 %1, %3, off offset:4\n\ts_mov_b64 exec, %0"
               : "=&s"(sv) : "v"(addr), "v"(a), "v"(b) : "memory");
}
__device__ __forceinline__ void stat_add1(float* addr, float a) {
  unsigned long long sv;
  asm volatile("s_mov_b64 %0, exec\n\ts_mov_b64 exec, 0xffff\n\tglobal_atomic_add_f32 %1, %2, off\n\ts_mov_b64 exec, %0"
               : "=&s"(sv) : "v"(addr), "v"(a) : "memory");
}
__device__ __forceinline__ void ret_item(ldsp lds, const Params& p, int item, bool do_stats) {
  constexpr int KS = 0, VTS = 33792, STS = 43008, PS = 76800;
  const int es = item & 7, h = (item >> 3) & 3, bl = item >> 5;
  const int tid = otid(p.wv), w = tid >> 6, lane = tid & 63, fr = lane & 15, fq = lane >> 4;
  unsigned char* R0 = oaddr(p.ws) + OFF_R0; unsigned char* DO = (unsigned char*)oaddr(p.out);
  const bf16_t* Qr = (const bf16_t*)(R0 + R_QR); const bf16_t* Kr = (const bf16_t*)(R0 + R_KR);
  const bf16_t* VrT = (const bf16_t*)(DO + D_VRT); bf16_t* OrB = (bf16_t*)(R0 + R_ORB);
  float* stR = (float*)(p.ws + OFF_SMALL) + SM_STR;
  const float gam = 1.0f - __builtin_amdgcn_exp2f(-5.0f - (float)h), lg2 = __log2f(gam), g64 = __builtin_amdgcn_exp2f(lg2 * 64.0f);
  const int it = w >> 1, eh = w & 1;
  f32x4 st[2][4];
#pragma unroll
  for (int a = 0; a < 2; ++a)
#pragma unroll
    for (int b = 0; b < 4; ++b) st[a][b] = (f32x4){0.f, 0.f, 0.f, 0.f};
  const float rowscale = __builtin_amdgcn_exp2f(lg2 * (float)(16 * it + fr - 63));
  u32x4 kreg[4], vtreg; bf16x8 qn[8];
#define RET_LOADS(TOK) do { \
    const bf16_t* kbase = vaddr(Kr + (size_t)((TOK) + (tid >> 5)) * 1024 + h * 256 + (tid & 31) * 8); \
    const bf16_t* vtbase = vaddr(VrT + (size_t)(h * 512 + es * 64 + (tid >> 3)) * TG + (TOK) + (tid & 7) * 8); \
    const bf16_t* qbase = vaddr(Qr + (size_t)((TOK) + 16 * it + fr) * 1024 + h * 256 + fq * 8); \
    _Pragma("unroll") for (int i = 0; i < 4; ++i) kreg[i] = gld<u32x4>(kbase + (size_t)i * 16 * 1024); \
    vtreg = gld<u32x4>(vtbase); \
    _Pragma("unroll") for (int ks = 0; ks < 8; ++ks) qn[ks] = gld<bf16x8>(qbase + ks * 32); } while (0)
  RET_LOADS(bl * SEQ);
  for (int n = 0; n < 64; ++n) {
    const int tok0 = bl * SEQ + n * 64;
    bf16x8 qf[8];
    bf16_t* obase = vaddr(OrB + (size_t)(tok0 + 16 * it + fr) * 2048 + h * 512 + es * 64 + 32 * eh + 4 * fq);
    float* sbase = vaddr(stR + ((size_t)(tok0 + 16 * it + fr) * 4 + h) * 2);
#pragma unroll
    for (int ks = 0; ks < 8; ++ks) qf[ks] = qn[ks];
    __builtin_amdgcn_sched_barrier(0);
#pragma unroll
    for (int dt = 0; dt < 2; ++dt)
#pragma unroll
      for (int et = 0; et < 4; ++et) {
        u32x2 o; o[0] = pk2(st[dt][et][0], st[dt][et][1]); o[1] = pk2(st[dt][et][2], st[dt][et][3]);
        *(LAS u32x2*)(lds + STS + (16 * et + fr) * 528 + (32 * w + 16 * dt + 4 * fq) * 2) = o;
      }
#pragma unroll
    for (int i = 0; i < 4; ++i) { const int c = tid + 512 * i, r = c >> 5, ch = c & 31; *(LAS u32x4*)(lds + KS + r * 528 + ch * 16) = kreg[i]; }
    { const int r = tid >> 3, ch = tid & 7; *(LAS u32x4*)(lds + VTS + r * 144 + ch * 16) = vtreg; }
    __syncthreads();
    { const int tokn = bl * SEQ + (n < 63 ? n + 1 : 63) * 64; RET_LOADS(tokn); }
    f32x4 oacc[2];
    {
      bf16x8 k0[8], k1[8];
#pragma unroll
      for (int ks = 0; ks < 8; ++ks) { k0[ks] = ldfrag(lds, KS + (16 * (2 * eh) + fr) * 528 + (32 * ks + 8 * fq) * 2); k1[ks] = ldfrag(lds, KS + (16 * (2 * eh + 1) + fr) * 528 + (32 * ks + 8 * fq) * 2); }
      __builtin_amdgcn_sched_barrier(0);
      f32x4 s0 = (f32x4){0.f, 0.f, 0.f, 0.f}, s1_ = (f32x4){0.f, 0.f, 0.f, 0.f};
#pragma unroll
      for (int ks = 0; ks < 8; ++ks) { s0 = mfma16(k0[ks], qf[ks], s0); s1_ = mfma16(k1[ks], qf[ks], s1_); }
      const int i_ = 16 * it + fr;
      { const int j0 = 16 * (2 * eh) + 4 * fq;
        u32x2 o; o[0] = pk2(j0 + 0 <= i_ ? s0[0] : 0.f, j0 + 1 <= i_ ? s0[1] : 0.f); o[1] = pk2(j0 + 2 <= i_ ? s0[2] : 0.f, j0 + 3 <= i_ ? s0[3] : 0.f);
        *(LAS u32x2*)(lds + PS + i_ * 144 + j0 * 2) = o; }
      { const int j0 = 16 * (2 * eh + 1) + 4 * fq;
        u32x2 o; o[0] = pk2(j0 + 0 <= i_ ? s1_[0] : 0.f, j0 + 1 <= i_ ? s1_[1] : 0.f); o[1] = pk2(j0 + 2 <= i_ ? s1_[2] : 0.f, j0 + 3 <= i_ ? s1_[3] : 0.f);
        *(LAS u32x2*)(lds + PS + i_ * 144 + j0 * 2) = o; }
    }
    __builtin_amdgcn_sched_barrier(0);
    {
      bf16x8 a0[8], a1[8];
#pragma unroll
      for (int ks = 0; ks < 8; ++ks) { a0[ks] = ldfrag(lds, STS + (16 * (2 * eh) + fr) * 528 + (32 * ks + 8 * fq) * 2); a1[ks] = ldfrag(lds, STS + (16 * (2 * eh + 1) + fr) * 528 + (32 * ks + 8 * fq) * 2); }
      __builtin_amdgcn_sched_barrier(0);
      f32x4 o0 = (f32x4){0.f, 0.f, 0.f, 0.f}, o1 = (f32x4){0.f, 0.f, 0.f, 0.f};
#pragma unroll
      for (int ks = 0; ks < 8; ++ks) { o0 = mfma16(a0[ks], qf[ks], o0); o1 = mfma16(a1[ks], qf[ks], o1); }
      oacc[0] = o0; oacc[1] = o1;
    }
    __builtin_amdgcn_sched_barrier(0);
    {
      bf16x8 vf[2][4]; s16x4 t[2][2][2];
#pragma unroll
      for (int k2 = 0; k2 < 2; ++k2) {
#pragma unroll
        for (int et = 0; et < 4; ++et) vf[k2][et] = ldfrag(lds, VTS + (16 * et + fr) * 144 + (32 * k2 + 8 * fq) * 2);
#pragma unroll
        for (int dt = 0; dt < 2; ++dt) {
          const int a0_ = KS + (32 * k2 + 8 * fq + (fr >> 2)) * 528 + (32 * w + 16 * dt + 4 * (fr & 3)) * 2;
          t[k2][dt][0] = __builtin_amdgcn_ds_read_tr16_b64_v4i16((LAS s16x4*)(lds + a0_));
          t[k2][dt][1] = __builtin_amdgcn_ds_read_tr16_b64_v4i16((LAS s16x4*)(lds + a0_ + 4 * 528));
        }
      }
      __builtin_amdgcn_sched_barrier(0);
#pragma unroll
      for (int k2 = 0; k2 < 2; ++k2)
#pragma unroll
        for (int dt = 0; dt < 2; ++dt) {
          const bf16x8 kf = (bf16x8){t[k2][dt][0][0], t[k2][dt][0][1], t[k2][dt][0][2], t[k2][dt][0][3], t[k2][dt][1][0], t[k2][dt][1][1], t[k2][dt][1][2], t[k2][dt][1][3]};
#pragma unroll
          for (int et = 0; et < 4; ++et) st[dt][et] = mfma16(kf, vf[k2][et], st[dt][et]);
        }
    }
#pragma unroll
    for (int dt = 0; dt < 2; ++dt)
#pragma unroll
      for (int et = 0; et < 4; ++et)
#pragma unroll
        for (int r = 0; r < 4; ++r) st[dt][et][r] *= g64;
    __syncthreads();
    float s1 = 0.f, s2 = 0.f;
    {
      bf16x8 pv[2], vv[2][2];
#pragma unroll
      for (int k2 = 0; k2 < 2; ++k2) {
        pv[k2] = ldfrag(lds, PS + (16 * it + fr) * 144 + (32 * k2 + 8 * fq) * 2);
        vv[0][k2] = ldfrag(lds, VTS + (16 * (2 * eh) + fr) * 144 + (32 * k2 + 8 * fq) * 2);
        vv[1][k2] = ldfrag(lds, VTS + (16 * (2 * eh + 1) + fr) * 144 + (32 * k2 + 8 * fq) * 2);
      }
      __builtin_amdgcn_sched_barrier(0);
#pragma unroll
      for (int ee = 0; ee < 2; ++ee) {
        f32x4 o = oacc[ee];
#pragma unroll
        for (int k2 = 0; k2 < 2; ++k2) o = mfma16(vv[ee][k2], pv[k2], o);
#pragma unroll
        for (int r = 0; r < 4; ++r) { o[r] *= rowscale; s1 += o[r]; s2 += o[r] * o[r]; }
        u32x2 ov; ov[0] = pk2(o[0], o[1]); ov[1] = pk2(o[2], o[3]);
        gst<u32x2>(obase + 16 * ee, ov);
      }
    }
    s1 += shx(s1, 16, lane); s1 += shx(s1, 32, lane); s2 += shx(s2, 16, lane); s2 += shx(s2, 32, lane);
    if (do_stats) stat_add2(sbase, s1, s2);
    __syncthreads();
  }
}
__device__ __forceinline__ void hgrn_item(ldsp lds, const Params& p, int item, bool do_stats) {
  constexpr int QT = 0, KT = 17408, QB = 34816, KBT = 52224, VTS = 70656, STS = 75264, PS = 83968, TOT = 93184, DEC = 97280;
  const int es = item & 3, h = (item >> 2) & 7, bl = item >> 5;
  const int tid = otid(p.wv), w = tid >> 6, lane = tid & 63, fr = lane & 15, fq = lane >> 4;
  unsigned char* R0 = oaddr(p.ws) + OFF_R0; unsigned char* DO = (unsigned char*)oaddr(p.out);
  const bf16_t* Qh = (const bf16_t*)(R0 + R_QH); const float* LF = (const float*)(DO + D_LF); const bf16_t* ViT = (const bf16_t*)(R0 + R_VIT);
  bf16_t* OrA = (bf16_t*)(R0 + R_ORA);
  float* stH = (float*)(p.ws + OFF_SMALL) + SM_STH;
  LAS float* tot = (LAS float*)(lds + TOT); LAS float* dec = (LAS float*)(lds + DEC);
  const int it = w >> 1, eh = w & 1, d0 = 2 * lane;
  f32x4 st[2];
  st[0] = (f32x4){0.f, 0.f, 0.f, 0.f}; st[1] = (f32x4){0.f, 0.f, 0.f, 0.f};
  float lxn[8], lyn[8]; unsigned q2n[8]; u32x4 vtreg;
#define HG_LOADS(TOK) do { \
    const float* lfbase = vaddr(LF + (size_t)((TOK) + 8 * w) * 1024 + h * 128 + d0); \
    const bf16_t* qhbase = vaddr(Qh + (size_t)((TOK) + 8 * w) * 1024 + h * 128 + d0); \
    const bf16_t* vtbase = vaddr(ViT + (size_t)(h * 128 + es * 32 + ((tid & 255) >> 3)) * TG + (TOK) + (tid & 7) * 8); \
    _Pragma("unroll") for (int jj = 0; jj < 8; ++jj) { \
      const f32x2_ t = gld<f32x2_>(lfbase + (size_t)jj * 1024); lxn[jj] = t[0]; lyn[jj] = t[1]; q2n[jj] = gld<unsigned>(qhbase + (size_t)jj * 1024); } \
    vtreg = gld<u32x4>(vtbase); } while (0)
  HG_LOADS(bl * SEQ);
  for (int n = 0; n < 64; ++n) {
    const int tok0 = bl * SEQ + n * 64;
    float lx[8], ly[8]; unsigned q2[8];
    bf16_t* obase = vaddr(OrA + (size_t)(tok0 + 16 * it + fr) * 1024 + h * 128 + es * 32 + 16 * eh + 4 * fq);
    float* sbase = vaddr(stH + (size_t)(tok0 + 16 * it + fr) * 8 + h);
#pragma unroll
    for (int jj = 0; jj < 8; ++jj) { lx[jj] = lxn[jj]; ly[jj] = lyn[jj]; q2[jj] = q2n[jj]; }
    __builtin_amdgcn_sched_barrier(0);
    float px[8], py[8]; float cx = 0.f, cy = 0.f;
#pragma unroll
    for (int jj = 0; jj < 8; ++jj) { cx += lx[jj]; cy += ly[jj]; px[jj] = cx; py[jj] = cy; }
    tot[w * 128 + d0] = cx; tot[w * 128 + d0 + 1] = cy;
#pragma unroll
    for (int et = 0; et < 2; ++et) {
      u32x2 o; o[0] = pk2(st[et][0], st[et][1]); o[1] = pk2(st[et][2], st[et][3]);
      *(LAS u32x2*)(lds + STS + (16 * et + fr) * 272 + (16 * w + 4 * fq) * 2) = o;
    }
    if (tid < 256) { const int r = tid >> 3, ch = tid & 7; *(LAS u32x4*)(lds + VTS + r * 144 + ch * 16) = vtreg; }
    __syncthreads();
    { const int tokn = bl * SEQ + (n < 63 ? n + 1 : 63) * 64; HG_LOADS(tokn); }
    float offx = 0.f, offy = 0.f, rx = 0.f, ry = 0.f, bx = 0.f, by = 0.f;
#pragma unroll
    for (int q = 0; q < 8; ++q) {
      const float tx = tot[q * 128 + d0], ty = tot[q * 128 + d0 + 1];
      if (q < w) { offx += tx; offy += ty; }
      if (q < 4) { rx += tx; ry += ty; }
      bx += tx; by += ty;
    }
    if (w == 0) { dec[d0] = __expf(bx); dec[d0 + 1] = __expf(by); }
    unsigned kbx[4], kby[4];
    const float L2E = 1.4426950408889634f;
    const float erx = __builtin_amdgcn_exp2f(rx * L2E), ery = __builtin_amdgcn_exp2f(ry * L2E);
    const float ebx = __builtin_amdgcn_exp2f((bx - rx) * L2E), eby = __builtin_amdgcn_exp2f((by - ry) * L2E);
#pragma unroll
    for (int jj = 0; jj < 8; ++jj) {
      const float Bx = offx + px[jj], By = offy + py[jj];
      const float qx = bflo(q2[jj]), qy = bfhi(q2[jj]);
      const float kx = 1.0f - __builtin_amdgcn_exp2f(lx[jj] * L2E), ky = 1.0f - __builtin_amdgcn_exp2f(ly[jj] * L2E);
      const float e1x = __builtin_amdgcn_exp2f(__builtin_amdgcn_fmed3f((Bx - rx) * L2E, -115.f, 115.f)), e1y = __builtin_amdgcn_exp2f(__builtin_amdgcn_fmed3f((By - ry) * L2E, -115.f, 115.f));
      const float e2x = __builtin_amdgcn_rcpf(e1x), e2y = __builtin_amdgcn_rcpf(e1y);
      const float qtx = qx * e1x, qty = qy * e1y, ktx = kx * e2x, kty = ky * e2y;
      const int j = 8 * w + jj;
      *(LAS unsigned*)(lds + QT + j * 272 + d0 * 2) = pk2(qtx, qty);
      *(LAS unsigned*)(lds + KT + j * 272 + d0 * 2) = pk2(ktx, kty);
      *(LAS unsigned*)(lds + QB + j * 272 + d0 * 2) = pk2(qtx * erx, qty * ery);
      const float kbvx = ktx * ebx, kbvy = kty * eby;
      if (jj & 1) { kbx[jj >> 1] = pk2(__uint_as_float(kbx[jj >> 1]), kbvx); kby[jj >> 1] = pk2(__uint_as_float(kby[jj >> 1]), kbvy); }
      else { kbx[jj >> 1] = __float_as_uint(kbvx); kby[jj >> 1] = __float_as_uint(kbvy); }
    }
    *(LAS u32x4*)(lds + KBT + d0 * 144 + (8 * w) * 2) = (u32x4){kbx[0], kbx[1], kbx[2], kbx[3]};
    *(LAS u32x4*)(lds + KBT + (d0 + 1) * 144 + (8 * w) * 2) = (u32x4){kby[0], kby[1], kby[2], kby[3]};
    __syncthreads();
    f32x4 oacc;
    {
      bf16x8 k0[4], k1[4], qt[4];
#pragma unroll
      for (int ks = 0; ks < 4; ++ks) {
        qt[ks] = ldfrag(lds, QT + (16 * it + fr) * 272 + (32 * ks + 8 * fq) * 2);
        k0[ks] = ldfrag(lds, KT + (16 * (2 * eh) + fr) * 272 + (32 * ks + 8 * fq) * 2);
        k1[ks] = ldfrag(lds, KT + (16 * (2 * eh + 1) + fr) * 272 + (32 * ks + 8 * fq) * 2);
      }
      __builtin_amdgcn_sched_barrier(0);
      f32x4 s0 = (f32x4){0.f, 0.f, 0.f, 0.f}, s1_ = (f32x4){0.f, 0.f, 0.f, 0.f};
#pragma unroll
      for (int ks = 0; ks < 4; ++ks) { s0 = mfma16(k0[ks], qt[ks], s0); s1_ = mfma16(k1[ks], qt[ks], s1_); }
      const int i_ = 16 * it + fr;
      { const int j0 = 16 * (2 * eh) + 4 * fq;
        u32x2 o; o[0] = pk2(j0 + 0 <= i_ ? s0[0] : 0.f, j0 + 1 <= i_ ? s0[1] : 0.f); o[1] = pk2(j0 + 2 <= i_ ? s0[2] : 0.f, j0 + 3 <= i_ ? s0[3] : 0.f);
        *(LAS u32x2*)(lds + PS + i_ * 144 + j0 * 2) = o; }
      { const int j0 = 16 * (2 * eh + 1) + 4 * fq;
        u32x2 o; o[0] = pk2(j0 + 0 <= i_ ? s1_[0] : 0.f, j0 + 1 <= i_ ? s1_[1] : 0.f); o[1] = pk2(j0 + 2 <= i_ ? s1_[2] : 0.f, j0 + 3 <= i_ ? s1_[3] : 0.f);
        *(LAS u32x2*)(lds + PS + i_ * 144 + j0 * 2) = o; }
    }
    __builtin_amdgcn_sched_barrier(0);
    {
      bf16x8 sa[4], qb[4], kf[2], vf[2][2];
#pragma unroll
      for (int ks = 0; ks < 4; ++ks) { sa[ks] = ldfrag(lds, STS + (16 * eh + fr) * 272 + (32 * ks + 8 * fq) * 2); qb[ks] = ldfrag(lds, QB + (16 * it + fr) * 272 + (32 * ks + 8 * fq) * 2); }
#pragma unroll
      for (int k2 = 0; k2 < 2; ++k2) {
        kf[k2] = ldfrag(lds, KBT + (16 * w + fr) * 144 + (32 * k2 + 8 * fq) * 2);
        vf[k2][0] = ldfrag(lds, VTS + (fr) * 144 + (32 * k2 + 8 * fq) * 2); vf[k2][1] = ldfrag(lds, VTS + (16 + fr) * 144 + (32 * k2 + 8 * fq) * 2);
      }
      const f32x4 dv = *(const LAS f32x4*)(dec + 16 * w + 4 * fq);
      __builtin_amdgcn_sched_barrier(0);
      f32x4 o = (f32x4){0.f, 0.f, 0.f, 0.f};
#pragma unroll
      for (int et = 0; et < 2; ++et)
#pragma unroll
        for (int r = 0; r < 4; ++r) st[et][r] *= dv[r];
#pragma unroll
      for (int ks = 0; ks < 4; ++ks) o = mfma16(sa[ks], qb[ks], o);
#pragma unroll
      for (int k2 = 0; k2 < 2; ++k2)
#pragma unroll
        for (int et = 0; et < 2; ++et) st[et] = mfma16(kf[k2], vf[k2][et], st[et]);
      oacc = o;
    }
    __syncthreads();
    {
      bf16x8 pv[2], vv[2];
#pragma unroll
      for (int k2 = 0; k2 < 2; ++k2) { pv[k2] = ldfrag(lds, PS + (16 * it + fr) * 144 + (32 * k2 + 8 * fq) * 2); vv[k2] = ldfrag(lds, VTS + (16 * eh + fr) * 144 + (32 * k2 + 8 * fq) * 2); }
      __builtin_amdgcn_sched_barrier(0);
      f32x4 o = oacc;
#pragma unroll
      for (int k2 = 0; k2 < 2; ++k2) o = mfma16(vv[k2], pv[k2], o);
      float s2 = o[0] * o[0] + o[1] * o[1] + o[2] * o[2] + o[3] * o[3];
      u32x2 ov; ov[0] = pk2(o[0], o[1]); ov[1] = pk2(o[2], o[3]);
      gst<u32x2>(obase, ov);
      s2 += shx(s2, 16, lane); s2 += shx(s2, 32, lane);
      if (do_stats) stat_add1(sbase, s2);
    }
    __syncthreads();
  }
}
#ifndef TSEL
#define TSEL -1
#endif
#ifndef STAGGER_TICKS
#define STAGGER_TICKS 0
#endif
#ifndef REP_RET
#define REP_RET 1
#endif
#ifndef REP_HG
#define REP_HG 1
#endif
#ifndef REP_G1
#define REP_G1 1
#endif
#ifndef REP_G2
#define REP_G2 1
#endif
#ifndef REP_G4
#define REP_G4 1
#endif
#ifndef REP_SYNC
#define REP_SYNC 1
#endif
#ifndef REP_PRO
#define REP_PRO 1
#endif
#ifndef REP_S1
#define REP_S1 1
#endif
enum { ST_G1 = 0, ST_S1, ST_G1B, ST_G2, ST_G3, ST_L1, ST_G4, ST_G5, ST_L2 };
__global__ void __launch_bounds__(512, 2) mega(Params p0) {
  extern __shared__ __attribute__((aligned(16))) unsigned char shm[];
  ldsp lds = (ldsp)shm;
  cg::grid_group grid = cg::this_grid();
  Params p = p0; p.ws = oaddr(p0.ws); p.out = oaddr(p0.out); p.wv = __builtin_amdgcn_readfirstlane((int)(threadIdx.x >> 6));
  volatile LAS unsigned* xst = (volatile LAS unsigned*)(lds + 131072);
  if (threadIdx.x < 4) xst[threadIdx.x] = 0u;
  __syncthreads();
  (void)xcd_barrier_post((unsigned*)(p0.ws + OFF_SMALL + SM_BAR_BYTES), xst);
  for (int r = 0; r < REP_PRO; ++r) {
    p.ws = oaddr(p0.ws);
    phase_mod(lds, p);
    phase_conv(lds, p, 0);
    grid.sync();
  }
  phase_u0(p);
  gbar((unsigned*)(p0.ws + OFF_SMALL + SM_BAR_BYTES), xst);
#if TSEL >= 0
  volatile LAS unsigned* tacc = (volatile LAS unsigned*)(lds + 131072 + 16);
  if (threadIdx.x == 0) tacc[0] = 0u;
#endif
  for (int pc = 0; pc < 28; ++pc) {
#if TSEL >= 0
    if (otid(p.wv) == 0) tacc[1] = (unsigned)__builtin_amdgcn_s_memrealtime();
#endif
    p.ws = oaddr(p0.ws); p.out = oaddr(p0.out);
    const bf16_t* WB = (const bf16_t*)(p.ws + OFF_WB);
    const bf16_t* U = (const bf16_t*)(p.ws + OFF_U);
    unsigned char* R0 = p.ws + OFF_R0;
    const int l = pc / 14, k = pc - l * 14;
    int g = 0, stg;
    if (k < 10) { g = k / 5; stg = k - g * 5; } else stg = ST_L1 + (k - 10);
    int nj = 0, jmode0 = 0, jmode1 = 0; const bf16_t* jA0 = nullptr; const bf16_t* jA1 = nullptr; const bf16_t* jB0 = nullptr; const bf16_t* jB1 = nullptr;
    int jM0 = 0, jM1 = 0, jN0 = 0, jN1 = 0, jK0 = 0, jK1 = 0;
    if (stg == ST_G1) {
      float* stz = (float*)(p.ws + OFF_SMALL) + SM_STR;
      for (int i = obid() * 512 + otid(p.wv); i < TG * 16; i += gridDim.x * 512) stz[i] = 0.f;
      nj = 2;
      jmode0 = MD_G1A; jA0 = U + (size_t)g * TG * 1024; jB0 = WB + W1A; jM0 = TG; jN0 = 4096; jK0 = 1024;
      jmode1 = MD_G1S; jA1 = WB + W1S; jB1 = U + (size_t)g * TG * 1024; jM1 = 3072; jN1 = TG; jK1 = 1024;
    } else if (stg == ST_S1) {
      for (int rep = 0; rep < REP_S1; ++rep) {
        if (rep) { gbar((unsigned*)(p0.ws + OFF_SMALL + SM_BAR_BYTES), xst); float* stz = (float*)(p.ws + OFF_SMALL) + SM_STR; for (int i = obid() * 512 + otid(p.wv); i < TG * 16; i += gridDim.x * 512) stz[i] = 0.f; gbar((unsigned*)(p0.ws + OFF_SMALL + SM_BAR_BYTES), xst); }
        const int bid = obid();
        if (bid < 128) { const int xcd = bid & 7, slot = bid >> 3, item = ((xcd * 2 + (slot >> 3)) << 3) | (slot & 7);
          for (int r2 = 0; r2 < REP_RET; ++r2) ret_item(lds, p, item, r2 == REP_RET - 1); }
        else { const int b2 = bid - 128, xcd = b2 & 7, slot = b2 >> 3, item = ((xcd * 4 + (slot >> 2)) << 2) | (slot & 3);
          for (int r2 = 0; r2 < REP_HG; ++r2) hgrn_item(lds, p, item, r2 == REP_HG - 1); }
      }
    } else if (stg == ST_G1B) {
      nj = 1; jmode0 = MD_G1B; jA0 = U + (size_t)g * TG * 1024; jB0 = WB + W1B; jM0 = TG; jN0 = 5120; jK0 = 1024;
    } else if (stg == ST_G2) {
      nj = 2;
      jmode0 = MD_G2A; jA0 = (const bf16_t*)(R0 + R_ORA); jB0 = WB + WPA; jM0 = TG; jN0 = 1024; jK0 = 1024;
      jmode1 = MD_G2B; jA1 = (const bf16_t*)(R0 + R_ORB); jB1 = WB + WPB; jM1 = TG; jN1 = 1024; jK1 = 2048;
    } else if (stg == ST_G3) {
      nj = 1; jmode0 = MD_G3; jA0 = (const bf16_t*)(R0 + R_MG); jB0 = WB + WO; jM0 = TG; jN0 = 1024; jK0 = 1024;
    } else if (stg == ST_L1) {
      phase_ln(p, p.ln1_g + l * 1024, p.ln1_b + l * 1024, l, 3, false);
    } else if (stg == ST_G4) {
      nj = 1; jmode0 = MD_G4; jA0 = U; jB0 = WB + WUP; jM0 = T_ALL; jN0 = 4096; jK0 = 1024;
    } else if (stg == ST_G5) {
      nj = 1; jmode0 = MD_G5; jA0 = (const bf16_t*)R0; jB0 = WB + WDN; jM0 = T_ALL; jN0 = 1024; jK0 = 4096;
    } else {
      phase_ln(p, p.ln2_g + l * 1024, p.ln2_b + l * 1024, l == 0 ? 1 : 0, 0, l == 1);
      if (l == 0) phase_conv(lds, p, 1);
    }
    for (int j = 0; j < nj * (stg == ST_G4 ? REP_G4 : 1) * (stg == ST_G1 ? REP_G1 : 1) * (stg == ST_G2 ? REP_G2 : 1); ++j) {
      pg8::Gemm gm; const bool j1 = (nj == 2 && (j & 1) == 1); gm.A = j1 ? jA1 : jA0; gm.Bt = j1 ? jB1 : jB0; gm.M = j1 ? jM1 : jM0; gm.N = j1 ? jN1 : jN0; gm.K = j1 ? jK1 : jK0;
      pg8::StaticOrder S; S.init(gm.M, gm.N, (int)gridDim.x, obid());
      EpiP E; E.mode = j1 ? jmode1 : jmode0; E.l = l; E.g = g; E.pp = &p;
#if STAGGER_TICKS > 0
      if (j == 0 && (gm.M >> 8) * (gm.N >> 8) >= 3 * (int)gridDim.x && ((obid() >> 3) & 1)) {
        const unsigned long long t0 = __builtin_amdgcn_s_memrealtime();
        while (__builtin_amdgcn_s_memrealtime() - t0 < (unsigned long long)STAGGER_TICKS) __builtin_amdgcn_s_sleep(32);
      }
#endif
      pg8::gemm_phase<EpiP, pg8::StaticOrder, false>((PG8_LAS unsigned char*)shm, gm, S, E, nullptr);
    }
    for (int r = 0; r < REP_SYNC; ++r) gbar((unsigned*)(p0.ws + OFF_SMALL + SM_BAR_BYTES), xst);
#if TSEL >= 0
    const int k2_ = pc - (pc / 14) * 14, stg2_ = k2_ < 10 ? k2_ % 5 : ST_L1 + (k2_ - 10);
    if (otid(p.wv) == 0 && ((TSEL >> stg2_) & 1)) tacc[0] = tacc[0] + ((unsigned)__builtin_amdgcn_s_memrealtime() - tacc[1]);
#endif
  }
#if TSEL >= 0
  if (obid() == 0 && otid(p.wv) == 0) { const unsigned long long t0 = __builtin_amdgcn_s_memrealtime(); const unsigned long long w = 4ull * tacc[0]; while (__builtin_amdgcn_s_memrealtime() - t0 < w) __builtin_amdgcn_s_sleep(32); }
#endif
}

extern "C" void kernel_launch(void* const* d_in, const int* in_sizes, int n_in, void* d_out, int out_size,
                              void* d_ws, size_t ws_size, hipStream_t stream) {
  constexpr size_t kDynLds = 131072 + 16 + 16;
  static int configured = 0;
  if (!configured) {
    (void)hipFuncSetAttribute((const void*)mega, hipFuncAttributeMaxDynamicSharedMemorySize, (int)kDynLds);
    configured = 1;
  }
  Params p{};
  p.x = (const float*)d_in[0]; p.c = (const float*)d_in[1]; p.pos = (const int*)d_in[2]; p.lb_logits = (const float*)d_in[3];
  p.w_ada = (const float*)d_in[4]; p.b_ada = (const float*)d_in[5]; p.w_in = (const float*)d_in[6]; p.w_pa = (const float*)d_in[7];
  p.w_pb = (const float*)d_in[8]; p.w_o = (const float*)d_in[9]; p.ln1_g = (const float*)d_in[10]; p.ln1_b = (const float*)d_in[11];
  p.w_up = (const float*)d_in[12]; p.b_up = (const float*)d_in[13]; p.w_down = (const float*)d_in[14]; p.b_down = (const float*)d_in[15];
  p.ln2_g = (const float*)d_in[16]; p.ln2_b = (const float*)d_in[17];
  p.out = (float*)d_out; p.ws = (unsigned char*)d_ws;
  if (ws_size < 512ull * 1024 * 1024) { fprintf(stderr, "workspace too small\n"); return; }
  (void)hipMemsetAsync((unsigned char*)d_ws + OFF_SMALL + SM_BAR_BYTES, 0, XCD_BAR_WORDS * 4, stream);
  void* args[] = {&p};
  hipError_t e = hipLaunchCooperativeKernel((void*)mega, dim3(256), dim3(512), args, kDynLds, stream);
  if (e != hipSuccess) fprintf(stderr, "cooperative launch failed: %s\n", hipGetErrorString(e));
}
```

```cpp
#include <hip/hip_runtime.h>
#include <hip/hip_cooperative_groups.h>
#include <cstdio>
namespace cg = cooperative_groups;
__device__ __forceinline__ int otid(int wv) { int t = (wv << 6) | (int)__builtin_amdgcn_mbcnt_hi(~0u, __builtin_amdgcn_mbcnt_lo(~0u, 0u)); asm volatile("" : "+v"(t)); return t; }
__device__ __forceinline__ int obid() { int t = blockIdx.x; asm volatile("" : "+s"(t)); return t; }
template <class T> __device__ __forceinline__ T* oaddr(T* q) { asm volatile("" : "+s"(q)); return q; }
namespace pg8 {
#define PG8_LAS __attribute__((address_space(3)))
typedef unsigned short bf16_t;
typedef short bf16x8 __attribute__((ext_vector_type(8)));
typedef float f32x4 __attribute__((ext_vector_type(4)));
typedef unsigned u32x4 __attribute__((ext_vector_type(4)));
constexpr int BM = 256, BK = 64, HALF = 128, HTB = HALF * BK * 2  , STAGE_BYTES = 8 * HTB, NXCD = 8, WGM = 8;

__host__ __device__ __forceinline__ int lds_byte(int r, int c) { const int st = (r >> 4) * 2 + (c >> 5), rr = r & 15, cc = c & 31, ob = rr * 64 + cc * 2; return st * 1024 + (ob ^ (((ob >> 9) & 1) << 5)); }
__host__ __device__ __forceinline__ void stage_rc(int b, int& R, int& C) { const int st = b / 1024, sb = b % 1024, swz = sb ^ (((sb >> 9) & 1) << 5); R = (st >> 1) * 16 + swz / 64; C = (st & 1) * 32 + (swz % 64) / 2; }
__host__ __device__ __forceinline__ int perm32(int rho) { const int n = rho >> 4, i = rho & 15; return 8 * (i >> 2) + 4 * n + (i & 3); }

struct Unit { int pm, pn; };
struct Gemm { const bf16_t* A; const bf16_t* Bt; int M, N, K; };

struct StaticOrder {
    int nM, nN, nwg, G, c;
    __host__ __device__ void init(int M, int N, int G_, int c_) { nM = M / BM; nN = N / BM; nwg = nM * nN; G = G_; c = c_; }
    __host__ __device__ bool next(int i, Unit& u) const {
        const long L = (long)i * G + c; if (L >= nwg) return false;
        int wgid = (int)L; { const int q = nwg / NXCD, r = nwg % NXCD, xcd = wgid % NXCD, off = wgid / NXCD; wgid = (xcd < r ? xcd * (q + 1) : r * (q + 1) + (xcd - r) * q) + off; }
        const int nig = WGM * nN, gid = wgid / nig, fm = gid * WGM, gsz = (nM - fm) < WGM ? (nM - fm) : WGM;
        u.pm = fm + ((wgid % nig) % gsz); u.pn = (wgid % nig) / gsz; return true;
    }
    __device__ __forceinline__ void a_ready(const Unit&) const {}
    __device__ __forceinline__ void done(const Unit&) const {}
};
__device__ __forceinline__ unsigned cvt_pk_bf16(float lo, float hi) { unsigned r; asm volatile("v_cvt_pk_bf16_f32 %0, %1, %2" : "=v"(r) : "v"(lo), "v"(hi)); return r; }

template <class Epi, class Sched, bool STAMP = false>
__device__ __forceinline__ void gemm_phase(PG8_LAS unsigned char* lds, const Gemm g, const Sched& S, const Epi& E, unsigned long long* stamps) {
    const int tid = otid(E.pp->wv), wid = __builtin_amdgcn_readfirstlane(tid >> 6), lane = tid & 63, wr = wid >> 2, wc = wid & 3, fr = lane & 15, fq = lane >> 4;
    const int K = g.K, nt = K / BK;
    int ts_lo = 0, ts_hi = 0, nts = 0; const unsigned long long rt_entry = STAMP ? (unsigned long long)wall_clock64() : 0ull;
#define PG8_STAMP() do { if (STAMP && wid == 0 && nts < 64) { const unsigned long long _c = (unsigned long long)clock64(); \
        ts_lo = (lane == nts) ? (int)(unsigned)_c : ts_lo; ts_hi = (lane == nts) ? (int)(unsigned)(_c >> 32) : ts_hi; ++nts; } } while (0)
    PG8_STAMP();
    unsigned voffA[2], voffB[2];
#pragma unroll
    for (int i = 0; i < 2; ++i) { int R, C; stage_rc(tid * 16 + i * 8192, R, C); const int Rb = Epi::PERM ? ((R & ~31) + perm32(R & 31)) : R;
        voffA[i] = (unsigned)(R * K + C) * 2u; voffB[i] = (unsigned)(Rb * K + C) * 2u; }
    const size_t kstep = (size_t)(BK * 2);
    const size_t hstep = (size_t)HALF * K * 2;
    const size_t tstep = 2 * hstep;
    const unsigned ldsw = (unsigned)wid * 1024u;
    const int aoff = lds_byte(wr * 64 + fr, fq * 8), boff = lds_byte(wc * 32 + fr, fq * 8);
#define PG8_SA(b, h) (((b) * 2 + (h)) * HTB)
#define PG8_SB(b, h) ((4 + (b) * 2 + (h)) * HTB)
#define PG8_STAGE(bufoff, gbase, voff) do { _Pragma("unroll") for (int _i = 0; _i < 2; ++_i) \
        __builtin_amdgcn_global_load_lds((const unsigned*)((const char*)(gbase) + (voff)[_i]), (PG8_LAS unsigned*)(lds + (bufoff) + ldsw + _i * 8192), 16, 0, 0); } while (0)
#define PG8_LDA(dst, b, h) do { _Pragma("unroll") for (int m = 0; m < 4; ++m) _Pragma("unroll") for (int k = 0; k < 2; ++k) dst[m][k] = *(const PG8_LAS bf16x8*)(lds + PG8_SA(b, h) + aoff + m * 2048 + k * 1024); } while (0)
#define PG8_LDB(dst, b, h) do { _Pragma("unroll") for (int n = 0; n < 2; ++n) _Pragma("unroll") for (int k = 0; k < 2; ++k) dst[n][k] = *(const PG8_LAS bf16x8*)(lds + PG8_SB(b, h) + boff + n * 2048 + k * 1024); } while (0)
#define PG8_MMA(ai, bj, At, Bt) do { __builtin_amdgcn_s_setprio(1); _Pragma("unroll") for (int m = 0; m < 4; ++m) _Pragma("unroll") for (int n = 0; n < 2; ++n) _Pragma("unroll") for (int k = 0; k < 2; ++k) \
        acc[ai][bj][m][n] = __builtin_amdgcn_mfma_f32_16x16x32_bf16(Bt[n][k], At[m][k], acc[ai][bj][m][n], 0, 0, 0); __builtin_amdgcn_s_setprio(0); } while (0)
#define PG8_WAIT_V(n) asm volatile("s_waitcnt vmcnt(" #n ")" ::: "memory")
#define PG8_WAIT_L(n) asm volatile("s_waitcnt lgkmcnt(" #n ")" ::: "memory")
#define PG8_BAR __builtin_amdgcn_s_barrier()
#define PG8_SCHED __builtin_amdgcn_sched_barrier(0)
    Unit cur, nxt; int ui = 0;
    if (!S.next(0, cur)) return;
    f32x4 acc[2][2][4][2];
#pragma unroll
    for (int a = 0; a < 2; ++a)
#pragma unroll
        for (int b = 0; b < 2; ++b)
#pragma unroll
            for (int m = 0; m < 4; ++m)
#pragma unroll
                for (int n = 0; n < 2; ++n) acc[a][b][m][n] = (f32x4){0.f, 0.f, 0.f, 0.f};
    bf16x8 At[4][2], B0[2][2], B1[2][2];
    const char* cA = (const char*)g.A + (size_t)cur.pm * tstep; const char* cB = (const char*)g.Bt + (size_t)cur.pn * tstep;
    S.a_ready(cur);
    PG8_STAGE(PG8_SB(0, 0), cB, voffB); PG8_STAGE(PG8_SA(0, 0), cA, voffA); PG8_STAGE(PG8_SB(0, 1), cB + hstep, voffB); PG8_STAGE(PG8_SA(0, 1), cA + hstep, voffA);
    if (wr == 1) PG8_BAR;
    PG8_WAIT_V(4); PG8_BAR;
    PG8_STAGE(PG8_SB(1, 0), cB + kstep, voffB); PG8_STAGE(PG8_SA(1, 0), cA + kstep, voffA); PG8_STAGE(PG8_SB(1, 1), cB + hstep + kstep, voffB);
    PG8_WAIT_V(6); PG8_BAR;
    PG8_STAMP();
    for (;;) {
        const bool has_next = S.next(ui + 1, nxt);
        const char* nA = has_next ? (const char*)g.A + (size_t)nxt.pm * tstep : cA; const char* nB = has_next ? (const char*)g.Bt + (size_t)nxt.pn * tstep : cB;
        for (int t = 0; t < nt; t += 2) {
            const bool last = (t == nt - 2);
            const char* a1 = cA + (size_t)(t + 1) * kstep;
            const char* a2 = last ? nA : cA + (size_t)(t + 2) * kstep; const char* b2 = last ? nB : cB + (size_t)(t + 2) * kstep;
            const char* a3 = a2 + kstep; const char* b3 = b2 + kstep;
            if (last && has_next) S.a_ready(nxt);
            PG8_LDB(B0, 0, 0); PG8_SCHED; PG8_LDA(At, 0, 0); PG8_STAGE(PG8_SA(1, 1), a1 + hstep, voffA);
            PG8_WAIT_L(8); PG8_BAR; PG8_WAIT_L(0); PG8_MMA(0, 0, At, B0); PG8_BAR; PG8_SCHED;
            PG8_LDB(B1, 0, 1); PG8_STAGE(PG8_SB(0, 0), b2, voffB);
            PG8_BAR; PG8_WAIT_L(0); PG8_MMA(0, 1, At, B1); PG8_BAR;
            PG8_LDA(At, 0, 1); PG8_STAGE(PG8_SA(0, 0), a2, voffA);
            PG8_BAR; PG8_WAIT_L(0); PG8_MMA(1, 0, At, B0); PG8_BAR; PG8_SCHED;
            PG8_STAGE(PG8_SB(0, 1), b2 + hstep, voffB);
            PG8_WAIT_V(6); PG8_BAR; PG8_MMA(1, 1, At, B1); PG8_BAR;
            PG8_LDB(B0, 1, 0); PG8_SCHED; PG8_LDA(At, 1, 0); PG8_STAGE(PG8_SA(0, 1), a2 + hstep, voffA);
            PG8_WAIT_L(8); PG8_BAR; PG8_WAIT_L(0); PG8_MMA(0, 0, At, B0); PG8_BAR; PG8_SCHED;
            PG8_LDB(B1, 1, 1); PG8_STAGE(PG8_SB(1, 0), b3, voffB);
            PG8_BAR; PG8_WAIT_L(0); PG8_MMA(0, 1, At, B1); PG8_BAR;
            PG8_LDA(At, 1, 1); PG8_STAGE(PG8_SA(1, 0), a3, voffA);
            PG8_BAR; PG8_WAIT_L(0); PG8_MMA(1, 0, At, B0); PG8_BAR; PG8_SCHED;
            PG8_STAGE(PG8_SB(1, 1), b3 + hstep, voffB);
            PG8_WAIT_V(6); PG8_BAR; PG8_MMA(1, 1, At, B1); PG8_BAR;
        }
        PG8_STAMP();
        if constexpr (!Epi::AFTER_DRAIN) { E(acc, cur, wr, wc, fr, fq); S.done(cur); }
        PG8_STAMP();
        if (!has_next) break;
#pragma unroll
        for (int a = 0; a < 2; ++a)
#pragma unroll
            for (int b = 0; b < 2; ++b)
#pragma unroll
                for (int m = 0; m < 4; ++m)
#pragma unroll
                    for (int n = 0; n < 2; ++n) acc[a][b][m][n] = (f32x4){0.f, 0.f, 0.f, 0.f};
        cur = nxt; cA = nA; cB = nB; ++ui;
    }
    PG8_WAIT_V(0);
    if (wr == 0) PG8_BAR;
    PG8_BAR;
    if constexpr (Epi::AFTER_DRAIN) { E.fused(acc, cur, wr, wc, fr, fq, lds, wid, lane); S.done(cur); }
    PG8_STAMP();
    if (STAMP && wid == 0) { stamps[lane] = lane < nts ? (((unsigned long long)(unsigned)ts_hi << 32) | (unsigned)ts_lo) : 0ull;
        if (lane == 62) stamps[62] = rt_entry; if (lane == 63) stamps[63] = (unsigned long long)wall_clock64(); }
#undef PG8_STAMP
#undef PG8_SA
#undef PG8_SB
#undef PG8_STAGE
#undef PG8_LDA
#undef PG8_LDB
#undef PG8_MMA
#undef PG8_WAIT_V
#undef PG8_WAIT_L
#undef PG8_BAR
#undef PG8_SCHED
}
}
using pg8::bf16_t; using pg8::bf16x8; using pg8::f32x4; using pg8::u32x4; using pg8::Unit;
typedef unsigned u32x2 __attribute__((ext_vector_type(2)));
#define LAS __attribute__((address_space(3)))
#define GAS __attribute__((address_space(1)))
typedef LAS unsigned char* ldsp;

constexpr int T_ALL = 32768, TG = 16384, DM = 1024, SEQ = 4096;
constexpr float ALPHA = 1.4142135623730951f;
constexpr size_t MB = 1024ull * 1024ull;
constexpr size_t OFF_XB = 0, OFF_WB = 128 * MB, OFF_U = 184 * MB, OFF_SMALL = 248 * MB, OFF_R0 = 256 * MB;
constexpr size_t W1A = 0, W1S = W1A + 4096ull * 1024, W1B = W1S + 3072ull * 1024, WPA = W1B + 5120ull * 1024, WPB = WPA + 1024ull * 1024,
                 WO = WPB + 1024ull * 2048, WUP = WO + 1024ull * 1024, WDN = WUP + 4096ull * 1024, W_END = WDN + 4096ull * 1024;
static_assert(W_END * 2 <= 56 * MB, "weights");
constexpr size_t SM_MOD = 0  , SM_LB = 2 * 8 * 6144  , SM_STR = SM_LB + 2048  , SM_STH = SM_STR + (size_t)TG * 8  , SM_END = SM_STH + (size_t)TG * 8;
constexpr size_t SM_BAR_BYTES = 7 * MB;
static_assert(SM_END * 4 <= 7 * MB, "small");
constexpr size_t R_QH = 0, R_VIT = 32 * MB, R_QR = 64 * MB, R_KR = 96 * MB, R_KRT = 128 * MB, R_ORA = 160 * MB, R_ORB = 192 * MB;
constexpr size_t R_SGA = R_QH, R_SGB = R_VIT, R_M1 = R_QR, R_MG = R_KRT;
constexpr size_t D_LF = 0, D_VRT = 64 * MB;

struct Params {
  const float* x; const float* c; const int* pos; const float* lb_logits; const float* w_ada; const float* b_ada; const float* w_in; const float* w_pa; const float* w_pb;
  const float* w_o; const float* ln1_g; const float* ln1_b; const float* w_up; const float* b_up; const float* w_down; const float* b_down; const float* ln2_g; const float* ln2_b;
  float* out; unsigned char* ws; int wv; int pad;
};

__device__ __forceinline__ float bf2f(unsigned short b) { return __uint_as_float(((unsigned)b) << 16); }
__device__ __forceinline__ float bflo(unsigned u) { return __uint_as_float(u << 16); }
__device__ __forceinline__ float bfhi(unsigned u) { return __uint_as_float(u & 0xffff0000u); }
typedef float f32x2_ __attribute__((ext_vector_type(2)));
typedef __bf16 bf16x2_ __attribute__((ext_vector_type(2)));
__device__ __forceinline__ unsigned pk2(float lo, float hi) { const f32x2_ v = {lo, hi}; const bf16x2_ b = __builtin_convertvector(v, bf16x2_); return __builtin_bit_cast(unsigned, b); }
__device__ __forceinline__ float sigmoidf_(float v) { return __builtin_amdgcn_rcpf(1.0f + __expf(-v)); }
__device__ __forceinline__ float siluf_(float v) { return v * sigmoidf_(v); }
__device__ __forceinline__ f32x4 mfma16(bf16x8 a, bf16x8 b, f32x4 c) { return __builtin_amdgcn_mfma_f32_16x16x32_bf16(a, b, c, 0, 0, 0); }
__device__ __forceinline__ bf16x8 ldfrag(ldsp base, int off) { return *(const LAS bf16x8*)(base + off); }
__device__ __forceinline__ float shx(float v, int mask, int lane) { return __int_as_float(__builtin_amdgcn_ds_bpermute((lane ^ mask) << 2, __float_as_int(v))); }
__device__ __forceinline__ float wave_sum(float v, int lane) {
#pragma unroll
  for (int o = 32; o > 0; o >>= 1) v += shx(v, o, lane);
  return v;
}

#ifdef USE_NT
#define NTS(val, ptr) __builtin_nontemporal_store((val), (ptr))
#else
#define NTS(val, ptr) (*(ptr) = (val))
#endif
enum { MD_G1A = 0, MD_G1S, MD_G1B, MD_G2A, MD_G2B, MD_G3, MD_G4, MD_G5 };
struct RowBuf { u32x4 a[2]; f32x4 b0[2], b1[2]; f32x4 s[2]; int pi; };
struct UnitBuf { f32x4 c0[2], c1[2], d0[2], d1[2]; };
struct EpiP {
  static constexpr bool PERM = true, AFTER_DRAIN = false;
  int mode, l, g;
  const Params* pp;
  template <int MODE> __device__ __forceinline__ void unitload(UnitBuf& ub, const Unit& u, int wc, int fq) const {
    const Params& p = *pp;
    const GAS float* small = (const GAS float*)(p.ws + OFF_SMALL);
    const GAS float* mod = small + SM_MOD + (size_t)l * 8 * 6144;
#pragma unroll
    for (int bj = 0; bj < 2; ++bj) {
      const int col = u.pn * 256 + bj * 128 + wc * 32 + 8 * fq;
      if constexpr (MODE == MD_G1A) {
        if ((col >> 10) == 1) { const GAS float* lbp = small + SM_LB + l * 1024 + (col & 1023); ub.c0[bj] = *(const GAS f32x4*)lbp; ub.c1[bj] = *(const GAS f32x4*)(lbp + 4); }
      } else if constexpr (MODE == MD_G3) {
        const int b = (g * TG + u.pm * 256) >> 12; const GAS float* gt = mod + (size_t)b * 6144 + 2 * 1024 + col;
        ub.c0[bj] = *(const GAS f32x4*)gt; ub.c1[bj] = *(const GAS f32x4*)(gt + 4);
      } else if constexpr (MODE == MD_G4) {
        const GAS float* bp = (const GAS float*)p.b_up + (size_t)l * 4096 + col; ub.c0[bj] = *(const GAS f32x4*)bp; ub.c1[bj] = *(const GAS f32x4*)(bp + 4);
      } else if constexpr (MODE == MD_G5) {
        const int b = (u.pm * 256) >> 12; const GAS float* gt = mod + (size_t)b * 6144 + 5 * 1024 + col; const GAS float* bp = (const GAS float*)p.b_down + (size_t)l * 1024 + col;
        ub.c0[bj] = *(const GAS f32x4*)gt; ub.c1[bj] = *(const GAS f32x4*)(gt + 4); ub.d0[bj] = *(const GAS f32x4*)bp; ub.d1[bj] = *(const GAS f32x4*)(bp + 4);
      }
    }
  }
  template <int MODE, int ai, int m, int PH> __device__ __forceinline__ void rowf(const f32x4 (&acc)[2][2][4][2], RowBuf& rb, const UnitBuf& ub, const Unit& u, int wr, int wc, int fr, int fq) const {
    if constexpr (PH == 0 && MODE == MD_G1A) { if ((u.pn >> 2) >= 2) rb.pi = ((const GAS int*)pp->pos)[g * TG + u.pm * 256 + ai * 128 + wr * 64 + m * 16 + fr]; }
    cell<MODE, ai, m, PH, 0>(acc, rb, ub, u, wr, wc, fr, fq);
    cell<MODE, ai, m, PH, 1>(acc, rb, ub, u, wr, wc, fr, fq);
  }
  template <int MODE, int ai, int m, int PH, int bj> __device__ __forceinline__ void cell(const f32x4 (&acc)[2][2][4][2], RowBuf& rb, const UnitBuf& ub, const Unit& u, int wr, int wc, int fr, int fq) const {
    const Params& p = *pp;
    GAS unsigned char* R0 = (GAS unsigned char*)(p.ws + OFF_R0); GAS unsigned char* DO = (GAS unsigned char*)p.out;
    GAS float* small = (GAS float*)(p.ws + OFF_SMALL);
    const int row = u.pm * 256 + ai * 128 + wr * 64 + m * 16 + fr;
    {
      const int col = u.pn * 256 + bj * 128 + wc * 32 + 8 * fq;
      float v[8];
#pragma unroll
      for (int i = 0; i < 4; ++i) { v[i] = acc[ai][bj][m][0][i]; v[4 + i] = acc[ai][bj][m][1][i]; }
      if constexpr (MODE == MD_G1A) {
        if constexpr (PH == 1) {
          const int sec = col >> 10, cs = col & 1023;
          if (sec == 0) {
            u32x4 o;
#pragma unroll
            for (int i = 0; i < 4; ++i) o[i] = pk2(siluf_(v[2 * i]), siluf_(v[2 * i + 1]));
            *(GAS u32x4*)(R0 + R_QH + ((size_t)row * 1024 + cs) * 2) = o;
          } else if (sec == 1) {
            float o[8];
            if (l == 0) {
#pragma unroll
              for (int i = 0; i < 8; ++i) { const float z = v[i]; o[i] = fminf(z, 0.f) - __logf(1.0f + __expf(-fabsf(z))); }
            } else {
#pragma unroll
              for (int i = 0; i < 8; ++i) {
                const float lbv = i < 4 ? ub.c0[bj][i & 3] : ub.c1[bj][i & 3];
                const float z = v[i], e = __expf(-fabsf(z)), r = __builtin_amdgcn_rcpf(1.0f + e);
                const float sg = z >= 0.f ? r : e * r;
                o[i] = __logf(lbv + (1.f - lbv) * sg);
              }
            }
            GAS float* dst = (GAS float*)(DO + D_LF) + (size_t)row * 1024 + cs;
            *(GAS f32x4*)dst = (f32x4){o[0], o[1], o[2], o[3]}; *(GAS f32x4*)(dst + 4) = (f32x4){o[4], o[5], o[6], o[7]};
          } else {
            const float posf = (float)rb.pi;
            const float sc = sec == 3 ? 0.0625f : 1.0f;
            const int p0 = (cs & 255) >> 1;
            u32x4 o;
#pragma unroll
            for (int i = 0; i < 4; ++i) {
              const float theta = __builtin_amdgcn_exp2f(-13.287712379549449f * (float)(p0 + i) * (1.0f / 127.0f));
              float rev = posf * theta * 0.15915494309189535f; rev -= floorf(rev);
              const float sn = __builtin_amdgcn_sinf(rev), cn = __builtin_amdgcn_cosf(rev);
              const float t1 = v[2 * i], t2 = v[2 * i + 1];
              o[i] = pk2((t1 * cn - t2 * sn) * sc, (t1 * sn + t2 * cn) * sc);
            }
            *(GAS u32x4*)(R0 + (sec == 2 ? R_QR : R_KR) + ((size_t)row * 1024 + cs) * 2) = o;
          }
        }
      } else if constexpr (MODE == MD_G1S) {
        if constexpr (PH == 1) {
          if ((row >> 10) == 0) {
            u32x4 o;
#pragma unroll
            for (int i = 0; i < 4; ++i) o[i] = pk2(v[2 * i], v[2 * i + 1]);
            *(GAS u32x4*)(R0 + R_VIT + ((size_t)row * TG + col) * 2) = o;
          } else {
            const int f = row - 1024, h = (u.pm * 256 - 1024) >> 9;
            const float lg2 = __log2f(1.0f - __builtin_amdgcn_exp2f(-5.0f - (float)h));
            u32x4 ov;
#pragma unroll
            for (int i = 0; i < 4; ++i) ov[i] = pk2(v[2 * i] * __builtin_amdgcn_exp2f(lg2 * (float)(63 - ((col + 2 * i) & 63))), v[2 * i + 1] * __builtin_amdgcn_exp2f(lg2 * (float)(63 - ((col + 2 * i + 1) & 63))));
            *(GAS u32x4*)(DO + D_VRT + ((size_t)f * TG + col) * 2) = ov;
          }
        }
      } else if constexpr (MODE == MD_G1B) {
        const int sec = col >> 10, cs = col & 1023;
        if (sec == 0) {
          GAS u32x4* ptr = (GAS u32x4*)(R0 + R_ORA + ((size_t)row * 1024 + cs) * 2);
          if constexpr (PH == 0) { rb.a[bj] = *ptr; rb.s[bj][0] = (small + SM_STH)[(size_t)row * 8 + (cs >> 7)]; }
          else {
            const float rstd = rsqrtf(rb.s[bj][0] * (1.0f / 128.0f) + 1e-6f);
            const u32x4 ov = rb.a[bj]; u32x4 o;
#pragma unroll
            for (int i = 0; i < 4; ++i) o[i] = pk2(bflo(ov[i]) * rstd * siluf_(v[2 * i]), bfhi(ov[i]) * rstd * siluf_(v[2 * i + 1]));
            *ptr = o;
          }
        } else if (sec < 3) {
          const int c2 = col - 1024;
          GAS u32x4* ptr = (GAS u32x4*)(R0 + R_ORB + ((size_t)row * 2048 + c2) * 2);
          if constexpr (PH == 0) { const GAS float* st = small + SM_STR + ((size_t)row * 4 + (c2 >> 9)) * 2; rb.a[bj] = *ptr; rb.s[bj][0] = st[0]; rb.s[bj][1] = st[1]; }
          else {
            const float mean = rb.s[bj][0] * (1.0f / 512.0f);
            const float var = fmaxf(rb.s[bj][1] * (1.0f / 512.0f) - mean * mean, 0.f);
            const float rstd = rsqrtf(var + 1e-6f);
            const u32x4 ov = rb.a[bj]; u32x4 o;
#pragma unroll
            for (int i = 0; i < 4; ++i) o[i] = pk2((bflo(ov[i]) - mean) * rstd * siluf_(v[2 * i]), (bfhi(ov[i]) - mean) * rstd * siluf_(v[2 * i + 1]));
            *ptr = o;
          }
        } else {
          if constexpr (PH == 1) {
            u32x4 o;
#pragma unroll
            for (int i = 0; i < 4; ++i) o[i] = pk2(sigmoidf_(v[2 * i]), sigmoidf_(v[2 * i + 1]));
            *(GAS u32x4*)(R0 + (sec == 3 ? R_SGA : R_SGB) + ((size_t)row * 1024 + cs) * 2) = o;
          }
        }
      } else if constexpr (MODE == MD_G2A) {
        if constexpr (PH == 0) rb.a[bj] = *(const GAS u32x4*)(R0 + R_SGA + ((size_t)row * 1024 + col) * 2);
        else {
          const u32x4 gv = rb.a[bj];
          GAS float* dst = (GAS float*)(R0 + R_M1) + (size_t)row * 1024 + col;
          *(GAS f32x4*)dst = (f32x4){bflo(gv[0]) * v[0], bfhi(gv[0]) * v[1], bflo(gv[1]) * v[2], bfhi(gv[1]) * v[3]};
          *(GAS f32x4*)(dst + 4) = (f32x4){bflo(gv[2]) * v[4], bfhi(gv[2]) * v[5], bflo(gv[3]) * v[6], bfhi(gv[3]) * v[7]};
        }
      } else if constexpr (MODE == MD_G2B) {
        if constexpr (PH == 0) {
          rb.a[bj] = *(const GAS u32x4*)(R0 + R_SGB + ((size_t)row * 1024 + col) * 2);
          const GAS float* src = (const GAS float*)(R0 + R_M1) + (size_t)row * 1024 + col;
          rb.b0[bj] = *(const GAS f32x4*)src; rb.b1[bj] = *(const GAS f32x4*)(src + 4);
        } else {
          const u32x4 gv = rb.a[bj]; const f32x4 m0 = rb.b0[bj], m1 = rb.b1[bj];
          u32x4 o;
          o[0] = pk2(m0[0] + bflo(gv[0]) * v[0], m0[1] + bfhi(gv[0]) * v[1]);
          o[1] = pk2(m0[2] + bflo(gv[1]) * v[2], m0[3] + bfhi(gv[1]) * v[3]);
          o[2] = pk2(m1[0] + bflo(gv[2]) * v[4], m1[1] + bfhi(gv[2]) * v[5]);
          o[3] = pk2(m1[2] + bflo(gv[3]) * v[6], m1[3] + bfhi(gv[3]) * v[7]);
          *(GAS u32x4*)(R0 + R_MG + ((size_t)row * 1024 + col) * 2) = o;
        }
      } else if constexpr (MODE == MD_G3) {
        const int tg = g * TG + row;
        if constexpr (PH == 0) {
          const GAS float* xin = (l == 0 ? (const GAS float*)p.x : (const GAS float*)(p.ws + OFF_XB)) + (size_t)tg * 1024 + col;
          rb.b0[bj] = *(const GAS f32x4*)xin; rb.b1[bj] = *(const GAS f32x4*)(xin + 4);
        } else {
          GAS float* dst = (GAS float*)(p.ws + OFF_XB) + (size_t)tg * 1024 + col;
          f32x4 o0, o1;
#pragma unroll
          for (int i = 0; i < 4; ++i) { o0[i] = ALPHA * rb.b0[bj][i] + (1.f + ub.c0[bj][i]) * v[i]; o1[i] = ALPHA * rb.b1[bj][i] + (1.f + ub.c1[bj][i]) * v[4 + i]; }
          *(GAS f32x4*)dst = o0; *(GAS f32x4*)(dst + 4) = o1;
        }
      } else if constexpr (MODE == MD_G4) {
        if constexpr (PH == 1) {
          float o[8];
#pragma unroll
          for (int i = 0; i < 8; ++i) { const float hh = fmaxf(v[i] + (i < 4 ? ub.c0[bj][i & 3] : ub.c1[bj][i & 3]), 0.f); o[i] = hh * hh; }
          u32x4 ov;
#pragma unroll
          for (int i = 0; i < 4; ++i) ov[i] = pk2(o[2 * i], o[2 * i + 1]);
          *(GAS u32x4*)(R0 + ((size_t)row * 4096 + col) * 2) = ov;
        }
      } else if constexpr (MODE == MD_G5) {
        GAS float* dst = (GAS float*)(p.ws + OFF_XB) + (size_t)row * 1024 + col;
        if constexpr (PH == 0) { rb.b0[bj] = *(const GAS f32x4*)dst; rb.b1[bj] = *(const GAS f32x4*)(dst + 4); }
        else {
          f32x4 o0, o1;
#pragma unroll
          for (int i = 0; i < 4; ++i) { o0[i] = ALPHA * rb.b0[bj][i] + (1.f + ub.c0[bj][i]) * (v[i] + ub.d0[bj][i]); o1[i] = ALPHA * rb.b1[bj][i] + (1.f + ub.c1[bj][i]) * (v[4 + i] + ub.d1[bj][i]); }
          *(GAS f32x4*)dst = o0; *(GAS f32x4*)(dst + 4) = o1;
        }
      }
    }
  }
  template <int MODE> __device__ __forceinline__ void run(const f32x4 (&acc)[2][2][4][2], const Unit& u, int wr, int wc, int fr, int fq) const {
    UnitBuf ub; unitload<MODE>(ub, u, wc, fq);
#define RB2(AI, M0, M1) { RowBuf r0, r1; \
      rowf<MODE, AI, M0, 0>(acc, r0, ub, u, wr, wc, fr, fq); rowf<MODE, AI, M1, 0>(acc, r1, ub, u, wr, wc, fr, fq); \
      rowf<MODE, AI, M0, 1>(acc, r0, ub, u, wr, wc, fr, fq); rowf<MODE, AI, M1, 1>(acc, r1, ub, u, wr, wc, fr, fq); }
    RB2(0, 0, 1) RB2(0, 2, 3) RB2(1, 0, 1) RB2(1, 2, 3)
#undef RB2
  }
  __device__ __forceinline__ void operator()(const f32x4 (&acc)[2][2][4][2], const Unit& u, int wr, int wc, int fr, int fq) const {
    asm volatile("" : "+v"(fr), "+v"(fq));
    switch (mode) {
      case MD_G1A: run<MD_G1A>(acc, u, wr, wc, fr, fq); break;
      case MD_G1S: run<MD_G1S>(acc, u, wr, wc, fr, fq); break;
      case MD_G1B: run<MD_G1B>(acc, u, wr, wc, fr, fq); break;
      case MD_G2A: run<MD_G2A>(acc, u, wr, wc, fr, fq); break;
      case MD_G2B: run<MD_G2B>(acc, u, wr, wc, fr, fq); break;
      case MD_G3: run<MD_G3>(acc, u, wr, wc, fr, fq); break;
      case MD_G4: run<MD_G4>(acc, u, wr, wc, fr, fq); break;
      default: run<MD_G5>(acc, u, wr, wc, fr, fq); break;
    }
  }
};
#define XB_TMO      128
#define XB_XCNT(j)  (256  + 64 * (j))
#define XB_XSUB(j)  (1280 + 64 * (j))
#define XB_XGEN(j)  (2304 + 64 * (j))
#define XB_TOP      3328
#define XB_TOPGEN   3392
#define XCD_BAR_WORDS 3456
#define XB_SPIN_CAP (1u << 18)

__device__ __forceinline__ unsigned xb_ld(unsigned* p)              { return __hip_atomic_load(p, __ATOMIC_RELAXED, __HIP_MEMORY_SCOPE_AGENT); }
__device__ __forceinline__ unsigned xb_add(unsigned* p, unsigned v) { return __hip_atomic_fetch_add(p, v, __ATOMIC_RELAXED, __HIP_MEMORY_SCOPE_AGENT); }
__device__ __forceinline__ unsigned xb_xcc_id() { return (unsigned)__builtin_amdgcn_s_getreg((3 << 11) | 20) & 0xFu; }
#define XB_SPIN(cond, bar) do { unsigned _sp = 0; while (cond) { __builtin_amdgcn_s_sleep(1); \
    if ((++_sp & 255u) == 0u) { if (xb_ld(&(bar)[XB_TMO])) break; if (_sp > XB_SPIN_CAP) { atomicAdd(&(bar)[XB_TMO], 1u); break; } } } } while (0)

struct XcdBarrier {
    unsigned* bar; unsigned x;
    volatile LAS unsigned* st;
};

__device__ __forceinline__ XcdBarrier xcd_barrier_post(unsigned* bar, volatile LAS unsigned* st) {
    XcdBarrier b; b.bar = bar; b.x = xb_xcc_id(); b.st = st;
    if (threadIdx.x == 0) (void)xb_add(&bar[XB_XCNT(b.x)], 1u);
    return b;
}
__device__ __forceinline__ void xcd_barrier_complete(unsigned* bar, unsigned x, unsigned& nloc, unsigned& nx) {
    const unsigned G = gridDim.x * gridDim.y * gridDim.z;
    unsigned sum, cnt, mine, sp = 0u;
    for (;;) {
        sum = 0u; cnt = 0u; mine = 0u;
#pragma unroll
        for (unsigned j = 0; j < 16; ++j) { const unsigned c = xb_ld(&bar[XB_XCNT(j)]); sum += c; cnt += (c > 0u) ? 1u : 0u; mine = (j == x) ? c : mine; }
        if (sum == G) break;
        __builtin_amdgcn_s_sleep(1);
        if ((++sp & 255u) == 0u) { if (xb_ld(&bar[XB_TMO])) break; if (sp > XB_SPIN_CAP) { atomicAdd(&bar[XB_TMO], 1u); break; } }
    }
    nloc = mine > 0u ? mine : 1u; nx = cnt > 0u ? cnt : 1u;
}

__device__ __forceinline__ void xcd_barrier(const XcdBarrier& b) {
    asm volatile("s_waitcnt vmcnt(0)" ::: "memory");
    __syncthreads();
    if (threadIdx.x == 0) {
        unsigned* bar = b.bar;
        __builtin_amdgcn_s_waitcnt(0);
        unsigned nloc = b.st[0], nx = b.st[1];
        if (nloc == 0u) { xcd_barrier_complete(bar, b.x, nloc, nx); b.st[0] = nloc; b.st[1] = nx; }
        const unsigned old = xb_add(&bar[XB_XSUB(b.x)], 1u);
        const unsigned gen = old / nloc;
        if (old + 1u == (gen + 1u) * nloc) {
            __builtin_amdgcn_fence(__ATOMIC_RELEASE, "agent");
            asm volatile("s_waitcnt vmcnt(0)" ::: "memory");
            const unsigned og = xb_add(&bar[XB_TOP], 1u);
            const unsigned tg = og / nx;
            if (og + 1u == (tg + 1u) * nx) xb_add(&bar[XB_TOPGEN], 1u);
            else XB_SPIN(xb_ld(&bar[XB_TOPGEN]) == tg, bar);
            __builtin_amdgcn_fence(__ATOMIC_ACQUIRE, "agent");
            xb_add(&bar[XB_XGEN(b.x)], 1u);
            asm volatile("s_waitcnt vmcnt(0)" ::: "memory");
        } else {
            XB_SPIN(xb_ld(&bar[XB_XGEN(b.x)]) == gen, bar);
            __builtin_amdgcn_fence(__ATOMIC_ACQUIRE, "agent");
            asm volatile("s_waitcnt vmcnt(0)" ::: "memory");
        }
    }
    __syncthreads();
}

__device__ __forceinline__ void gbar(unsigned* bar0, volatile LAS unsigned* st) {
    XcdBarrier b; b.bar = bar0; asm volatile("" : "+s"(b.bar)); b.x = (unsigned)__builtin_amdgcn_readfirstlane((int)xb_xcc_id()); asm volatile("" : "+s"(b.x)); b.st = st; xcd_barrier(b);
}
__device__ __forceinline__ void conv_job(ldsp lds, int wv, const float* src, int ld, int K, int c0, int ncols, bf16_t* dst) {
  LAS float* tile = (LAS float*)lds;
  const int tid = otid(wv), ntk = K >> 6, ntn = ncols >> 6, nt = ntk * ntn;
  const int rr = tid >> 6, cc = tid & 63, kp = tid & 31, nn = tid >> 5;
  int t = obid();
  float reg[8];
  if (t < nt) { const int tk = t / ntn, tn = t - tk * ntn;
#pragma unroll
    for (int i = 0; i < 8; ++i) reg[i] = src[(size_t)((tk << 6) + i * 8 + rr) * ld + c0 + (tn << 6) + cc]; }
  for (; t < nt; t += gridDim.x) {
    const int tk = t / ntn, tn = t - tk * ntn, k0 = tk << 6, n0 = tn << 6;
    __syncthreads();
#pragma unroll
    for (int i = 0; i < 8; ++i) tile[(i * 8 + rr) * 65 + cc] = reg[i];
    __syncthreads();
    const int t2 = t + gridDim.x;
    if (t2 < nt) { const int tk2 = t2 / ntn, tn2 = t2 - tk2 * ntn;
#pragma unroll
      for (int i = 0; i < 8; ++i) reg[i] = src[(size_t)((tk2 << 6) + i * 8 + rr) * ld + c0 + (tn2 << 6) + cc]; }
#pragma unroll
    for (int i = 0; i < 4; ++i) { const int n = nn + 16 * i; *(unsigned*)(dst + (size_t)(n0 + n) * K + k0 + 2 * kp) = pk2(tile[(2 * kp) * 65 + n], tile[(2 * kp + 1) * 65 + n]); }
  }
  __syncthreads();
}
__device__ __forceinline__ void phase_conv(ldsp lds, const Params& p, int l) {
  bf16_t* WB = (bf16_t*)(p.ws + OFF_WB);
  const float* win = p.w_in + (size_t)l * 1024 * 12288;
  conv_job(lds, p.wv, win, 12288, 1024, 0, 1024, WB + W1A);
  conv_job(lds, p.wv, win, 12288, 1024, 1024, 1024, WB + W1A + 1024ull * 1024);
  conv_job(lds, p.wv, win, 12288, 1024, 4096, 2048, WB + W1A + 2048ull * 1024);
  conv_job(lds, p.wv, win, 12288, 1024, 2048, 1024, WB + W1S);
  conv_job(lds, p.wv, win, 12288, 1024, 6144, 2048, WB + W1S + 1024ull * 1024);
  conv_job(lds, p.wv, win, 12288, 1024, 3072, 1024, WB + W1B);
  conv_job(lds, p.wv, win, 12288, 1024, 8192, 4096, WB + W1B + 1024ull * 1024);
  conv_job(lds, p.wv, p.w_pa + (size_t)l * 1024 * 1024, 1024, 1024, 0, 1024, WB + WPA);
  conv_job(lds, p.wv, p.w_pb + (size_t)l * 2048 * 1024, 1024, 2048, 0, 1024, WB + WPB);
  conv_job(lds, p.wv, p.w_o + (size_t)l * 1024 * 1024, 1024, 1024, 0, 1024, WB + WO);
  conv_job(lds, p.wv, p.w_up + (size_t)l * 1024 * 4096, 4096, 1024, 0, 4096, WB + WUP);
  conv_job(lds, p.wv, p.w_down + (size_t)l * 4096 * 1024, 1024, 4096, 0, 1024, WB + WDN);
}
__device__ __forceinline__ void phase_mod(ldsp lds, const Params& p) {
  float* small = (float*)(p.ws + OFF_SMALL);
  const int tid = otid(p.wv);
  const int bid = obid();
  if (bid < 192) {
    LAS float* cond = (LAS float*)lds;
    LAS float* part = (LAS float*)(lds + 32768);
    for (int i = tid; i < 8192; i += 512) cond[i] = siluf_(p.c[i]);
    __syncthreads();
    const int o0 = bid * 64, l = o0 / 6144, n0 = o0 - l * 6144, nl = tid & 63, kq = tid >> 6;
    const float* w = p.w_ada + (size_t)l * 1024 * 6144 + n0 + nl + (size_t)(kq * 128) * 6144;
    float a[8];
#pragma unroll
    for (int b = 0; b < 8; ++b) a[b] = 0.f;
#pragma unroll 8
    for (int k = 0; k < 128; ++k) {
      const float wv = w[(size_t)k * 6144];
#pragma unroll
      for (int b = 0; b < 8; ++b) a[b] += cond[b * 1024 + kq * 128 + k] * wv;
    }
#pragma unroll
    for (int b = 0; b < 8; ++b) part[(kq * 8 + b) * 64 + nl] = a[b];
    __syncthreads();
    {
      const int b = tid >> 6; float s = 0.f;
#pragma unroll
      for (int q = 0; q < 8; ++q) s += part[(q * 8 + b) * 64 + nl];
      small[SM_MOD + (size_t)l * 8 * 6144 + b * 6144 + n0 + nl] = s + p.b_ada[l * 6144 + n0 + nl];
    }
    __syncthreads();
  } else if (bid == 192) {
    for (int i = tid; i < 1024; i += 512) {
      const float a = p.lb_logits[i], b = p.lb_logits[1024 + i], mx = fmaxf(a, b);
      const float ea = __expf(a - mx), eb = __expf(b - mx);
      small[SM_LB + i] = 0.f; small[SM_LB + 1024 + i] = eb / (ea + eb);
    }
  }
}
__device__ __forceinline__ void phase_u0(const Params& p) {
  const float* mod = (const float*)(p.ws + OFF_SMALL) + SM_MOD;
  bf16_t* U = (bf16_t*)(p.ws + OFF_U);
  const size_t n4 = (size_t)T_ALL * 1024 / 4;
  for (size_t i = (size_t)obid() * 512 + otid(p.wv); i < n4; i += (size_t)gridDim.x * 512) {
    const size_t e = i * 4; const int t = (int)(e >> 10), cc = (int)(e & 1023), b = t >> 12;
    const f32x4 xv = *(const f32x4*)(p.x + e), sh = *(const f32x4*)(mod + b * 6144 + cc), sc = *(const f32x4*)(mod + b * 6144 + 1024 + cc);
    u32x2 o; o[0] = pk2(xv[0] * (1.f + sc[0]) + sh[0], xv[1] * (1.f + sc[1]) + sh[1]); o[1] = pk2(xv[2] * (1.f + sc[2]) + sh[2], xv[3] * (1.f + sc[3]) + sh[3]);
    *(u32x2*)(U + e) = o;
  }
}
__device__ __forceinline__ void phase_ln(const Params& p, const float* gam, const float* bet, int lm, int s_shift, bool fin) {
  GAS float* XB = (GAS float*)(p.ws + OFF_XB);
  const GAS float* mod = (const GAS float*)(p.ws + OFF_SMALL) + SM_MOD + (size_t)lm * 8 * 6144;
  GAS bf16_t* U = (GAS bf16_t*)(p.ws + OFF_U);
  GAS float* outp = (GAS float*)p.out;
  const GAS float* gamg = (const GAS float*)gam; const GAS float* betg = (const GAS float*)bet;
  const int tid_ = otid(p.wv); const int lane = tid_ & 63, gw = obid() * 8 + (tid_ >> 6), nw = gridDim.x * 8;
  f32x4 vn[4];
#pragma unroll
  for (int k = 0; k < 4; ++k) vn[k] = *(const GAS f32x4*)(XB + (size_t)gw * 1024 + 256 * k + 4 * lane);
  for (int row = gw; row < T_ALL; row += nw) {
    f32x4 v[4]; float s = 0.f;
#pragma unroll
    for (int k = 0; k < 4; ++k) { v[k] = vn[k]; s += v[k][0] + v[k][1] + v[k][2] + v[k][3]; }
    { const int rn = row + nw < T_ALL ? row + nw : row;
#pragma unroll
      for (int k = 0; k < 4; ++k) vn[k] = *(const GAS f32x4*)(XB + (size_t)rn * 1024 + 256 * k + 4 * lane); }
    const float mu = wave_sum(s, lane) * (1.0f / 1024.0f);
    float q = 0.f;
#pragma unroll
    for (int k = 0; k < 4; ++k)
#pragma unroll
      for (int i = 0; i < 4; ++i) { const float dd = v[k][i] - mu; q += dd * dd; }
    const float rstd = rsqrtf(wave_sum(q, lane) * (1.0f / 1024.0f) + 1e-5f);
    const int b = row >> 12;
#pragma unroll
    for (int k = 0; k < 4; ++k) {
      const int cc = 256 * k + 4 * lane;
      const f32x4 gg = *(const GAS f32x4*)(gamg + cc), bb = *(const GAS f32x4*)(betg + cc);
      f32x4 y;
#pragma unroll
      for (int i = 0; i < 4; ++i) y[i] = (v[k][i] - mu) * rstd * gg[i] + bb[i];
      if (fin) { *(GAS f32x4*)(outp + (size_t)row * 1024 + cc) = y; }
      else {
        *(GAS f32x4*)(XB + (size_t)row * 1024 + cc) = y;
        const f32x4 sh = *(const GAS f32x4*)(mod + b * 6144 + s_shift * 1024 + cc), sc = *(const GAS f32x4*)(mod + b * 6144 + (s_shift + 1) * 1024 + cc);
        u32x2 o; o[0] = pk2(y[0] * (1.f + sc[0]) + sh[0], y[1] * (1.f + sc[1]) + sh[1]); o[1] = pk2(y[2] * (1.f + sc[2]) + sh[2], y[3] * (1.f + sc[3]) + sh[3]);
        *(GAS u32x2*)(U + (size_t)row * 1024 + cc) = o;
      }
    }
  }
}
typedef short s16x4 __attribute__((ext_vector_type(4)));
template <class V, class T> __device__ __forceinline__ V gld(const T* q) { return *(const GAS V*)q; }
template <class V, class T> __device__ __forceinline__ void gst(T* q, V v) { *(GAS V*)q = v; }
template <class T> __device__ __forceinline__ T* vaddr(T* q) { asm volatile("" : "+v"(q)); return q; }
#ifndef DUP_ATOM
#define DUP_ATOM 0
#endif
__device__ __forceinline__ void stat_add2(float* addr, float a, float b) {
  unsigned long long sv;
  asm volatile("s_mov_b64 %0, exec\n\ts_mov_b64 exec, 0xffff\n\tglobal_atomic_add_f32 %1, %2, off\n\tglobal_atomic_add_f32 %1, %3, off offset:4\n\ts_mov_b64 exec, %0"
               : "=&s"(sv) : "v"(addr), "v"(a), "v"(b) : "memory");
}
__device__ __forceinline__ void stat_add1(float* addr, float a) {
  unsigned long long sv;
  asm volatile("s_mov_b64 %0, exec\n\ts_mov_b64 exec, 0xffff\n\tglobal_atomic_add_f32 %1, %2, off\n\ts_mov_b64 exec, %0"
               : "=&s"(sv) : "v"(addr), "v"(a) : "memory");
}
__device__ __forceinline__ void ret_item(ldsp lds, const Params& p, int item, bool do_stats) {
  constexpr int KS = 0, VTS = 33792, STS = 43008, PS = 76800;
  const int es = item & 7, h = (item >> 3) & 3, bl = item >> 5;
  const int tid = otid(p.wv), w = tid >> 6, lane = tid & 63, fr = lane & 15, fq = lane >> 4;
  unsigned char* R0 = oaddr(p.ws) + OFF_R0; unsigned char* DO = (unsigned char*)oaddr(p.out);
  const bf16_t* Qr = (const bf16_t*)(R0 + R_QR); const bf16_t* Kr = (const bf16_t*)(R0 + R_KR);
  const bf16_t* VrT = (const bf16_t*)(DO + D_VRT); bf16_t* OrB = (bf16_t*)(R0 + R_ORB);
  float* stR = (float*)(p.ws + OFF_SMALL) + SM_STR;
  const float gam = 1.0f - __builtin_amdgcn_exp2f(-5.0f - (float)h), lg2 = __log2f(gam), g64 = __builtin_amdgcn_exp2f(lg2 * 64.0f);
  const int it = w >> 1, eh = w & 1;
  f32x4 st[2][4];
#pragma unroll
  for (int a = 0; a < 2; ++a)
#pragma unroll
    for (int b = 0; b < 4; ++b) st[a][b] = (f32x4){0.f, 0.f, 0.f, 0.f};
  const float rowscale = __builtin_amdgcn_exp2f(lg2 * (float)(16 * it + fr - 63));
  u32x4 kreg[4], vtreg; bf16x8 qn[8];
#define RET_LOADS(TOK) do { \
    const bf16_t* kbase = vaddr(Kr + (size_t)((TOK) + (tid >> 5)) * 1024 + h * 256 + (tid & 31) * 8); \
    const bf16_t* vtbase = vaddr(VrT + (size_t)(h * 512 + es * 64 + (tid >> 3)) * TG + (TOK) + (tid & 7) * 8); \
    const bf16_t* qbase = vaddr(Qr + (size_t)((TOK) + 16 * it + fr) * 1024 + h * 256 + fq * 8); \
    _Pragma("unroll") for (int i = 0; i < 4; ++i) kreg[i] = gld<u32x4>(kbase + (size_t)i * 16 * 1024); \
    vtreg = gld<u32x4>(vtbase); \
    _Pragma("unroll") for (int ks = 0; ks < 8; ++ks) qn[ks] = gld<bf16x8>(qbase + ks * 32); } while (0)
  RET_LOADS(bl * SEQ);
  for (int n = 0; n < 64; ++n) {
    const int tok0 = bl * SEQ + n * 64;
    bf16x8 qf[8];
    bf16_t* obase = vaddr(OrB + (size_t)(tok0 + 16 * it + fr) * 2048 + h * 512 + es * 64 + 32 * eh + 4 * fq);
    float* sbase = vaddr(stR + ((size_t)(tok0 + 16 * it + fr) * 4 + h) * 2);
#pragma unroll
    for (int ks = 0; ks < 8; ++ks) qf[ks] = qn[ks];
    __builtin_amdgcn_sched_barrier(0);
#pragma unroll
    for (int dt = 0; dt < 2; ++dt)
#pragma unroll
      for (int et = 0; et < 4; ++et) {
        u32x2 o; o[0] = pk2(st[dt][et][0], st[dt][et][1]); o[1] = pk2(st[dt][et][2], st[dt][et][3]);
        *(LAS u32x2*)(lds + STS + (16 * et + fr) * 528 + (32 * w + 16 * dt + 4 * fq) * 2) = o;
      }
#pragma unroll
    for (int i = 0; i < 4; ++i) { const int c = tid + 512 * i, r = c >> 5, ch = c & 31; *(LAS u32x4*)(lds + KS + r * 528 + ch * 16) = kreg[i]; }
    { const int r = tid >> 3, ch = tid & 7; *(LAS u32x4*)(lds + VTS + r * 144 + ch * 16) = vtreg; }
    __syncthreads();
    { const int tokn = bl * SEQ + (n < 63 ? n + 1 : 63) * 64; RET_LOADS(tokn); }
    f32x4 oacc[2];
    if (w < 4) {
    {
      bf16x8 k0[8], k1[8];
#pragma unroll
      for (int ks = 0; ks < 8; ++ks) { k0[ks] = ldfrag(lds, KS + (16 * (2 * eh) + fr) * 528 + (32 * ks + 8 * fq) * 2); k1[ks] = ldfrag(lds, KS + (16 * (2 * eh + 1) + fr) * 528 + (32 * ks + 8 * fq) * 2); }
      __builtin_amdgcn_sched_barrier(0);
      f32x4 s0 = (f32x4){0.f, 0.f, 0.f, 0.f}, s1_ = (f32x4){0.f, 0.f, 0.f, 0.f};
#pragma unroll
      for (int ks = 0; ks < 8; ++ks) { s0 = mfma16(k0[ks], qf[ks], s0); s1_ = mfma16(k1[ks], qf[ks], s1_); }
      const int i_ = 16 * it + fr;
      { const int j0 = 16 * (2 * eh) + 4 * fq;
        u32x2 o; o[0] = pk2(j0 + 0 <= i_ ? s0[0] : 0.f, j0 + 1 <= i_ ? s0[1] : 0.f); o[1] = pk2(j0 + 2 <= i_ ? s0[2] : 0.f, j0 + 3 <= i_ ? s0[3] : 0.f);
        *(LAS u32x2*)(lds + PS + i_ * 144 + j0 * 2) = o; }
      { const int j0 = 16 * (2 * eh + 1) + 4 * fq;
        u32x2 o; o[0] = pk2(j0 + 0 <= i_ ? s1_[0] : 0.f, j0 + 1 <= i_ ? s1_[1] : 0.f); o[1] = pk2(j0 + 2 <= i_ ? s1_[2] : 0.f, j0 + 3 <= i_ ? s1_[3] : 0.f);
        *(LAS u32x2*)(lds + PS + i_ * 144 + j0 * 2) = o; }
    }
    __builtin_amdgcn_sched_barrier(0);
    {
      bf16x8 a0[8], a1[8];
#pragma unroll
      for (int ks = 0; ks < 8; ++ks) { a0[ks] = ldfrag(lds, STS + (16 * (2 * eh) + fr) * 528 + (32 * ks + 8 * fq) * 2); a1[ks] = ldfrag(lds, STS + (16 * (2 * eh + 1) + fr) * 528 + (32 * ks + 8 * fq) * 2); }
      __builtin_amdgcn_sched_barrier(0);
      f32x4 o0 = (f32x4){0.f, 0.f, 0.f, 0.f}, o1 = (f32x4){0.f, 0.f, 0.f, 0.f};
#pragma unroll
      for (int ks = 0; ks < 8; ++ks) { o0 = mfma16(a0[ks], qf[ks], o0); o1 = mfma16(a1[ks], qf[ks], o1); }
      oacc[0] = o0; oacc[1] = o1;
    }
    __builtin_amdgcn_sched_barrier(0);
    {
      bf16x8 vf[2][4]; s16x4 t[2][2][2];
#pragma unroll
      for (int k2 = 0; k2 < 2; ++k2) {
#pragma unroll
        for (int et = 0; et < 4; ++et) vf[k2][et] = ldfrag(lds, VTS + (16 * et + fr) * 144 + (32 * k2 + 8 * fq) * 2);
#pragma unroll
        for (int dt = 0; dt < 2; ++dt) {
          const int a0_ = KS + (32 * k2 + 8 * fq + (fr >> 2)) * 528 + (32 * w + 16 * dt + 4 * (fr & 3)) * 2;
          t[k2][dt][0] = __builtin_amdgcn_ds_read_tr16_b64_v4i16((LAS s16x4*)(lds + a0_));
          t[k2][dt][1] = __builtin_amdgcn_ds_read_tr16_b64_v4i16((LAS s16x4*)(lds + a0_ + 4 * 528));
        }
      }
      __builtin_amdgcn_sched_barrier(0);
#pragma unroll
      for (int k2 = 0; k2 < 2; ++k2)
#pragma unroll
        for (int dt = 0; dt < 2; ++dt) {
          const bf16x8 kf = (bf16x8){t[k2][dt][0][0], t[k2][dt][0][1], t[k2][dt][0][2], t[k2][dt][0][3], t[k2][dt][1][0], t[k2][dt][1][1], t[k2][dt][1][2], t[k2][dt][1][3]};
#pragma unroll
          for (int et = 0; et < 4; ++et) st[dt][et] = mfma16(kf, vf[k2][et], st[dt][et]);
        }
    }
    } else {
    {
      bf16x8 vf[2][4]; s16x4 t[2][2][2];
#pragma unroll
      for (int k2 = 0; k2 < 2; ++k2) {
#pragma unroll
        for (int et = 0; et < 4; ++et) vf[k2][et] = ldfrag(lds, VTS + (16 * et + fr) * 144 + (32 * k2 + 8 * fq) * 2);
#pragma unroll
        for (int dt = 0; dt < 2; ++dt) {
          const int a0_ = KS + (32 * k2 + 8 * fq + (fr >> 2)) * 528 + (32 * w + 16 * dt + 4 * (fr & 3)) * 2;
          t[k2][dt][0] = __builtin_amdgcn_ds_read_tr16_b64_v4i16((LAS s16x4*)(lds + a0_));
          t[k2][dt][1] = __builtin_amdgcn_ds_read_tr16_b64_v4i16((LAS s16x4*)(lds + a0_ + 4 * 528));
        }
      }
      __builtin_amdgcn_sched_barrier(0);
#pragma unroll
      for (int k2 = 0; k2 < 2; ++k2)
#pragma unroll
        for (int dt = 0; dt < 2; ++dt) {
          const bf16x8 kf = (bf16x8){t[k2][dt][0][0], t[k2][dt][0][1], t[k2][dt][0][2], t[k2][dt][0][3], t[k2][dt][1][0], t[k2][dt][1][1], t[k2][dt][1][2], t[k2][dt][1][3]};
#pragma unroll
          for (int et = 0; et < 4; ++et) st[dt][et] = mfma16(kf, vf[k2][et], st[dt][et]);
        }
    }
    __builtin_amdgcn_sched_barrier(0);
    {
      bf16x8 a0[8], a1[8];
#pragma unroll
      for (int ks = 0; ks < 8; ++ks) { a0[ks] = ldfrag(lds, STS + (16 * (2 * eh) + fr) * 528 + (32 * ks + 8 * fq) * 2); a1[ks] = ldfrag(lds, STS + (16 * (2 * eh + 1) + fr) * 528 + (32 * ks + 8 * fq) * 2); }
      __builtin_amdgcn_sched_barrier(0);
      f32x4 o0 = (f32x4){0.f, 0.f, 0.f, 0.f}, o1 = (f32x4){0.f, 0.f, 0.f, 0.f};
#pragma unroll
      for (int ks = 0; ks < 8; ++ks) { o0 = mfma16(a0[ks], qf[ks], o0); o1 = mfma16(a1[ks], qf[ks], o1); }
      oacc[0] = o0; oacc[1] = o1;
    }
    __builtin_amdgcn_sched_barrier(0);
    {
      bf16x8 k0[8], k1[8];
#pragma unroll
      for (int ks = 0; ks < 8; ++ks) { k0[ks] = ldfrag(lds, KS + (16 * (2 * eh) + fr) * 528 + (32 * ks + 8 * fq) * 2); k1[ks] = ldfrag(lds, KS + (16 * (2 * eh + 1) + fr) * 528 + (32 * ks + 8 * fq) * 2); }
      __builtin_amdgcn_sched_barrier(0);
      f32x4 s0 = (f32x4){0.f, 0.f, 0.f, 0.f}, s1_ = (f32x4){0.f, 0.f, 0.f, 0.f};
#pragma unroll
      for (int ks = 0; ks < 8; ++ks) { s0 = mfma16(k0[ks], qf[ks], s0); s1_ = mfma16(k1[ks], qf[ks], s1_); }
      const int i_ = 16 * it + fr;
      { const int j0 = 16 * (2 * eh) + 4 * fq;
        u32x2 o; o[0] = pk2(j0 + 0 <= i_ ? s0[0] : 0.f, j0 + 1 <= i_ ? s0[1] : 0.f); o[1] = pk2(j0 + 2 <= i_ ? s0[2] : 0.f, j0 + 3 <= i_ ? s0[3] : 0.f);
        *(LAS u32x2*)(lds + PS + i_ * 144 + j0 * 2) = o; }
      { const int j0 = 16 * (2 * eh + 1) + 4 * fq;
        u32x2 o; o[0] = pk2(j0 + 0 <= i_ ? s1_[0] : 0.f, j0 + 1 <= i_ ? s1_[1] : 0.f); o[1] = pk2(j0 + 2 <= i_ ? s1_[2] : 0.f, j0 + 3 <= i_ ? s1_[3] : 0.f);
        *(LAS u32x2*)(lds + PS + i_ * 144 + j0 * 2) = o; }
    }
    }
#pragma unroll
    for (int dt = 0; dt < 2; ++dt)
#pragma unroll
      for (int et = 0; et < 4; ++et)
#pragma unroll
        for (int r = 0; r < 4; ++r) st[dt][et][r] *= g64;
    __syncthreads();
    float s1 = 0.f, s2 = 0.f;
    {
      bf16x8 pv[2], vv[2][2];
#pragma unroll
      for (int k2 = 0; k2 < 2; ++k2) {
        pv[k2] = ldfrag(lds, PS + (16 * it + fr) * 144 + (32 * k2 + 8 * fq) * 2);
        vv[0][k2] = ldfrag(lds, VTS + (16 * (2 * eh) + fr) * 144 + (32 * k2 + 8 * fq) * 2);
        vv[1][k2] = ldfrag(lds, VTS + (16 * (2 * eh + 1) + fr) * 144 + (32 * k2 + 8 * fq) * 2);
      }
      __builtin_amdgcn_sched_barrier(0);
#pragma unroll
      for (int ee = 0; ee < 2; ++ee) {
        f32x4 o = oacc[ee];
#pragma unroll
        for (int k2 = 0; k2 < 2; ++k2) o = mfma16(vv[ee][k2], pv[k2], o);
#pragma unroll
        for (int r = 0; r < 4; ++r) { o[r] *= rowscale; s1 += o[r]; s2 += o[r] * o[r]; }
        u32x2 ov; ov[0] = pk2(o[0], o[1]); ov[1] = pk2(o[2], o[3]);
        gst<u32x2>(obase + 16 * ee, ov);
      }
    }
    s1 += shx(s1, 16, lane); s1 += shx(s1, 32, lane); s2 += shx(s2, 16, lane); s2 += shx(s2, 32, lane);
    LAS float* sx = (LAS float*)(lds + 86016);
    if (eh == 1) { sx[(16 * it + fr) * 2] = s1; sx[(16 * it + fr) * 2 + 1] = s2; }
    __syncthreads();
    if (eh == 0 && do_stats) stat_add2(sbase, s1 + sx[(16 * it + fr) * 2], s2 + sx[(16 * it + fr) * 2 + 1]);
  }
}
__device__ __forceinline__ void hgrn_item(ldsp lds, const Params& p, int item, bool do_stats) {
  constexpr int QT = 0, KT = 17408, QB = 34816, KBT = 52224, VTS = 70656, STS = 75264, PS = 83968, TOT = 93184, DEC = 97280;
  const int es = item & 3, h = (item >> 2) & 7, bl = item >> 5;
  const int tid = otid(p.wv), w = tid >> 6, lane = tid & 63, fr = lane & 15, fq = lane >> 4;
  unsigned char* R0 = oaddr(p.ws) + OFF_R0; unsigned char* DO = (unsigned char*)oaddr(p.out);
  const bf16_t* Qh = (const bf16_t*)(R0 + R_QH); const float* LF = (const float*)(DO + D_LF); const bf16_t* ViT = (const bf16_t*)(R0 + R_VIT);
  bf16_t* OrA = (bf16_t*)(R0 + R_ORA);
  float* stH = (float*)(p.ws + OFF_SMALL) + SM_STH;
  LAS float* tot = (LAS float*)(lds + TOT); LAS float* dec = (LAS float*)(lds + DEC);
  const int it = w >> 1, eh = w & 1, d0 = 2 * lane;
  f32x4 st[2];
  st[0] = (f32x4){0.f, 0.f, 0.f, 0.f}; st[1] = (f32x4){0.f, 0.f, 0.f, 0.f};
  float lxn[8], lyn[8]; unsigned q2n[8]; u32x4 vtreg;
#define HG_LOADS(TOK) do { \
    const float* lfbase = vaddr(LF + (size_t)((TOK) + 8 * w) * 1024 + h * 128 + d0); \
    const bf16_t* qhbase = vaddr(Qh + (size_t)((TOK) + 8 * w) * 1024 + h * 128 + d0); \
    const bf16_t* vtbase = vaddr(ViT + (size_t)(h * 128 + es * 32 + ((tid & 255) >> 3)) * TG + (TOK) + (tid & 7) * 8); \
    _Pragma("unroll") for (int jj = 0; jj < 8; ++jj) { \
      const f32x2_ t = gld<f32x2_>(lfbase + (size_t)jj * 1024); lxn[jj] = t[0]; lyn[jj] = t[1]; q2n[jj] = gld<unsigned>(qhbase + (size_t)jj * 1024); } \
    vtreg = gld<u32x4>(vtbase); } while (0)
  HG_LOADS(bl * SEQ);
  for (int n = 0; n < 64; ++n) {
    const int tok0 = bl * SEQ + n * 64;
    float lx[8], ly[8]; unsigned q2[8];
    bf16_t* obase = vaddr(OrA + (size_t)(tok0 + 16 * it + fr) * 1024 + h * 128 + es * 32 + 16 * eh + 4 * fq);
    float* sbase = vaddr(stH + (size_t)(tok0 + 16 * it + fr) * 8 + h);
#pragma unroll
    for (int jj = 0; jj < 8; ++jj) { lx[jj] = lxn[jj]; ly[jj] = lyn[jj]; q2[jj] = q2n[jj]; }
    __builtin_amdgcn_sched_barrier(0);
    float px[8], py[8]; float cx = 0.f, cy = 0.f;
#pragma unroll
    for (int jj = 0; jj < 8; ++jj) { cx += lx[jj]; cy += ly[jj]; px[jj] = cx; py[jj] = cy; }
    tot[w * 128 + d0] = cx; tot[w * 128 + d0 + 1] = cy;
#pragma unroll
    for (int et = 0; et < 2; ++et) {
      u32x2 o; o[0] = pk2(st[et][0], st[et][1]); o[1] = pk2(st[et][2], st[et][3]);
      *(LAS u32x2*)(lds + STS + (16 * et + fr) * 272 + (16 * w + 4 * fq) * 2) = o;
    }
    if (tid < 256) { const int r = tid >> 3, ch = tid & 7; *(LAS u32x4*)(lds + VTS + r * 144 + ch * 16) = vtreg; }
    __syncthreads();
    { const int tokn = bl * SEQ + (n < 63 ? n + 1 : 63) * 64; HG_LOADS(tokn); }
    float offx = 0.f, offy = 0.f, rx = 0.f, ry = 0.f, bx = 0.f, by = 0.f;
#pragma unroll
    for (int q = 0; q < 8; ++q) {
      const float tx = tot[q * 128 + d0], ty = tot[q * 128 + d0 + 1];
      if (q < w) { offx += tx; offy += ty; }
      if (q < 4) { rx += tx; ry += ty; }
      bx += tx; by += ty;
    }
    if (w == 0) { dec[d0] = __expf(bx); dec[d0 + 1] = __expf(by); }
    unsigned kbx[4], kby[4];
    const float L2E = 1.4426950408889634f;
    const float erx = __builtin_amdgcn_exp2f(rx * L2E), ery = __builtin_amdgcn_exp2f(ry * L2E);
    const float ebx = __builtin_amdgcn_exp2f((bx - rx) * L2E), eby = __builtin_amdgcn_exp2f((by - ry) * L2E);
#pragma unroll
    for (int jj = 0; jj < 8; ++jj) {
      const float Bx = offx + px[jj], By = offy + py[jj];
      const float qx = bflo(q2[jj]), qy = bfhi(q2[jj]);
      const float kx = 1.0f - __builtin_amdgcn_exp2f(lx[jj] * L2E), ky = 1.0f - __builtin_amdgcn_exp2f(ly[jj] * L2E);
      const float e1x = __builtin_amdgcn_exp2f(__builtin_amdgcn_fmed3f((Bx - rx) * L2E, -115.f, 115.f)), e1y = __builtin_amdgcn_exp2f(__builtin_amdgcn_fmed3f((By - ry) * L2E, -115.f, 115.f));
      const float e2x = __builtin_amdgcn_rcpf(e1x), e2y = __builtin_amdgcn_rcpf(e1y);
      const float qtx = qx * e1x, qty = qy * e1y, ktx = kx * e2x, kty = ky * e2y;
      const int j = 8 * w + jj;
      *(LAS unsigned*)(lds + QT + j * 272 + d0 * 2) = pk2(qtx, qty);
      *(LAS unsigned*)(lds + KT + j * 272 + d0 * 2) = pk2(ktx, kty);
      *(LAS unsigned*)(lds + QB + j * 272 + d0 * 2) = pk2(qtx * erx, qty * ery);
      const float kbvx = ktx * ebx, kbvy = kty * eby;
      if (jj & 1) { kbx[jj >> 1] = pk2(__uint_as_float(kbx[jj >> 1]), kbvx); kby[jj >> 1] = pk2(__uint_as_float(kby[jj >> 1]), kbvy); }
      else { kbx[jj >> 1] = __float_as_uint(kbvx); kby[jj >> 1] = __float_as_uint(kbvy); }
    }
    *(LAS u32x4*)(lds + KBT + d0 * 144 + (8 * w) * 2) = (u32x4){kbx[0], kbx[1], kbx[2], kbx[3]};
    *(LAS u32x4*)(lds + KBT + (d0 + 1) * 144 + (8 * w) * 2) = (u32x4){kby[0], kby[1], kby[2], kby[3]};
    __syncthreads();
    f32x4 oacc;
    {
      bf16x8 k0[4], k1[4], qt[4];
#pragma unroll
      for (int ks = 0; ks < 4; ++ks) {
        qt[ks] = ldfrag(lds, QT + (16 * it + fr) * 272 + (32 * ks + 8 * fq) * 2);
        k0[ks] = ldfrag(lds, KT + (16 * (2 * eh) + fr) * 272 + (32 * ks + 8 * fq) * 2);
        k1[ks] = ldfrag(lds, KT + (16 * (2 * eh + 1) + fr) * 272 + (32 * ks + 8 * fq) * 2);
      }
      __builtin_amdgcn_sched_barrier(0);
      f32x4 s0 = (f32x4){0.f, 0.f, 0.f, 0.f}, s1_ = (f32x4){0.f, 0.f, 0.f, 0.f};
#pragma unroll
      for (int ks = 0; ks < 4; ++ks) { s0 = mfma16(k0[ks], qt[ks], s0); s1_ = mfma16(k1[ks], qt[ks], s1_); }
      const int i_ = 16 * it + fr;
      { const int j0 = 16 * (2 * eh) + 4 * fq;
        u32x2 o; o[0] = pk2(j0 + 0 <= i_ ? s0[0] : 0.f, j0 + 1 <= i_ ? s0[1] : 0.f); o[1] = pk2(j0 + 2 <= i_ ? s0[2] : 0.f, j0 + 3 <= i_ ? s0[3] : 0.f);
        *(LAS u32x2*)(lds + PS + i_ * 144 + j0 * 2) = o; }
      { const int j0 = 16 * (2 * eh + 1) + 4 * fq;
        u32x2 o; o[0] = pk2(j0 + 0 <= i_ ? s1_[0] : 0.f, j0 + 1 <= i_ ? s1_[1] : 0.f); o[1] = pk2(j0 + 2 <= i_ ? s1_[2] : 0.f, j0 + 3 <= i_ ? s1_[3] : 0.f);
        *(LAS u32x2*)(lds + PS + i_ * 144 + j0 * 2) = o; }
    }
    __builtin_amdgcn_sched_barrier(0);
    {
      bf16x8 sa[4], qb[4], kf[2], vf[2][2];
#pragma unroll
      for (int ks = 0; ks < 4; ++ks) { sa[ks] = ldfrag(lds, STS + (16 * eh + fr) * 272 + (32 * ks + 8 * fq) * 2); qb[ks] = ldfrag(lds, QB + (16 * it + fr) * 272 + (32 * ks + 8 * fq) * 2); }
#pragma unroll
      for (int k2 = 0; k2 < 2; ++k2) {
        kf[k2] = ldfrag(lds, KBT + (16 * w + fr) * 144 + (32 * k2 + 8 * fq) * 2);
        vf[k2][0] = ldfrag(lds, VTS + (fr) * 144 + (32 * k2 + 8 * fq) * 2); vf[k2][1] = ldfrag(lds, VTS + (16 + fr) * 144 + (32 * k2 + 8 * fq) * 2);
      }
      const f32x4 dv = *(const LAS f32x4*)(dec + 16 * w + 4 * fq);
      __builtin_amdgcn_sched_barrier(0);
      f32x4 o = (f32x4){0.f, 0.f, 0.f, 0.f};
#pragma unroll
      for (int et = 0; et < 2; ++et)
#pragma unroll
        for (int r = 0; r < 4; ++r) st[et][r] *= dv[r];
#pragma unroll
      for (int ks = 0; ks < 4; ++ks) o = mfma16(sa[ks], qb[ks], o);
#pragma unroll
      for (int k2 = 0; k2 < 2; ++k2)
#pragma unroll
        for (int et = 0; et < 2; ++et) st[et] = mfma16(kf[k2], vf[k2][et], st[et]);
      oacc = o;
    }
    __syncthreads();
    {
      bf16x8 pv[2], vv[2];
#pragma unroll
      for (int k2 = 0; k2 < 2; ++k2) { pv[k2] = ldfrag(lds, PS + (16 * it + fr) * 144 + (32 * k2 + 8 * fq) * 2); vv[k2] = ldfrag(lds, VTS + (16 * eh + fr) * 144 + (32 * k2 + 8 * fq) * 2); }
      __builtin_amdgcn_sched_barrier(0);
      f32x4 o = oacc;
#pragma unroll
      for (int k2 = 0; k2 < 2; ++k2) o = mfma16(vv[k2], pv[k2], o);
      float s2 = o[0] * o[0] + o[1] * o[1] + o[2] * o[2] + o[3] * o[3];
      u32x2 ov; ov[0] = pk2(o[0], o[1]); ov[1] = pk2(o[2], o[3]);
      gst<u32x2>(obase, ov);
      s2 += shx(s2, 16, lane); s2 += shx(s2, 32, lane);
      LAS float* sx = (LAS float*)(lds + 97792);
      if (eh == 1) sx[16 * it + fr] = s2;
      __syncthreads();
      if (eh == 0 && do_stats) stat_add1(sbase, s2 + sx[16 * it + fr]);
    }
  }
}
#ifndef TSEL
#define TSEL -1
#endif
#ifndef STAGGER_TICKS
#define STAGGER_TICKS 0
#endif
#ifndef REP_RET
#define REP_RET 1
#endif
#ifndef REP_HG
#define REP_HG 1
#endif
#ifndef REP_G1
#define REP_G1 1
#endif
#ifndef REP_G2
#define REP_G2 1
#endif
#ifndef REP_G4
#define REP_G4 1
#endif
#ifndef REP_SYNC
#define REP_SYNC 1
#endif
#ifndef REP_PRO
#define REP_PRO 1
#endif
#ifndef REP_S1
#define REP_S1 1
#endif
enum { ST_G1 = 0, ST_S1, ST_G1B, ST_G2, ST_G3, ST_L1, ST_G4, ST_G5, ST_L2 };
__global__ void __launch_bounds__(512, 2) mega(Params p0) {
  extern __shared__ __attribute__((aligned(16))) unsigned char shm[];
  ldsp lds = (ldsp)shm;
  cg::grid_group grid = cg::this_grid();
  Params p = p0; p.ws = oaddr(p0.ws); p.out = oaddr(p0.out); p.wv = __builtin_amdgcn_readfirstlane((int)(threadIdx.x >> 6));
  volatile LAS unsigned* xst = (volatile LAS unsigned*)(lds + 131072);
  if (threadIdx.x < 4) xst[threadIdx.x] = 0u;
  __syncthreads();
  (void)xcd_barrier_post((unsigned*)(p0.ws + OFF_SMALL + SM_BAR_BYTES), xst);
  for (int r = 0; r < REP_PRO; ++r) {
    p.ws = oaddr(p0.ws);
    phase_mod(lds, p);
    phase_conv(lds, p, 0);
    grid.sync();
  }
  phase_u0(p);
  gbar((unsigned*)(p0.ws + OFF_SMALL + SM_BAR_BYTES), xst);
#if TSEL >= 0
  volatile LAS unsigned* tacc = (volatile LAS unsigned*)(lds + 131072 + 16);
  if (threadIdx.x == 0) tacc[0] = 0u;
#endif
  for (int pc = 0; pc < 28; ++pc) {
#if TSEL >= 0
    if (otid(p.wv) == 0) tacc[1] = (unsigned)__builtin_amdgcn_s_memrealtime();
#endif
    p.ws = oaddr(p0.ws); p.out = oaddr(p0.out);
    const bf16_t* WB = (const bf16_t*)(p.ws + OFF_WB);
    const bf16_t* U = (const bf16_t*)(p.ws + OFF_U);
    unsigned char* R0 = p.ws + OFF_R0;
    const int l = pc / 14, k = pc - l * 14;
    int g = 0, stg;
    if (k < 10) { g = k / 5; stg = k - g * 5; } else stg = ST_L1 + (k - 10);
    int nj = 0, jmode0 = 0, jmode1 = 0; const bf16_t* jA0 = nullptr; const bf16_t* jA1 = nullptr; const bf16_t* jB0 = nullptr; const bf16_t* jB1 = nullptr;
    int jM0 = 0, jM1 = 0, jN0 = 0, jN1 = 0, jK0 = 0, jK1 = 0;
    if (stg == ST_G1) {
      float* stz = (float*)(p.ws + OFF_SMALL) + SM_STR;
      for (int i = obid() * 512 + otid(p.wv); i < TG * 16; i += gridDim.x * 512) stz[i] = 0.f;
      nj = 2;
      jmode0 = MD_G1A; jA0 = U + (size_t)g * TG * 1024; jB0 = WB + W1A; jM0 = TG; jN0 = 4096; jK0 = 1024;
      jmode1 = MD_G1S; jA1 = WB + W1S; jB1 = U + (size_t)g * TG * 1024; jM1 = 3072; jN1 = TG; jK1 = 1024;
    } else if (stg == ST_S1) {
      for (int rep = 0; rep < REP_S1; ++rep) {
        if (rep) { gbar((unsigned*)(p0.ws + OFF_SMALL + SM_BAR_BYTES), xst); float* stz = (float*)(p.ws + OFF_SMALL) + SM_STR; for (int i = obid() * 512 + otid(p.wv); i < TG * 16; i += gridDim.x * 512) stz[i] = 0.f; gbar((unsigned*)(p0.ws + OFF_SMALL + SM_BAR_BYTES), xst); }
        const int bid = obid();
        if (bid < 128) { const int xcd = bid & 7, slot = bid >> 3, item = ((xcd * 2 + (slot >> 3)) << 3) | (slot & 7);
          for (int r2 = 0; r2 < REP_RET; ++r2) ret_item(lds, p, item, r2 == REP_RET - 1); }
        else { const int b2 = bid - 128, xcd = b2 & 7, slot = b2 >> 3, item = ((xcd * 4 + (slot >> 2)) << 2) | (slot & 3);
          for (int r2 = 0; r2 < REP_HG; ++r2) hgrn_item(lds, p, item, r2 == REP_HG - 1); }
      }
    } else if (stg == ST_G1B) {
      nj = 1; jmode0 = MD_G1B; jA0 = U + (size_t)g * TG * 1024; jB0 = WB + W1B; jM0 = TG; jN0 = 5120; jK0 = 1024;
    } else if (stg == ST_G2) {
      nj = 2;
      jmode0 = MD_G2A; jA0 = (const bf16_t*)(R0 + R_ORA); jB0 = WB + WPA; jM0 = TG; jN0 = 1024; jK0 = 1024;
      jmode1 = MD_G2B; jA1 = (const bf16_t*)(R0 + R_ORB); jB1 = WB + WPB; jM1 = TG; jN1 = 1024; jK1 = 2048;
    } else if (stg == ST_G3) {
      nj = 1; jmode0 = MD_G3; jA0 = (const bf16_t*)(R0 + R_MG); jB0 = WB + WO; jM0 = TG; jN0 = 1024; jK0 = 1024;
    } else if (stg == ST_L1) {
      phase_ln(p, p.ln1_g + l * 1024, p.ln1_b + l * 1024, l, 3, false);
    } else if (stg == ST_G4) {
      nj = 1; jmode0 = MD_G4; jA0 = U; jB0 = WB + WUP; jM0 = T_ALL; jN0 = 4096; jK0 = 1024;
    } else if (stg == ST_G5) {
      nj = 1; jmode0 = MD_G5; jA0 = (const bf16_t*)R0; jB0 = WB + WDN; jM0 = T_ALL; jN0 = 1024; jK0 = 4096;
    } else {
      phase_ln(p, p.ln2_g + l * 1024, p.ln2_b + l * 1024, l == 0 ? 1 : 0, 0, l == 1);
      if (l == 0) phase_conv(lds, p, 1);
    }
    for (int j = 0; j < nj * (stg == ST_G4 ? REP_G4 : 1) * (stg == ST_G1 ? REP_G1 : 1) * (stg == ST_G2 ? REP_G2 : 1); ++j) {
      pg8::Gemm gm; const bool j1 = (nj == 2 && (j & 1) == 1); gm.A = j1 ? jA1 : jA0; gm.Bt = j1 ? jB1 : jB0; gm.M = j1 ? jM1 : jM0; gm.N = j1 ? jN1 : jN0; gm.K = j1 ? jK1 : jK0;
      pg8::StaticOrder S; S.init(gm.M, gm.N, (int)gridDim.x, obid());
      EpiP E; E.mode = j1 ? jmode1 : jmode0; E.l = l; E.g = g; E.pp = &p;
#if STAGGER_TICKS > 0
      if (j == 0 && (gm.M >> 8) * (gm.N >> 8) >= 3 * (int)gridDim.x && ((obid() >> 3) & 1)) {
        const unsigned long long t0 = __builtin_amdgcn_s_memrealtime();
        while (__builtin_amdgcn_s_memrealtime() - t0 < (unsigned long long)STAGGER_TICKS) __builtin_amdgcn_s_sleep(32);
      }
#endif
      pg8::gemm_phase<EpiP, pg8::StaticOrder, false>((PG8_LAS unsigned char*)shm, gm, S, E, nullptr);
    }
    for (int r = 0; r < REP_SYNC; ++r) gbar((unsigned*)(p0.ws + OFF_SMALL + SM_BAR_BYTES), xst);
#if TSEL >= 0
    const int k2_ = pc - (pc / 14) * 14, stg2_ = k2_ < 10 ? k2_ % 5 : ST_L1 + (k2_ - 10);
    if (otid(p.wv) == 0 && ((TSEL >> stg2_) & 1)) tacc[0] = tacc[0] + ((unsigned)__builtin_amdgcn_s_memrealtime() - tacc[1]);
#endif
  }
#if TSEL >= 0
  if (obid() == 0 && otid(p.wv) == 0) { const unsigned long long t0 = __builtin_amdgcn_s_memrealtime(); const unsigned long long w = 4ull * tacc[0]; while (__builtin_amdgcn_s_memrealtime() - t0 < w) __builtin_amdgcn_s_sleep(32); }
#endif
}

extern "C" void kernel_launch(void* const* d_in, const int* in_sizes, int n_in, void* d_out, int out_size,
                              void* d_ws, size_t ws_size, hipStream_t stream) {
  constexpr size_t kDynLds = 131072 + 16 + 16;
  static int configured = 0;
  if (!configured) {
    (void)hipFuncSetAttribute((const void*)mega, hipFuncAttributeMaxDynamicSharedMemorySize, (int)kDynLds);
    configured = 1;
  }
  Params p{};
  p.x = (const float*)d_in[0]; p.c = (const float*)d_in[1]; p.pos = (const int*)d_in[2]; p.lb_logits = (const float*)d_in[3];
  p.w_ada = (const float*)d_in[4]; p.b_ada = (const float*)d_in[5]; p.w_in = (const float*)d_in[6]; p.w_pa = (const float*)d_in[7];
  p.w_pb = (const float*)d_in[8]; p.w_o = (const float*)d_in[9]; p.ln1_g = (const float*)d_in[10]; p.ln1_b = (const float*)d_in[11];
  p.w_up = (const float*)d_in[12]; p.b_up = (const float*)d_in[13]; p.w_down = (const float*)d_in[14]; p.b_down = (const float*)d_in[15];
  p.ln2_g = (const float*)d_in[16]; p.ln2_b = (const float*)d_in[17];
  p.out = (float*)d_out; p.ws = (unsigned char*)d_ws;
  if (ws_size < 512ull * 1024 * 1024) { fprintf(stderr, "workspace too small\n"); return; }
  (void)hipMemsetAsync((unsigned char*)d_ws + OFF_SMALL + SM_BAR_BYTES, 0, XCD_BAR_WORDS * 4, stream);
  void* args[] = {&p};
  hipError_t e = hipLaunchCooperativeKernel((void*)mega, dim3(256), dim3(512), args, kDynLds, stream);
  if (e != hipSuccess) fprintf(stderr, "cooperative launch failed: %s\n", hipGetErrorString(e));
}
```
